# Optimizing an MI355X kernel written in HIP

```python
import jax, jax.numpy as jnp
from jax import lax
import numpy as np

D_MODEL = 2048
BATCH = 2
SEQ = 8192
DEPTH = 4

N_MEM = 256
W_MEM = D_MODEL // 4
W_CONV = (D_MODEL - W_MEM) // 2
W_DIFF = D_MODEL - W_MEM - W_CONV
W_MIX = W_CONV + W_DIFF + W_MEM
CONV_GROUP_DIM = 128
CONV_GROUPS = W_CONV // CONV_GROUP_DIM
CONV_WIDTH = 3
DIFF_V_DIM = 128
DIFF_HALF_DIM = 64
DIFF_HEADS = W_DIFF // DIFF_V_DIM
MEM_HEAD_DIM = 128
MEM_HEADS = W_MEM // MEM_HEAD_DIM
Q_BLOCK = 128
EPS = 1e-6
SPLIT_SIZES = (W_CONV, W_CONV, W_CONV, W_CONV,
               W_DIFF, W_DIFF, W_DIFF, W_DIFF,
               W_MEM, W_MEM)
IN_COLS = sum(SPLIT_SIZES)

kernel_name = "hybrid_conv_diffattn_memxattn_encoder"


def rmsnorm(x, g):
    xf = x.astype(jnp.float32)
    y = xf * lax.rsqrt(jnp.mean(xf * xf, axis=-1, keepdims=True) + EPS)
    return (y * g.astype(jnp.float32)).astype(x.dtype)


def alibi_slopes(n_heads):
    return jnp.asarray(np.array([2.0 ** (-8.0 * (h + 1) / n_heads) for h in range(n_heads)], dtype=np.float32))


def short_gated_conv(a_x, a_b, a_c, w, b):
    u = a_c * a_x
    up = jnp.pad(u, ((0, 0), (1, 1), (0, 0)))
    z = up[:, :-2] * w[0] + up[:, 1:-1] * w[1] + up[:, 2:] * w[2] + b
    return a_b * z


def diff_attention(q, k, v, lam, slopes):
    b, s = q.shape[0], q.shape[1]
    nb = s // Q_BLOCK
    scale = DIFF_HALF_DIM ** -0.5
    kt = k.transpose(0, 2, 3, 1, 4)
    vt = v.transpose(0, 2, 1, 3)
    qb = q.reshape(b, nb, Q_BLOCK, DIFF_HEADS, 2, DIFF_HALF_DIM).transpose(1, 0, 3, 4, 2, 5)
    key_pos = jnp.arange(s, dtype=jnp.float32)

    def block(args):
        qi, i = args
        qpos = (i * Q_BLOCK + jnp.arange(Q_BLOCK)).astype(jnp.float32)
        bias = -slopes[:, None, None] * jnp.abs(qpos[:, None] - key_pos[None, :])
        sc = jnp.einsum('bhcqd,bhckd->bhcqk', qi, kt).astype(jnp.float32) * scale + bias[None, :, None]
        p = jax.nn.softmax(sc, axis=-1).astype(vt.dtype)
        o = jnp.einsum('bhcqk,bhkd->bhcqd', p, vt)
        return o[:, :, 0] - lam.astype(o.dtype) * o[:, :, 1]

    out = lax.map(block, (qb, jnp.arange(nb)))
    return out.transpose(1, 0, 3, 2, 4).reshape(b, s, DIFF_HEADS, DIFF_V_DIM)


def memory_attention(q, mk, mv):
    sc = jnp.einsum('bshd,bmhd->bhsm', q, mk).astype(jnp.float32) * (MEM_HEAD_DIM ** -0.5)
    p = jax.nn.softmax(sc, axis=-1).astype(mv.dtype)
    return jnp.einsum('bhsm,bmhd->bshd', p, mv)


def setup_inputs(seed: int = 0) -> dict:
    key = jax.random.key(seed)
    ks = jax.random.split(key, 18)
    nrm = jax.random.normal
    f32 = jnp.float32
    gain = lambda k, shape: 1.0 + 0.02 * nrm(k, shape, f32)
    return {
        "x": nrm(ks[0], (BATCH, SEQ, D_MODEL), f32),
        "mem": nrm(ks[1], (BATCH, N_MEM, D_MODEL), f32),
        "norm_g": gain(ks[2], (DEPTH, D_MODEL)),
        "w_in": nrm(ks[3], (DEPTH, D_MODEL, IN_COLS), f32) * D_MODEL ** -0.5,
        "conv_w": nrm(ks[4], (DEPTH, CONV_WIDTH, W_CONV), f32) * CONV_WIDTH ** -0.5,
        "conv_b": 0.02 * nrm(ks[5], (DEPTH, W_CONV), f32),
        "diff_q_norm_g": gain(ks[6], (DEPTH, DIFF_HALF_DIM)),
        "diff_k_norm_g": gain(ks[7], (DEPTH, DIFF_HALF_DIM)),
        "lambda_q1": 0.1 * nrm(ks[8], (DEPTH, DIFF_HALF_DIM), f32),
        "lambda_k1": 0.1 * nrm(ks[9], (DEPTH, DIFF_HALF_DIM), f32),
        "lambda_q2": 0.1 * nrm(ks[10], (DEPTH, DIFF_HALF_DIM), f32),
        "lambda_k2": 0.1 * nrm(ks[11], (DEPTH, DIFF_HALF_DIM), f32),
        "diff_head_norm_g": gain(ks[12], (DEPTH, DIFF_V_DIM)),
        "mem_norm_g": gain(ks[13], (DEPTH, D_MODEL)),
        "w_mem_kv": nrm(ks[14], (DEPTH, D_MODEL, 2 * W_MEM), f32) * D_MODEL ** -0.5,
        "mem_q_norm_g": gain(ks[15], (DEPTH, MEM_HEAD_DIM)),
        "mem_k_norm_g": gain(ks[16], (DEPTH, MEM_HEAD_DIM)),
        "w_out": nrm(ks[17], (DEPTH, W_MIX, D_MODEL), f32) * W_MIX ** -0.5,
    }


def reference(x, mem, norm_g, w_in, conv_w, conv_b, diff_q_norm_g, diff_k_norm_g,
              lambda_q1, lambda_k1, lambda_q2, lambda_k2, diff_head_norm_g,
              mem_norm_g, w_mem_kv, mem_q_norm_g, mem_k_norm_g, w_out):
    b, s = x.shape[0], x.shape[1]
    slopes = alibi_slopes(DIFF_HEADS)
    offsets = list(np.cumsum(SPLIT_SIZES)[:-1])
    for l in range(DEPTH):
        h = rmsnorm(x, norm_g[l])
        proj = h @ w_in[l]
        a_x, a_b, a_c, a_g, d_q, d_k, d_v, d_g, m_q, m_g = jnp.split(proj, offsets, axis=-1)

        y_a = short_gated_conv(a_x, a_b, a_c, conv_w[l], conv_b[l]) * jax.nn.silu(a_g)

        q = rmsnorm(d_q.reshape(b, s, DIFF_HEADS, 2, DIFF_HALF_DIM), diff_q_norm_g[l])
        k = rmsnorm(d_k.reshape(b, s, DIFF_HEADS, 2, DIFF_HALF_DIM), diff_k_norm_g[l])
        v = d_v.reshape(b, s, DIFF_HEADS, DIFF_V_DIM)
        lam_init = 0.8 - 0.6 * float(np.exp(-0.3 * l))
        lam = (jnp.exp(jnp.sum(lambda_q1[l].astype(jnp.float32) * lambda_k1[l].astype(jnp.float32)))
               - jnp.exp(jnp.sum(lambda_q2[l].astype(jnp.float32) * lambda_k2[l].astype(jnp.float32)))
               + lam_init)
        o_d = diff_attention(q, k, v, lam, slopes)
        o_d = rmsnorm(o_d, diff_head_norm_g[l]) * (1.0 - lam_init)
        y_d = o_d.reshape(b, s, W_DIFF) * jax.nn.silu(d_g)

        mn = rmsnorm(mem, mem_norm_g[l])
        mkv = mn @ w_mem_kv[l]
        mk = rmsnorm(mkv[..., :W_MEM].reshape(b, N_MEM, MEM_HEADS, MEM_HEAD_DIM), mem_k_norm_g[l])
        mv = mkv[..., W_MEM:].reshape(b, N_MEM, MEM_HEADS, MEM_HEAD_DIM)
        mq = rmsnorm(m_q.reshape(b, s, MEM_HEADS, MEM_HEAD_DIM), mem_q_norm_g[l])
        y_m = memory_attention(mq, mk, mv).reshape(b, s, W_MEM) * jax.nn.silu(m_g)

        y = jnp.concatenate([y_a, y_d, y_m], axis=-1) @ w_out[l]
        x = x + y
    return x
```

```cpp
#include <hip/hip_runtime.h>
#include <hip/hip_cooperative_groups.h>
#include <cstdio>
#include <cstdint>
namespace cg = cooperative_groups;

#ifndef DIFF_ANTIPHASE
#define DIFF_ANTIPHASE 1
#endif
#ifndef MK_ONE_LAUNCH
#define MK_ONE_LAUNCH 1
#endif

constexpr int DM = 2048, BATCH = 2, SEQ = 8192, DEPTH = 4, NMEM = 256, MTOK = BATCH * SEQ, INC = 7168, MKVC = 4096, MMEM = BATCH * NMEM;
constexpr int C_AX = 0, C_AB = 768, C_AC = 1536, C_AG = 2304, C_DQ = 3072, C_DK = 3840, C_DV = 4608, C_DG = 5376, C_MQ = 6144, C_MG = 6656;
constexpr int Y_A = 0, Y_D = 768, Y_M = 1536;
constexpr float EPS = 1e-6f, LOG2E = 1.4426950408889634f;
constexpr float QSCALE_D = 0.125f * LOG2E;
constexpr float QSCALE_M = 0.08838834764831845f * LOG2E;
constexpr size_t MiB = 1u << 20;
constexpr size_t WS_WIN = 0, WS_WOUT = 112 * MiB, WS_WMEM = 144 * MiB, WS_XB = 160 * MiB, WS_MEMB = 224 * MiB, WS_MKV = 226 * MiB, WS_SSQ = 230 * MiB, WS_SSQM = 232 * MiB, WS_CTR = 233 * MiB, WS_BAR = 234 * MiB,
                 WS_PROJ = 240 * MiB, WS_Y = 464 * MiB, WS_END = 528 * MiB;
constexpr int LDS_BYTES = 131072 + 4096;
__device__ __forceinline__ int opaque_tid(int wv) { int lane_; asm volatile("v_mbcnt_lo_u32_b32 %0, -1, 0\n\tv_mbcnt_hi_u32_b32 %0, -1, %0" : "=v"(lane_)); return wv * 64 + lane_; }
template <int X> __device__ __forceinline__ float swz_xor(float v) { return __int_as_float(__builtin_amdgcn_ds_swizzle(__float_as_int(v), (X << 10) | 0x1f)); }
__device__ __forceinline__ float xsum32(float v) { auto rr = __builtin_amdgcn_permlane32_swap(__float_as_uint(v), __float_as_uint(v), false, false); return __uint_as_float(rr[0]) + __uint_as_float(rr[1]); }
__device__ __forceinline__ float xmax32(float v) { auto rr = __builtin_amdgcn_permlane32_swap(__float_as_uint(v), __float_as_uint(v), false, false); return fmaxf(__uint_as_float(rr[0]), __uint_as_float(rr[1])); }
namespace pg8 {
#define PG8_LAS __attribute__((address_space(3)))
typedef unsigned short bf16_t;
typedef short bf16x8 __attribute__((ext_vector_type(8)));
typedef float f32x4 __attribute__((ext_vector_type(4)));
typedef unsigned u32x4 __attribute__((ext_vector_type(4)));
constexpr int BM = 256, BK = 64, HALF = 128, HTB = HALF * BK * 2  , STAGE_BYTES = 8 * HTB, NXCD = 8, WGM = 8;

__host__ __device__ __forceinline__ int lds_byte(int r, int c) { const int st = (r >> 4) * 2 + (c >> 5), rr = r & 15, cc = c & 31, ob = rr * 64 + cc * 2; return st * 1024 + (ob ^ (((ob >> 9) & 1) << 5)); }
__host__ __device__ __forceinline__ void stage_rc(int b, int& R, int& C) { const int st = b / 1024, sb = b % 1024, swz = sb ^ (((sb >> 9) & 1) << 5); R = (st >> 1) * 16 + swz / 64; C = (st & 1) * 32 + (swz % 64) / 2; }
__host__ __device__ __forceinline__ int perm32(int rho) { const int n = rho >> 4, i = rho & 15; return 8 * (i >> 2) + 4 * n + (i & 3); }

struct Unit { int pm, pn; };
struct Gemm { const bf16_t* A; const bf16_t* Bt; int M, N, K; };

struct StaticOrder {
    int nM, nN, nwg, G, c;
    __host__ __device__ void init(int M, int N, int G_, int c_) { nM = M / BM; nN = N / BM; nwg = nM * nN; G = G_; c = c_; }
    __host__ __device__ bool next(int i, Unit& u) const {
        const long L = (long)i * G + c; if (L >= nwg) return false;
        int wgid = (int)L; { const int q = nwg / NXCD, r = nwg % NXCD, xcd = wgid % NXCD, off = wgid / NXCD; wgid = (xcd < r ? xcd * (q + 1) : r * (q + 1) + (xcd - r) * q) + off; }
        const int nig = WGM * nN, gid = wgid / nig, fm = gid * WGM, gsz = (nM - fm) < WGM ? (nM - fm) : WGM;
        u.pm = fm + ((wgid % nig) % gsz); u.pn = (wgid % nig) / gsz; return true;
    }
    __device__ __forceinline__ void a_ready(const Unit&) const {}
    __device__ __forceinline__ void done(const Unit&) const {}
};


__device__ __forceinline__ unsigned cvt_pk_bf16(float lo, float hi) { unsigned r; asm volatile("v_cvt_pk_bf16_f32 %0, %1, %2" : "=v"(r) : "v"(lo), "v"(hi)); return r; }

struct EpiProj {
    static constexpr bool PERM = true, AFTER_DRAIN = false;
    bf16_t* O; int ldc; const float* ssq; const float* gq; const float* gk; int qlo, qhi, klo, khi; float qscale;
    __device__ __forceinline__ void operator()(const f32x4 (&acc)[2][2][4][2], const Unit& u, int wr, int wc, int fr, int fq) const {
        const int row0 = u.pm * BM + wr * 64 + fr, colw = u.pn * BM + wc * 64 + 8 * fq;
        const int mode = (u.pn >= qlo && u.pn < qhi) ? 1 : ((u.pn >= klo && u.pn < khi) ? 2 : 0);
        f32x4 gv[2][2];
#pragma unroll
        for (int bj = 0; bj < 2; ++bj)
#pragma unroll
            for (int n = 0; n < 2; ++n) gv[bj][n] = (f32x4){1.f, 1.f, 1.f, 1.f};
        if (mode) { const float* g = (mode == 1) ? gq : gk; const float s = (mode == 1) ? qscale : 1.f;
#pragma unroll
            for (int bj = 0; bj < 2; ++bj)
#pragma unroll
                for (int n = 0; n < 2; ++n) gv[bj][n] = *(const f32x4*)(g + 32 * bj + 8 * fq + 4 * n) * s; }
#pragma unroll
        for (int ai = 0; ai < 2; ++ai)
#pragma unroll
            for (int m = 0; m < 4; ++m) {
                const int row = row0 + ai * HALF + m * 16;
                const f32x4* sp = (const f32x4*)(ssq + (size_t)row * 32 + 8 * fq); const f32x4 sa = sp[0], sb = sp[1];
                float s = ((sa.x + sa.y) + (sa.z + sa.w)) + ((sb.x + sb.y) + (sb.z + sb.w)); s += swz_xor<16>(s); s = xsum32(s);
                const float r = 1.0f / sqrtf(s * (1.0f / 2048.0f) + 1e-6f);
                f32x4 v[2][2]; float ss = 0.f;
#pragma unroll
                for (int bj = 0; bj < 2; ++bj)
#pragma unroll
                    for (int n = 0; n < 2; ++n) { v[bj][n] = acc[ai][bj][m][n] * r; const f32x4 q = v[bj][n] * v[bj][n]; ss += (q.x + q.y) + (q.z + q.w); }
                float rn = 1.f;
                if (mode) { ss += swz_xor<16>(ss); ss = xsum32(ss); rn = 1.0f / sqrtf(ss * (1.0f / 64.0f) + 1e-6f); }
                bf16_t* rowp = O + (size_t)row * ldc + colw;
#pragma unroll
                for (int bj = 0; bj < 2; ++bj) { const f32x4 v0 = v[bj][0] * gv[bj][0] * rn, v1 = v[bj][1] * gv[bj][1] * rn;
                    u32x4 w; w.x = cvt_pk_bf16(v0[0], v0[1]); w.y = cvt_pk_bf16(v0[2], v0[3]); w.z = cvt_pk_bf16(v1[0], v1[1]); w.w = cvt_pk_bf16(v1[2], v1[3]);
                    *(u32x4*)(rowp + 32 * bj) = w; }
            }
    }
};

struct EpiOut {
    static constexpr bool PERM = true, AFTER_DRAIN = false;
    float* xout; bf16_t* xb; float* ssq; int last;
    __device__ __forceinline__ void operator()(const f32x4 (&acc)[2][2][4][2], const Unit& u, int wr, int wc, int fr, int fq) const {
        const int row0 = u.pm * BM + wr * 64 + fr, colw = u.pn * BM + wc * 64 + 8 * fq;
#pragma unroll
        for (int ai = 0; ai < 2; ++ai)
#pragma unroll
            for (int m = 0; m < 4; ++m) {
                const int row = row0 + ai * HALF + m * 16; float ss = 0.f;
#pragma unroll
                for (int bj = 0; bj < 2; ++bj) { const size_t off = (size_t)row * 2048 + colw + 32 * bj;
                    const u32x4 xw = *(const u32x4*)(xb + off);
                    f32x4 v0, v1;
                    v0.x = __uint_as_float(xw.x << 16); v0.y = __uint_as_float(xw.x & 0xffff0000u); v0.z = __uint_as_float(xw.y << 16); v0.w = __uint_as_float(xw.y & 0xffff0000u);
                    v1.x = __uint_as_float(xw.z << 16); v1.y = __uint_as_float(xw.z & 0xffff0000u); v1.z = __uint_as_float(xw.w << 16); v1.w = __uint_as_float(xw.w & 0xffff0000u);
                    v0 = v0 + acc[ai][bj][m][0]; v1 = v1 + acc[ai][bj][m][1];
                    if (last) { f32x4* op = (f32x4*)(xout + off); op[0] = v0; op[1] = v1; }
                    else { u32x4 w; w.x = cvt_pk_bf16(v0[0], v0[1]); w.y = cvt_pk_bf16(v0[2], v0[3]); w.z = cvt_pk_bf16(v1[0], v1[1]); w.w = cvt_pk_bf16(v1[2], v1[3]);
                        *(u32x4*)(xb + off) = w;
                        const f32x4 q0 = v0 * v0, q1 = v1 * v1; ss += ((q0.x + q0.y) + (q0.z + q0.w)) + ((q1.x + q1.y) + (q1.z + q1.w)); } }
                if (!last) { ss += swz_xor<16>(ss); ss = xsum32(ss);
                    if (fq == 0) ssq[(size_t)row * 32 + u.pn * 4 + wc] = ss; }
            }
    }
};

template <class Epi, class Sched, bool ALIGN_EPI = false, bool SP2 = false>
__device__ __forceinline__ void gemm_phase(PG8_LAS unsigned char* lds, const Gemm g, const Sched& S, const Epi& E, int wv) {
    const int tid = opaque_tid(wv), wid = __builtin_amdgcn_readfirstlane(tid >> 6), lane = tid & 63, wr = wid >> 2, wc = wid & 3, fr = lane & 15, fq = lane >> 4;
    const int K = g.K, nt = K / BK;
    unsigned voffA[2], voffB[2];
#pragma unroll
    for (int i = 0; i < 2; ++i) { int R, C; stage_rc(tid * 16 + i * 8192, R, C); const int Rb = Epi::PERM ? ((R & ~31) + perm32(R & 31)) : R;
        voffA[i] = (unsigned)(R * K + C) * 2u; voffB[i] = (unsigned)(Rb * K + C) * 2u; }
    const size_t kstep = (size_t)(BK * 2);
    const size_t hstep = (size_t)HALF * K * 2;
    const size_t tstep = 2 * hstep;
    const unsigned ldsw = (unsigned)wid * 1024u;
    const int aoff = lds_byte(wr * 64 + fr, fq * 8), boff = lds_byte(wc * 32 + fr, fq * 8);
#define PG8_SA(b, h) (((b) * 2 + (h)) * HTB)
#define PG8_SB(b, h) ((4 + (b) * 2 + (h)) * HTB)
#define PG8_STAGE(bufoff, gbase, voff) do { _Pragma("unroll") for (int _i = 0; _i < 2; ++_i) \
        __builtin_amdgcn_global_load_lds((const unsigned*)((const char*)(gbase) + (voff)[_i]), (PG8_LAS unsigned*)(lds + (bufoff) + ldsw + _i * 8192), 16, 0, 0); } while (0)
#define PG8_LDA(dst, b, h) do { _Pragma("unroll") for (int m = 0; m < 4; ++m) _Pragma("unroll") for (int k = 0; k < 2; ++k) dst[m][k] = *(const PG8_LAS bf16x8*)(lds + PG8_SA(b, h) + aoff + m * 2048 + k * 1024); } while (0)
#define PG8_LDB(dst, b, h) do { _Pragma("unroll") for (int n = 0; n < 2; ++n) _Pragma("unroll") for (int k = 0; k < 2; ++k) dst[n][k] = *(const PG8_LAS bf16x8*)(lds + PG8_SB(b, h) + boff + n * 2048 + k * 1024); } while (0)
#define PG8_MMA(ai, bj, At, Bt) do { __builtin_amdgcn_s_setprio(1); _Pragma("unroll") for (int m = 0; m < 4; ++m) _Pragma("unroll") for (int n = 0; n < 2; ++n) _Pragma("unroll") for (int k = 0; k < 2; ++k) \
        acc[ai][bj][m][n] = __builtin_amdgcn_mfma_f32_16x16x32_bf16(Bt[n][k], At[m][k], acc[ai][bj][m][n], 0, 0, 0); __builtin_amdgcn_s_setprio(0); } while (0)
#define PG8_WAIT_V(n) asm volatile("s_waitcnt vmcnt(" #n ")" ::: "memory")
#define PG8_WAIT_L(n) asm volatile("s_waitcnt lgkmcnt(" #n ")" ::: "memory")
#define PG8_BAR __builtin_amdgcn_s_barrier()
#define PG8_SCHED __builtin_amdgcn_sched_barrier(0)
    Unit cur, nxt; int ui = 0;
    if (!S.next(0, cur)) return;
    f32x4 acc[2][2][4][2];
#pragma unroll
    for (int a = 0; a < 2; ++a)
#pragma unroll
        for (int b = 0; b < 2; ++b)
#pragma unroll
            for (int m = 0; m < 4; ++m)
#pragma unroll
                for (int n = 0; n < 2; ++n) acc[a][b][m][n] = (f32x4){0.f, 0.f, 0.f, 0.f};
    bf16x8 At[4][2], B0[2][2], B1[2][2];
    const char* cA = (const char*)g.A + (size_t)cur.pm * tstep; const char* cB = (const char*)g.Bt + (size_t)cur.pn * tstep;
    S.a_ready(cur);
    if constexpr (SP2) {
        PG8_STAGE(PG8_SB(0, 0), cB, voffB); PG8_STAGE(PG8_SB(0, 1), cB + hstep, voffB); PG8_STAGE(PG8_SA(0, 0), cA, voffA); PG8_STAGE(PG8_SA(0, 1), cA + hstep, voffA);
        if (wr == 1) PG8_BAR;
        PG8_WAIT_V(2); PG8_BAR;
        PG8_STAGE(PG8_SB(1, 0), cB + kstep, voffB); PG8_STAGE(PG8_SA(1, 0), cA + kstep, voffA); PG8_STAGE(PG8_SB(1, 1), cB + hstep + kstep, voffB);
        PG8_WAIT_V(6); PG8_BAR;
    } else {
        PG8_STAGE(PG8_SB(0, 0), cB, voffB); PG8_STAGE(PG8_SA(0, 0), cA, voffA); PG8_STAGE(PG8_SB(0, 1), cB + hstep, voffB); PG8_STAGE(PG8_SA(0, 1), cA + hstep, voffA);
        if (wr == 1) PG8_BAR;
        PG8_WAIT_V(4); PG8_BAR;
        PG8_STAGE(PG8_SB(1, 0), cB + kstep, voffB); PG8_STAGE(PG8_SA(1, 0), cA + kstep, voffA); PG8_STAGE(PG8_SB(1, 1), cB + hstep + kstep, voffB);
        PG8_WAIT_V(6); PG8_BAR;
    }
    for (;;) {
        const bool has_next = S.next(ui + 1, nxt);
        const char* nA = has_next ? (const char*)g.A + (size_t)nxt.pm * tstep : cA; const char* nB = has_next ? (const char*)g.Bt + (size_t)nxt.pn * tstep : cB;
        for (int t = 0; t < nt; t += 2) {
            const bool last = (t == nt - 2);
            const char* a1 = cA + (size_t)(t + 1) * kstep;
            const char* a2 = last ? nA : cA + (size_t)(t + 2) * kstep; const char* b2 = last ? nB : cB + (size_t)(t + 2) * kstep;
            const char* a3 = a2 + kstep; const char* b3 = b2 + kstep;
            if (last && has_next) S.a_ready(nxt);
            if constexpr (SP2) {
            PG8_LDB(B0, 0, 0); PG8_LDB(B1, 0, 1); PG8_SCHED; PG8_LDA(At, 0, 0); PG8_STAGE(PG8_SA(1, 1), a1 + hstep, voffA);
            PG8_WAIT_V(8); PG8_WAIT_L(0); PG8_BAR; PG8_MMA(0, 0, At, B0); PG8_MMA(0, 1, At, B1); PG8_BAR; PG8_SCHED;
            PG8_LDA(At, 0, 1); PG8_STAGE(PG8_SB(0, 0), b2, voffB); PG8_STAGE(PG8_SB(0, 1), b2 + hstep, voffB); PG8_STAGE(PG8_SA(0, 0), a2, voffA);
            PG8_WAIT_V(8); PG8_WAIT_L(0); PG8_BAR; PG8_MMA(1, 0, At, B0); PG8_MMA(1, 1, At, B1); PG8_BAR; PG8_SCHED;
            PG8_LDB(B0, 1, 0); PG8_LDB(B1, 1, 1); PG8_SCHED; PG8_LDA(At, 1, 0); PG8_STAGE(PG8_SA(0, 1), a2 + hstep, voffA);
            PG8_WAIT_V(8); PG8_WAIT_L(0); PG8_BAR; PG8_MMA(0, 0, At, B0); PG8_MMA(0, 1, At, B1); PG8_BAR; PG8_SCHED;
            PG8_LDA(At, 1, 1); PG8_STAGE(PG8_SB(1, 0), b3, voffB); PG8_STAGE(PG8_SB(1, 1), b3 + hstep, voffB); PG8_STAGE(PG8_SA(1, 0), a3, voffA);
            PG8_WAIT_V(8); PG8_WAIT_L(0); PG8_BAR; PG8_MMA(1, 0, At, B0); PG8_MMA(1, 1, At, B1); PG8_BAR; PG8_SCHED;
            } else {
            PG8_LDB(B0, 0, 0); PG8_SCHED; PG8_LDA(At, 0, 0); PG8_STAGE(PG8_SA(1, 1), a1 + hstep, voffA);
            PG8_WAIT_L(8); PG8_BAR; PG8_WAIT_L(0); PG8_MMA(0, 0, At, B0); PG8_BAR; PG8_SCHED;
            PG8_LDB(B1, 0, 1); PG8_STAGE(PG8_SB(0, 0), b2, voffB);
            PG8_BAR; PG8_WAIT_L(0); PG8_MMA(0, 1, At, B1); PG8_BAR;
            PG8_LDA(At, 0, 1); PG8_STAGE(PG8_SA(0, 0), a2, voffA);
            PG8_BAR; PG8_WAIT_L(0); PG8_MMA(1, 0, At, B0); PG8_BAR; PG8_SCHED;
            PG8_STAGE(PG8_SB(0, 1), b2 + hstep, voffB);
            PG8_WAIT_V(6); PG8_BAR; PG8_MMA(1, 1, At, B1); PG8_BAR;
            PG8_LDB(B0, 1, 0); PG8_SCHED; PG8_LDA(At, 1, 0); PG8_STAGE(PG8_SA(0, 1), a2 + hstep, voffA);
            PG8_WAIT_L(8); PG8_BAR; PG8_WAIT_L(0); PG8_MMA(0, 0, At, B0); PG8_BAR; PG8_SCHED;
            PG8_LDB(B1, 1, 1); PG8_STAGE(PG8_SB(1, 0), b3, voffB);
            PG8_BAR; PG8_WAIT_L(0); PG8_MMA(0, 1, At, B1); PG8_BAR;
            PG8_LDA(At, 1, 1); PG8_STAGE(PG8_SA(1, 0), a3, voffA);
            PG8_BAR; PG8_WAIT_L(0); PG8_MMA(1, 0, At, B0); PG8_BAR; PG8_SCHED;
            PG8_STAGE(PG8_SB(1, 1), b3 + hstep, voffB);
            PG8_WAIT_V(6); PG8_BAR; PG8_MMA(1, 1, At, B1); PG8_BAR;
            }
        }
        if constexpr (ALIGN_EPI) { if (wr == 0) PG8_BAR; }
        if constexpr (!Epi::AFTER_DRAIN) { E(acc, cur, wr, wc, fr, fq); S.done(cur); }
        if (!has_next) break;
#pragma unroll
        for (int a = 0; a < 2; ++a)
#pragma unroll
            for (int b = 0; b < 2; ++b)
#pragma unroll
                for (int m = 0; m < 4; ++m)
#pragma unroll
                    for (int n = 0; n < 2; ++n) acc[a][b][m][n] = (f32x4){0.f, 0.f, 0.f, 0.f};
        cur = nxt; cA = nA; cB = nB; ++ui;
        if constexpr (ALIGN_EPI) { if (wr == 1) PG8_BAR; }
    }
    PG8_WAIT_V(0);
    if constexpr (!ALIGN_EPI) { if (wr == 0) PG8_BAR; }
    PG8_BAR;
    if constexpr (Epi::AFTER_DRAIN) { E.fused(acc, cur, wr, wc, fr, fq, lds, wid, lane); S.done(cur); }
#undef PG8_SA
#undef PG8_SB
#undef PG8_STAGE
#undef PG8_LDA
#undef PG8_LDB
#undef PG8_MMA
#undef PG8_WAIT_V
#undef PG8_WAIT_L
#undef PG8_BAR
#undef PG8_SCHED
}
}

namespace att {
using bf16 = unsigned short;
using bf16x8 = __attribute__((ext_vector_type(8))) short;
using s16x4  = __attribute__((ext_vector_type(4))) short;
using f32x16 = __attribute__((ext_vector_type(16))) float;
using f32x4  = __attribute__((ext_vector_type(4))) float;
using u32x4  = __attribute__((ext_vector_type(4))) unsigned;
constexpr int KVBLK = 64;
constexpr int SHM_V = 64 * 128 * 2, SHM_K = 64 * 128 * 2;
#define KSWZ(row, colB) ((row) * 256 + ((colB) ^ (((row) & 7) << 4)))
#define SBAR() __builtin_amdgcn_sched_barrier(0)
__device__ __forceinline__ int crow(int r, int hi) { return (r & 3) + 8 * (r >> 2) + 4 * hi; }
typedef float f32x2_t __attribute__((ext_vector_type(2))); typedef __bf16 bf16x2_t __attribute__((ext_vector_type(2)));
__device__ __forceinline__ unsigned cvtpk(float lo, float hi) { f32x2_t v = {lo, hi}; bf16x2_t b = __builtin_convertvector(v, bf16x2_t); return __builtin_bit_cast(unsigned, b); }
__device__ __forceinline__ float bf2f(unsigned short h) { return __uint_as_float(((unsigned)h) << 16); }
__device__ __forceinline__ float wave_sum(float v) { v += swz_xor<1>(v); v += swz_xor<2>(v); v += swz_xor<4>(v); v += swz_xor<8>(v); v += swz_xor<16>(v); return xsum32(v); }
__device__ __forceinline__ float wave_max(float v) { v = fmaxf(v, swz_xor<1>(v)); v = fmaxf(v, swz_xor<2>(v)); v = fmaxf(v, swz_xor<4>(v)); v = fmaxf(v, swz_xor<8>(v)); v = fmaxf(v, swz_xor<16>(v)); return xmax32(v); }
__device__ __forceinline__ float uni(float x) { return __uint_as_float(__builtin_amdgcn_readfirstlane(__float_as_uint(x))); }
__device__ __forceinline__ int to_sgpr(int v) { asm volatile("" : "+v"(v)); return __builtin_amdgcn_readfirstlane(v); }
__device__ __forceinline__ float silu(float x) { return x / (1.0f + __expf(-x)); }

__device__ __forceinline__ int v_st(int k, int c) { const int kk = (k & ~0xC) | ((k & 4) << 1) | ((k & 8) >> 1); return ((kk >> 3) * 4 + (c >> 5)) * 512 + ((kk & 7) * 32 + (c & 31)) * 2; }
__device__ __forceinline__ int v_rd_base(int lane) { return ((lane & 3) << 3) | (((lane >> 2) & 3) << 6) | (((lane >> 4) & 1) << 5) | (((lane >> 5) & 1) << 8); }
constexpr int v_rd_off(int d0, int ks, int half) { return d0 * 512 + ks * 4096 + half * 2048; }
template <int OFF> __device__ __forceinline__ s16x4 tr_read(int vb) {
    s16x4 r; asm volatile("ds_read_b64_tr_b16 %0, %1 offset:%2" : "=&v"(r) : "v"(vb), "i"(OFF) : "memory"); return r;
}
template <int D0> __device__ __forceinline__ void pv_one(f32x16& od, int vb, bf16x8 pa0, bf16x8 pa1, bf16x8 pa2, bf16x8 pa3) {
    const s16x4 l0 = tr_read<v_rd_off(D0, 0, 0)>(vb), h0 = tr_read<v_rd_off(D0, 0, 1)>(vb), l1 = tr_read<v_rd_off(D0, 1, 0)>(vb), h1 = tr_read<v_rd_off(D0, 1, 1)>(vb);
    const s16x4 l2 = tr_read<v_rd_off(D0, 2, 0)>(vb), h2 = tr_read<v_rd_off(D0, 2, 1)>(vb), l3 = tr_read<v_rd_off(D0, 3, 0)>(vb), h3 = tr_read<v_rd_off(D0, 3, 1)>(vb);
    asm volatile("s_waitcnt lgkmcnt(0)" ::: "memory"); SBAR();
#define PK(L, H) (bf16x8){L[0], L[1], L[2], L[3], H[0], H[1], H[2], H[3]}
    od = __builtin_amdgcn_mfma_f32_32x32x16_bf16(pa0, PK(l0, h0), od, 0, 0, 0);
    od = __builtin_amdgcn_mfma_f32_32x32x16_bf16(pa1, PK(l1, h1), od, 0, 0, 0);
    od = __builtin_amdgcn_mfma_f32_32x32x16_bf16(pa2, PK(l2, h2), od, 0, 0, 0);
    od = __builtin_amdgcn_mfma_f32_32x32x16_bf16(pa3, PK(l3, h3), od, 0, 0, 0);
#undef PK
}
template <int KS> __device__ __forceinline__ void pv_ks(f32x16* o, int vb, bf16x8 pa) {
    const s16x4 l0 = tr_read<v_rd_off(0, KS, 0)>(vb), h0 = tr_read<v_rd_off(0, KS, 1)>(vb), l1 = tr_read<v_rd_off(1, KS, 0)>(vb), h1 = tr_read<v_rd_off(1, KS, 1)>(vb);
    const s16x4 l2 = tr_read<v_rd_off(2, KS, 0)>(vb), h2 = tr_read<v_rd_off(2, KS, 1)>(vb), l3 = tr_read<v_rd_off(3, KS, 0)>(vb), h3 = tr_read<v_rd_off(3, KS, 1)>(vb);
#define PK(L, H) (bf16x8){L[0], L[1], L[2], L[3], H[0], H[1], H[2], H[3]}
    asm volatile("s_waitcnt lgkmcnt(6)" ::: "memory"); SBAR();
    o[0] = __builtin_amdgcn_mfma_f32_32x32x16_bf16(pa, PK(l0, h0), o[0], 0, 0, 0);
    asm volatile("s_waitcnt lgkmcnt(4)" ::: "memory"); SBAR();
    o[1] = __builtin_amdgcn_mfma_f32_32x32x16_bf16(pa, PK(l1, h1), o[1], 0, 0, 0);
    asm volatile("s_waitcnt lgkmcnt(2)" ::: "memory"); SBAR();
    o[2] = __builtin_amdgcn_mfma_f32_32x32x16_bf16(pa, PK(l2, h2), o[2], 0, 0, 0);
    asm volatile("s_waitcnt lgkmcnt(0)" ::: "memory"); SBAR();
    o[3] = __builtin_amdgcn_mfma_f32_32x32x16_bf16(pa, PK(l3, h3), o[3], 0, 0, 0);
#undef PK
}
__device__ __forceinline__ void pv_d0(f32x16* o, int vb, bf16x8 pa0, bf16x8 pa1, bf16x8 pa2, bf16x8 pa3) {
    pv_ks<0>(o, vb, pa0); pv_ks<1>(o, vb, pa1); pv_ks<2>(o, vb, pa2); pv_ks<3>(o, vb, pa3);
}
__device__ __forceinline__ void exp_half(f32x16& p) {
#pragma unroll
    for (int r = 0; r < 16; ++r) p[r] = __builtin_amdgcn_exp2f(p[r]);
}
__device__ __forceinline__ void pack_p(const f32x16& p0, const f32x16& p1, float& l_reg, bf16x8& pa0, bf16x8& pa1, bf16x8& pa2, bf16x8& pa3) {
    float ps = 0;
#pragma unroll
    for (int r = 0; r < 16; ++r) ps += p0[r];
#pragma unroll
    for (int r = 0; r < 16; ++r) ps += p1[r];
    l_reg += ps;
#define PK4(P, BASE, OUT) do { unsigned a0 = cvtpk(P[BASE + 0], P[BASE + 1]), a1 = cvtpk(P[BASE + 2], P[BASE + 3]);   \
    unsigned b0 = cvtpk(P[BASE + 4], P[BASE + 5]), b1 = cvtpk(P[BASE + 6], P[BASE + 7]);                              \
    auto r0 = __builtin_amdgcn_permlane32_swap(a0, b0, false, false); auto r1 = __builtin_amdgcn_permlane32_swap(a1, b1, false, false); \
    u32x4 w = {r0[0], r1[0], r0[1], r1[1]}; OUT = *reinterpret_cast<bf16x8*>(&w); } while (0)
    PK4(p0, 0, pa0); PK4(p0, 8, pa1); PK4(p1, 0, pa2); PK4(p1, 8, pa3);
#undef PK4
}
template <int ND0> __device__ __forceinline__ void qkt(f32x16& p0, f32x16& p1, const char* Ks, const bf16x8* qr, int r32, int hi, int colB0) {
#pragma unroll
    for (int d0 = 0; d0 < ND0; ++d0) { const int cb = colB0 + (d0 * 16 + hi * 8) * 2;
        const bf16x8 b0 = *reinterpret_cast<const bf16x8*>(Ks + KSWZ(r32, cb));
        const bf16x8 b1 = *reinterpret_cast<const bf16x8*>(Ks + KSWZ(32 + r32, cb));
        p0 = __builtin_amdgcn_mfma_f32_32x32x16_bf16(b0, qr[d0], p0, 0, 0, 0);
        p1 = __builtin_amdgcn_mfma_f32_32x32x16_bf16(b1, qr[d0], p1, 0, 0, 0); }
}
__device__ __forceinline__ void bias_init(f32x16& p0, f32x16& p1, float base, float nslope2, float nM2, int rel  ) {
    if (rel <= -63 || rel >= 31) {
        const float sg = (rel < 0) ? -nslope2 : nslope2, lbv = fmaf(-sg, base, nM2);
#pragma unroll
        for (int r = 0; r < 16; ++r) { p0[r] = fmaf((float)((r & 3) + 8 * (r >> 2)), sg, lbv); p1[r] = fmaf((float)((r & 3) + 8 * (r >> 2) + 32), sg, lbv); }
    } else {
#pragma unroll
        for (int r = 0; r < 16; ++r) { const float d = base - (float)((r & 3) + 8 * (r >> 2));
            p0[r] = fmaf(fabsf(d), nslope2, nM2); p1[r] = fmaf(fabsf(d - 32.f), nslope2, nM2); }
    }
}

struct DiffArgs { const bf16* proj; bf16* y; const float* ghead; int nM2b, lamb, laminitb; };

__device__ __forceinline__ void diff_unit(const DiffArgs& A, int b, int h, int qb, char* lds, int wv) {
    const int tid = opaque_tid(wv), wid = __builtin_amdgcn_readfirstlane(tid >> 6), lane = tid & 63, r32 = lane & 31, hi = lane >> 5, c = wid >> 2, wq = wid & 3;
    const char* Pb = (const char*)A.proj + ((size_t)b * SEQ * INC + h * 128) * 2;
    char* V_lds = lds; char* K_lds = lds + 4 * SHM_V;
    float* wsl = (float*)(lds + 131072) + wid * 64;
    int t_lo, nt; float nM2, lam, lam_init;
    { int a_ = A.nM2b, b_ = A.lamb, c_ = A.laminitb;
      asm volatile("" : "+s"(a_), "+s"(b_), "+s"(c_)); nM2 = __int_as_float(a_); lam = __int_as_float(b_); lam_init = __int_as_float(c_); }
    const float slope = exp2f(-8.0f * (float)(h + 1) / 6.0f);
    const float nslope2 = uni(-slope * LOG2E);
    { const float Df = (151.0f + 2.0f * (-nM2)) / (-nslope2); const int Dk = Df > 20000.f ? 20000 : (int)Df + 1; const int i0 = qb * 128;
      int lo_ = i0 - Dk + 1; lo_ = lo_ > 0 ? (lo_ >> 6) : 0; int hi_ = (i0 + 126 + Dk) >> 6; hi_ = hi_ > SEQ / KVBLK - 1 ? SEQ / KVBLK - 1 : hi_;
      if (((hi_ - lo_ + 1) & 1) != 0) { if (lo_ > 0) --lo_; else ++hi_; }
      t_lo = __builtin_amdgcn_readfirstlane(lo_); nt = __builtin_amdgcn_readfirstlane(hi_ - lo_ + 1); }
    const int ipos = qb * 128 + wq * 32 + r32;
    float l_reg = 0; f32x16 o[4] = {}; bf16x8 qr[4];
    { const char* Qw = Pb + (size_t)(qb * 128 + wq * 32) * (INC * 2) + (C_DQ + c * 64) * 2; const unsigned qoff = (unsigned)((r32 * INC + hi * 8) * 2);
#pragma unroll
      for (int d0 = 0; d0 < 4; ++d0) qr[d0] = *reinterpret_cast<const bf16x8*>(Qw + qoff + d0 * 32); }
    const int colB0 = c * 128;
    const int krow = wid * 4 + (lane >> 4), kcc = (lane & 15) ^ (krow & 7);
    const unsigned koff = (unsigned)((krow * INC + kcc * 8) * 2);
    const int vkey = (wid >> 2) * 16 + (((lane >> 4) & 1) << 3) + (((wid >> 1) & 1) << 2) + ((lane >> 2) & 3), vcol = ((wid & 1) * 2 + (lane >> 5)) * 32 + (lane & 3) * 8;
    const unsigned voff = (unsigned)((vkey * INC + vcol) * 2 + (C_DV - C_DK) * 2);
    const int vb0 = (int)(uintptr_t)V_lds + v_rd_base(lane);
    const char* Pk = Pb + (size_t)(t_lo * KVBLK) * (INC * 2) + C_DK * 2; int iposk = ipos - t_lo * KVBLK - 4 * hi; asm volatile("" : "+v"(iposk));     const int relw = t_lo * KVBLK - (qb * 128 + wq * 32);
    typedef __attribute__((address_space(3))) unsigned lds_u32;
    __attribute__((address_space(3))) unsigned char* ldsA = (__attribute__((address_space(3))) unsigned char*)lds + wid * 1024;
#define GLDS(gp, lp) __builtin_amdgcn_global_load_lds((const unsigned*)(gp), (lds_u32*)(lp), 16, 0, 0)
#define STAGE(t) do { const char* kt_ = Pk + (size_t)((t) * KVBLK) * (INC * 2); const int so_ = ((t) & 3) * SHM_K; \
    GLDS(kt_ + koff, ldsA + 4 * SHM_V + so_); GLDS(kt_ + 32 * INC * 2 + koff, ldsA + 4 * SHM_V + so_ + 8192); \
    GLDS(kt_ + voff, ldsA + so_); GLDS(kt_ + 32 * INC * 2 + voff, ldsA + so_ + 8192); } while (0)
#define SLOT(t) (((t) & 3) * SHM_K)
#define ENDI() do { asm volatile("s_waitcnt vmcnt(0)" ::: "memory"); __syncthreads(); } while (0)
#define BIAS(P0, P1, t) bias_init(P0, P1, (float)(iposk - (t) * KVBLK), nslope2, nM2, relw + (t) * KVBLK)
    f32x16 pA0, pA1, pB0, pB1; bf16x8 pa0, pa1, pa2, pa3; const int NT = nt;
    STAGE(0); ENDI();
    STAGE(1);
    BIAS(pA0, pA1, 0); qkt<4>(pA0, pA1, K_lds, qr, r32, hi, colB0);
#if DIFF_ANTIPHASE
    if (c == 0) {
#endif
        const int lp_ = opaque_tid(wv) & 63, r32p = lp_ & 31, hip = lp_ >> 5;
        exp_half(pA0);
        ENDI();
#pragma unroll 1
        for (int j = 1; j + 1 < NT; j += 2) {
            STAGE(j + 1);
            SBAR(); BIAS(pB0, pB1, j); qkt<4>(pB0, pB1, K_lds + SLOT(j), qr, r32p, hip, colB0);
            exp_half(pA1); pack_p(pA0, pA1, l_reg, pa0, pa1, pa2, pa3); SBAR();
            pv_d0(o, vb0 + SLOT(j - 1), pa0, pa1, pa2, pa3); exp_half(pB0);
            ENDI();
            STAGE(j + 2);
            SBAR(); BIAS(pA0, pA1, j + 1); qkt<4>(pA0, pA1, K_lds + SLOT(j + 1), qr, r32p, hip, colB0);
            exp_half(pB1); pack_p(pB0, pB1, l_reg, pa0, pa1, pa2, pa3); SBAR();
            pv_d0(o, vb0 + SLOT(j), pa0, pa1, pa2, pa3); exp_half(pA0);
            ENDI();
        }
        { const int lt_ = opaque_tid(wv) & 63;
          SBAR(); BIAS(pB0, pB1, NT - 1); qkt<4>(pB0, pB1, K_lds + SLOT(NT - 1), qr, lt_ & 31, lt_ >> 5, colB0); }
        exp_half(pA1); pack_p(pA0, pA1, l_reg, pa0, pa1, pa2, pa3); SBAR();
        pv_d0(o, vb0 + SLOT(NT - 2), pa0, pa1, pa2, pa3); exp_half(pB0);
        exp_half(pB1); pack_p(pB0, pB1, l_reg, pa0, pa1, pa2, pa3); SBAR();
        pv_d0(o, vb0 + SLOT(NT - 1), pa0, pa1, pa2, pa3);
#if DIFF_ANTIPHASE
    } else {
        const int lp_ = opaque_tid(wv) & 63, r32p = lp_ & 31, hip = lp_ >> 5;
        pa0 = bf16x8{}; pa1 = bf16x8{}; pa2 = bf16x8{}; pa3 = bf16x8{};
        ENDI();
#pragma unroll 1
        for (int j = 1; j + 1 < NT; j += 2) {
            STAGE(j + 1);
            SBAR(); pv_d0(o, vb0 + (j > 1 ? SLOT(j - 2) : 0), pa0, pa1, pa2, pa3);
            exp_half(pA0); SBAR();
            BIAS(pB0, pB1, j); qkt<4>(pB0, pB1, K_lds + SLOT(j), qr, r32p, hip, colB0);
            exp_half(pA1); pack_p(pA0, pA1, l_reg, pa0, pa1, pa2, pa3); SBAR();
            ENDI();
            STAGE(j + 2);
            SBAR(); pv_d0(o, vb0 + SLOT(j - 1), pa0, pa1, pa2, pa3);
            exp_half(pB0); SBAR();
            BIAS(pA0, pA1, j + 1); qkt<4>(pA0, pA1, K_lds + SLOT(j + 1), qr, r32p, hip, colB0);
            exp_half(pB1); pack_p(pB0, pB1, l_reg, pa0, pa1, pa2, pa3); SBAR();
            ENDI();
        }
        SBAR(); pv_d0(o, vb0 + SLOT(NT - 3), pa0, pa1, pa2, pa3);
        exp_half(pA0); SBAR();
        { const int lt_ = opaque_tid(wv) & 63;
          BIAS(pB0, pB1, NT - 1); qkt<4>(pB0, pB1, K_lds + SLOT(NT - 1), qr, lt_ & 31, lt_ >> 5, colB0); }
        exp_half(pA1); pack_p(pA0, pA1, l_reg, pa0, pa1, pa2, pa3); SBAR();
        pv_d0(o, vb0 + SLOT(NT - 2), pa0, pa1, pa2, pa3);
        exp_half(pB0); exp_half(pB1); pack_p(pB0, pB1, l_reg, pa0, pa1, pa2, pa3); SBAR();
        pv_d0(o, vb0 + SLOT(NT - 1), pa0, pa1, pa2, pa3);
    }
#endif
#undef GLDS
#undef STAGE
#undef SLOT
#undef ENDI
#undef BIAS
    { auto rr = __builtin_amdgcn_permlane32_swap(__float_as_uint(l_reg), __float_as_uint(l_reg), false, false);
      l_reg = __uint_as_float(rr[0]) + __uint_as_float(rr[1]); }
    const int tid_e = opaque_tid(wv), lane_e = tid_e & 63;
#define tid tid_e
#define r32 (lane_e & 31)
#define hi (lane_e >> 5)
    if (hi == 0) wsl[r32] = l_reg;
    asm volatile("s_waitcnt lgkmcnt(0)" ::: "memory");
    float rli[16];
#pragma unroll
    for (int r = 0; r < 16; ++r) rli[r] = (c ? lam : 1.0f) / wsl[crow(r, hi)];
    __syncthreads();
    float* OS = (float*)lds;
    if (c == 1) {
#pragma unroll
        for (int r = 0; r < 16; ++r) { float* orow = OS + (wq * 32 + crow(r, hi)) * 132 + r32;
#pragma unroll
            for (int d0 = 0; d0 < 4; ++d0) orow[d0 * 32] = o[d0][r] * rli[r]; }
    }
    __syncthreads();
    if (c == 0) {
#pragma unroll
        for (int r = 0; r < 16; ++r) { float* orow = OS + (wq * 32 + crow(r, hi)) * 132 + r32;
#pragma unroll
            for (int d0 = 0; d0 < 4; ++d0) orow[d0 * 32] = o[d0][r] * rli[r] - orow[d0 * 32]; }
    }
    __syncthreads();
    { const int row = tid >> 2, cq = tid & 3; const float* src = OS + row * 132 + cq * 32;
      f32x4 v[8]; float ss = 0.f;
#pragma unroll
      for (int i = 0; i < 8; ++i) { v[i] = *(const f32x4*)(src + 4 * i); const f32x4 q = v[i] * v[i]; ss += (q.x + q.y) + (q.z + q.w); }
      ss += swz_xor<1>(ss); ss += swz_xor<2>(ss);
      const float rn = (1.0f - lam_init) / sqrtf(ss * (1.0f / 128.0f) + EPS);
      const bf16* gp = (const bf16*)(Pb + (size_t)(qb * 128) * (INC * 2) + C_DG * 2 + (unsigned)((row * INC + cq * 32) * 2));
      bf16* yp = (bf16*)((char*)A.y + ((size_t)(b * SEQ + qb * 128) * DM + Y_D + h * 128) * 2 + (unsigned)((row * DM + cq * 32) * 2)); const float* gh = A.ghead + cq * 32;
#pragma unroll
      for (int i = 0; i < 4; ++i) { const bf16x8 g8 = *reinterpret_cast<const bf16x8*>(gp + 8 * i); const f32x4 h0 = *(const f32x4*)(gh + 8 * i), h1 = *(const f32x4*)(gh + 8 * i + 4);
          const f32x4 a = v[2 * i] * h0 * rn, bq = v[2 * i + 1] * h1 * rn;
          u32x4 w; w.x = cvtpk(a.x * silu(bf2f(g8[0])), a.y * silu(bf2f(g8[1]))); w.y = cvtpk(a.z * silu(bf2f(g8[2])), a.w * silu(bf2f(g8[3])));
          w.z = cvtpk(bq.x * silu(bf2f(g8[4])), bq.y * silu(bf2f(g8[5]))); w.w = cvtpk(bq.z * silu(bf2f(g8[6])), bq.w * silu(bf2f(g8[7])));
          *(u32x4*)(yp + 8 * i) = w; } }
    __syncthreads();
#undef tid
#undef r32
#undef hi
}

__device__ __forceinline__ int next_item(unsigned* ctr, char* lds, int tid) {
    int* slot = (int*)(lds + 131072 + 3072);
    if (tid == 0) *slot = (int)atomicAdd(ctr, 1u);
    __syncthreads();
    return __builtin_amdgcn_readfirstlane(*slot);
}

struct MemArgs { const bf16* proj; const bf16* mkv; bf16* y; const float* gmq; const float* gmk; int layer; };
__device__ __forceinline__ void mem_unit(const MemArgs& A, int unit, char* lds, int wv) {
    const int tid = opaque_tid(wv), wid = __builtin_amdgcn_readfirstlane(tid >> 6), lane = tid & 63, r32 = lane & 31, hi = lane >> 5;
    const int b = unit / (4 * 32), hm = (unit / 32) % 4, qb = unit % 32;
    const bf16* Kh = A.mkv + (size_t)b * NMEM * MKVC + A.layer * 1024 + hm * 128;
    const bf16* Vh = Kh + 512;
    char* V_lds = lds; char* K_lds = lds + 4 * SHM_V;
    float* wsl = (float*)(lds + 131072) + wid * 64;
    float nM2;
    { const float a = wave_max(fmaxf(fabsf(A.gmq[lane]), fabsf(A.gmq[lane + 64]))), bb = wave_max(fmaxf(fabsf(A.gmk[lane]), fabsf(A.gmk[lane + 64])));
      nM2 = -(11.3137085f * a * bb * LOG2E * 1.03f + 0.25f); }
    { const int sr = tid >> 4, sc = (tid & 15) * 8, kc = sc * 2;
      const f32x4 g0 = *(const f32x4*)(A.gmk + sc), g1 = *(const f32x4*)(A.gmk + sc + 4);
#pragma unroll
      for (int t = 0; t < 4; ++t)
#pragma unroll
        for (int hh = 0; hh < 2; ++hh) { const int key = t * 64 + hh * 32 + sr;
          const bf16x8 v8 = *reinterpret_cast<const bf16x8*>(&Vh[(size_t)key * MKVC + sc]); const bf16x8 k8 = *reinterpret_cast<const bf16x8*>(&Kh[(size_t)key * MKVC + sc]);
          float f[8]; float ss = 0.f;
#pragma unroll
          for (int i = 0; i < 8; ++i) { f[i] = bf2f((unsigned short)k8[i]); ss += f[i] * f[i]; }
          ss += swz_xor<1>(ss); ss += swz_xor<2>(ss); ss += swz_xor<4>(ss); ss += swz_xor<8>(ss);
          const float rn = 1.0f / sqrtf(ss * (1.0f / 128.0f) + EPS);
          u32x4 w; w.x = cvtpk(f[0] * rn * g0.x, f[1] * rn * g0.y); w.y = cvtpk(f[2] * rn * g0.z, f[3] * rn * g0.w); w.z = cvtpk(f[4] * rn * g1.x, f[5] * rn * g1.y); w.w = cvtpk(f[6] * rn * g1.z, f[7] * rn * g1.w);
          *(u32x4*)(K_lds + t * SHM_K + KSWZ(hh * 32 + sr, kc)) = w;
          *(bf16x8*)(V_lds + t * SHM_V + v_st(hh * 32 + sr, sc)) = v8; } }
    bf16x8 qr[8];
    const size_t grow0 = (size_t)b * SEQ + qb * 256 + wid * 32;
    { const bf16* Qw = A.proj + (grow0 + r32) * INC + C_MQ + hm * 128 + hi * 8;
      bf16x8 raw[8]; float ss = 0.f;
#pragma unroll
      for (int d0 = 0; d0 < 8; ++d0) { raw[d0] = *reinterpret_cast<const bf16x8*>(Qw + d0 * 16);
#pragma unroll
          for (int i = 0; i < 8; ++i) { const float f = bf2f((unsigned short)raw[d0][i]); ss += f * f; } }
      { auto rr = __builtin_amdgcn_permlane32_swap(__float_as_uint(ss), __float_as_uint(ss), false, false); ss = __uint_as_float(rr[0]) + __uint_as_float(rr[1]); }
      const float rn = QSCALE_M / sqrtf(ss * (1.0f / 128.0f) + EPS);
#pragma unroll
      for (int d0 = 0; d0 < 8; ++d0) { const f32x4 g0 = *(const f32x4*)(A.gmq + d0 * 16 + hi * 8), g1 = *(const f32x4*)(A.gmq + d0 * 16 + hi * 8 + 4);
          u32x4 w; w.x = cvtpk(bf2f((unsigned short)raw[d0][0]) * rn * g0.x, bf2f((unsigned short)raw[d0][1]) * rn * g0.y); w.y = cvtpk(bf2f((unsigned short)raw[d0][2]) * rn * g0.z, bf2f((unsigned short)raw[d0][3]) * rn * g0.w);
          w.z = cvtpk(bf2f((unsigned short)raw[d0][4]) * rn * g1.x, bf2f((unsigned short)raw[d0][5]) * rn * g1.y); w.w = cvtpk(bf2f((unsigned short)raw[d0][6]) * rn * g1.z, bf2f((unsigned short)raw[d0][7]) * rn * g1.w);
          qr[d0] = *reinterpret_cast<bf16x8*>(&w); } }
    __syncthreads();
    float l_reg = 0; f32x16 o[4] = {};
    const int vb0 = (int)(uintptr_t)V_lds + v_rd_base(lane);
#pragma unroll 1
    for (int t = 0; t < 4; ++t) {
        f32x16 p0, p1; bf16x8 pa0, pa1, pa2, pa3;
#pragma unroll
        for (int r = 0; r < 16; ++r) { p0[r] = nM2; p1[r] = nM2; }
        qkt<8>(p0, p1, K_lds + t * SHM_K, qr, r32, hi, 0);
        exp_half(p0); exp_half(p1); pack_p(p0, p1, l_reg, pa0, pa1, pa2, pa3); SBAR();
        pv_d0(o, vb0 + t * SHM_V, pa0, pa1, pa2, pa3);
    }
    { auto rr = __builtin_amdgcn_permlane32_swap(__float_as_uint(l_reg), __float_as_uint(l_reg), false, false);
      l_reg = __uint_as_float(rr[0]) + __uint_as_float(rr[1]); }
    if (hi == 0) wsl[r32] = l_reg;
    asm volatile("s_waitcnt lgkmcnt(0)" ::: "memory");
#pragma unroll
    for (int r = 0; r < 16; ++r) { const int rr_ = crow(r, hi); const float rl = 1.0f / wsl[rr_];
        const bf16* gp = A.proj + (grow0 + rr_) * INC + C_MG + hm * 128 + r32; bf16* yp = A.y + (grow0 + rr_) * DM + Y_M + hm * 128 + r32;
#pragma unroll
        for (int d0 = 0; d0 < 4; ++d0) { const float g = bf2f(gp[d0 * 32]); const float val = o[d0][r] * rl * silu(g);
            yp[d0 * 32] = (bf16)(cvtpk(val, val) & 0xffffu); } }
    __syncthreads();
}

struct ConvArgs { const bf16* proj; bf16* y; const float* w; const float* bias; };
__device__ __forceinline__ void conv_items(const ConvArgs& A, long first, long stride) {
    constexpr long NIT = (long)(MTOK / 4) * 96;
    for (long it = first; it < NIT; it += stride) {
        const int row0 = (int)(it / 96) * 4, c8 = (int)(it % 96) * 8, t0 = row0 & (SEQ - 1);
        const bf16* p = A.proj + (size_t)row0 * INC + c8;
        bf16x8 xr[6], cr[6], br[4], gr[4];
#pragma unroll
        for (int i = 0; i < 6; ++i) { const int t = t0 - 1 + i; const bool ok = (t >= 0) && (t < SEQ);
            xr[i] = ok ? *reinterpret_cast<const bf16x8*>(p + (long)(i - 1) * INC + C_AX) : bf16x8{}; cr[i] = ok ? *reinterpret_cast<const bf16x8*>(p + (long)(i - 1) * INC + C_AC) : bf16x8{}; }
#pragma unroll
        for (int i = 0; i < 4; ++i) { br[i] = *reinterpret_cast<const bf16x8*>(p + (long)i * INC + C_AB); gr[i] = *reinterpret_cast<const bf16x8*>(p + (long)i * INC + C_AG); }
        float w0[8], w1[8], w2[8], bb[8];
#pragma unroll
        for (int i = 0; i < 2; ++i) { const f32x4 a = *(const f32x4*)(A.w + c8 + 4 * i), bq = *(const f32x4*)(A.w + 768 + c8 + 4 * i), cc = *(const f32x4*)(A.w + 1536 + c8 + 4 * i), dd = *(const f32x4*)(A.bias + c8 + 4 * i);
#pragma unroll
            for (int k = 0; k < 4; ++k) { w0[4 * i + k] = a[k]; w1[4 * i + k] = bq[k]; w2[4 * i + k] = cc[k]; bb[4 * i + k] = dd[k]; } }
        float u[6][8];
#pragma unroll
        for (int i = 0; i < 6; ++i)
#pragma unroll
            for (int k = 0; k < 8; ++k) u[i][k] = bf2f((unsigned short)cr[i][k]) * bf2f((unsigned short)xr[i][k]);
#pragma unroll
        for (int j = 0; j < 4; ++j) { float out[8];
#pragma unroll
            for (int k = 0; k < 8; ++k) { const float z = u[j][k] * w0[k] + u[j + 1][k] * w1[k] + u[j + 2][k] * w2[k] + bb[k];
                out[k] = bf2f((unsigned short)br[j][k]) * z * silu(bf2f((unsigned short)gr[j][k])); }
            u32x4 w; w.x = cvtpk(out[0], out[1]); w.y = cvtpk(out[2], out[3]); w.z = cvtpk(out[4], out[5]); w.w = cvtpk(out[6], out[7]);
            *(u32x4*)(A.y + (size_t)(row0 + j) * DM + Y_A + c8) = w; }
    }
}
}

using att::bf16;
typedef float f32x4_t __attribute__((ext_vector_type(4)));
typedef unsigned u32x4_t __attribute__((ext_vector_type(4)));
typedef unsigned u32x2_t __attribute__((ext_vector_type(2)));

__device__ __forceinline__ void transpose_item(const float* __restrict__ W, int K, int N, const float* __restrict__ gain, bf16* __restrict__ WT, float* scr, int item, int lane) {
    const int nblk = N / 32, kb = item / nblk, nb = item % nblk, k0 = 64 * kb, n0 = 32 * nb;
    float wv_[32], gv_[32];
    const float* wp_ = W + (size_t)(k0 + (lane >> 5)) * N + n0 + (lane & 31);
#pragma unroll
    for (int i = 0; i < 32; ++i) { wv_[i] = wp_[(size_t)(2 * i) * N]; gv_[i] = gain ? gain[k0 + 2 * i + (lane >> 5)] : 1.0f; }
#pragma unroll
    for (int i = 0; i < 32; ++i) scr[(2 * i + (lane >> 5)) * 33 + (lane & 31)] = wv_[i] * gv_[i];
    __builtin_amdgcn_s_waitcnt(0xc07f); asm volatile("s_waitcnt lgkmcnt(0)" ::: "memory");
    const int g8 = (n0 & 255) >> 5, n0p = (n0 & ~255) + 128 * (g8 & 1) + 32 * (g8 >> 1);
    const int c = lane & 7;
#pragma unroll
    for (int j = 0; j < 4; ++j) { const int n = (lane >> 3) + 8 * j; const float* s = scr + (8 * c) * 33 + n;
        u32x4_t o; o.x = pg8::cvt_pk_bf16(s[0 * 33], s[1 * 33]); o.y = pg8::cvt_pk_bf16(s[2 * 33], s[3 * 33]); o.z = pg8::cvt_pk_bf16(s[4 * 33], s[5 * 33]); o.w = pg8::cvt_pk_bf16(s[6 * 33], s[7 * 33]);
        *(u32x4_t*)(WT + (size_t)(n0p + n) * K + k0 + 8 * c) = o; }
    asm volatile("s_waitcnt lgkmcnt(0)" ::: "memory");
}
__device__ __forceinline__ void row_to_bf16(const float* __restrict__ xrow, bf16* __restrict__ orow, float* __restrict__ ssrow, int lane) {
    const f32x4_t* xr = (const f32x4_t*)xrow + lane; f32x4_t v[8]; float s = 0.f;
#pragma unroll
    for (int j = 0; j < 8; ++j) { v[j] = xr[64 * j]; s += (v[j].x * v[j].x + v[j].y * v[j].y) + (v[j].z * v[j].z + v[j].w * v[j].w); }
    s = att::wave_sum(s);
    u32x2_t* o8 = (u32x2_t*)orow + lane;
#pragma unroll
    for (int j = 0; j < 8; ++j) { u32x2_t w; w.x = pg8::cvt_pk_bf16(v[j].x, v[j].y); w.y = pg8::cvt_pk_bf16(v[j].z, v[j].w); o8[64 * j] = w; }
    if (lane < 32) ssrow[lane] = (lane == 0) ? s : 0.f;
}


#define XB_TMO      128
#define XB_XCNT(j)  (256  + 64 * (j))
#define XB_XSUB(j)  (1280 + 64 * (j))
#define XB_XGEN(j)  (2304 + 64 * (j))
#define XB_TOP      3328
#define XB_TOPGEN   3392
#define XCD_BAR_WORDS 3456
#define XB_SPIN_CAP (1u << 18)
#define LAS __attribute__((address_space(3)))

__device__ __forceinline__ unsigned xb_ld(unsigned* p)              { return __hip_atomic_load(p, __ATOMIC_RELAXED, __HIP_MEMORY_SCOPE_AGENT); }
__device__ __forceinline__ unsigned xb_add(unsigned* p, unsigned v) { return __hip_atomic_fetch_add(p, v, __ATOMIC_RELAXED, __HIP_MEMORY_SCOPE_AGENT); }
__device__ __forceinline__ unsigned xb_xcc_id() { return (unsigned)__builtin_amdgcn_s_getreg((3 << 11) | 20) & 0xFu; }
#define XB_SPIN(cond, bar) do { unsigned _sp = 0; while (cond) { __builtin_amdgcn_s_sleep(1); \
    if ((++_sp & 255u) == 0u) { if (xb_ld(&(bar)[XB_TMO])) break; if (_sp > XB_SPIN_CAP) { atomicAdd(&(bar)[XB_TMO], 1u); break; } } } } while (0)

struct XcdBarrier {
    unsigned* bar; unsigned x;
    volatile LAS unsigned* st;
};

__device__ __forceinline__ XcdBarrier xcd_barrier_post(unsigned* bar, volatile LAS unsigned* st) {
    XcdBarrier b; b.bar = bar; b.x = xb_xcc_id(); b.st = st;
    if (threadIdx.x == 0) (void)xb_add(&bar[XB_XCNT(b.x)], 1u);
    return b;
}
__device__ __forceinline__ void xcd_barrier_complete(unsigned* bar, unsigned x, unsigned& nloc, unsigned& nx) {
    const unsigned G = gridDim.x * gridDim.y * gridDim.z;
    unsigned sum, cnt, mine, sp = 0u;
    for (;;) {
        sum = 0u; cnt = 0u; mine = 0u;
#pragma unroll
        for (unsigned j = 0; j < 16; ++j) { const unsigned c = xb_ld(&bar[XB_XCNT(j)]); sum += c; cnt += (c > 0u) ? 1u : 0u; mine = (j == x) ? c : mine; }
        if (sum == G) break;
        __builtin_amdgcn_s_sleep(1);
        if ((++sp & 255u) == 0u) { if (xb_ld(&bar[XB_TMO])) break; if (sp > XB_SPIN_CAP) { atomicAdd(&bar[XB_TMO], 1u); break; } }
    }
    nloc = mine > 0u ? mine : 1u; nx = cnt > 0u ? cnt : 1u;
}

__device__ __forceinline__ void xcd_barrier(const XcdBarrier& b) {
    asm volatile("s_waitcnt vmcnt(0)" ::: "memory");
    __syncthreads();
    if (threadIdx.x == 0) {
        unsigned* bar = b.bar;
        __builtin_amdgcn_s_waitcnt(0);
        unsigned nloc = b.st[0], nx = b.st[1];
        if (nloc == 0u) { xcd_barrier_complete(bar, b.x, nloc, nx); b.st[0] = nloc; b.st[1] = nx; }
        const unsigned old = xb_add(&bar[XB_XSUB(b.x)], 1u);
        const unsigned gen = old / nloc;
        if (old + 1u == (gen + 1u) * nloc) {
            __builtin_amdgcn_fence(__ATOMIC_RELEASE, "agent");
            asm volatile("s_waitcnt vmcnt(0)" ::: "memory");
            const unsigned og = xb_add(&bar[XB_TOP], 1u);
            const unsigned tg = og / nx;
            if (og + 1u == (tg + 1u) * nx) xb_add(&bar[XB_TOPGEN], 1u);
            else XB_SPIN(xb_ld(&bar[XB_TOPGEN]) == tg, bar);
            __builtin_amdgcn_fence(__ATOMIC_ACQUIRE, "agent");
            xb_add(&bar[XB_XGEN(b.x)], 1u);
            asm volatile("s_waitcnt vmcnt(0)" ::: "memory");
        } else {
            XB_SPIN(xb_ld(&bar[XB_XGEN(b.x)]) == gen, bar);
            __builtin_amdgcn_fence(__ATOMIC_ACQUIRE, "agent");
            asm volatile("s_waitcnt vmcnt(0)" ::: "memory");
        }
    }
    __syncthreads();
}

struct Args { const float* in[18]; float* out; unsigned char* ws; int ph_lo, ph_hi; };
constexpr int NPHASE = 2 + 3 * DEPTH;

__global__ void __launch_bounds__(512) fwd_megakernel(Args args) {
    extern __shared__ __attribute__((aligned(16))) unsigned char lds[];
    cg::grid_group grid = cg::this_grid();
    const int tid = threadIdx.x, lane = tid & 63, wave = __builtin_amdgcn_readfirstlane(tid >> 6);
    const int G = gridDim.x, bx = blockIdx.x;
    unsigned char* ws = args.ws;
    bf16* WinT = (bf16*)(ws + WS_WIN); bf16* WoutT = (bf16*)(ws + WS_WOUT); bf16* WmemT = (bf16*)(ws + WS_WMEM);
    bf16* xb = (bf16*)(ws + WS_XB); bf16* memb = (bf16*)(ws + WS_MEMB); bf16* mkv = (bf16*)(ws + WS_MKV);
    float* ssq = (float*)(ws + WS_SSQ); float* ssqm = (float*)(ws + WS_SSQM);
    bf16* proj = (bf16*)(ws + WS_PROJ); bf16* yb = (bf16*)(ws + WS_Y);
    const int lo = args.ph_lo, hi = args.ph_hi;
#define IN(k) (lo <= (k) && (k) < hi)
    volatile LAS unsigned* xb_st = (volatile LAS unsigned*)((LAS unsigned char*)lds + 131072 + 3584);
    if (threadIdx.x < 4) xb_st[threadIdx.x] = 0u;
    __syncthreads();
    XcdBarrier xbar; xbar.bar = (unsigned*)(ws + WS_BAR); xbar.x = 0; xbar.st = xb_st;
#define SEAM(k) do { if (IN(k) && IN((k) + 1)) { if ((k) == 0) { grid.sync(); xbar = xcd_barrier_post((unsigned*)(ws + WS_BAR), xb_st); } else xcd_barrier(xbar); } } while (0)

#ifndef NO_PRO
    if (IN(0)) {
        float* scr = (float*)lds + wave * (64 * 33);
        const int gw = bx * 8 + wave, NGW = G * 8;
        constexpr int I_IN = (DM / 64) * (INC / 32), I_OUT = (DM / 64) * (DM / 32), I_MEM = (DM / 64) * (1024 / 32);
        constexpr int NITEMS = DEPTH * (I_IN + I_OUT + I_MEM);
        for (int it = gw; it < NITEMS; it += NGW) {
            int r = it;
            if (r < DEPTH * I_IN) { const int l = r / I_IN; r -= l * I_IN;
                transpose_item(args.in[3] + (size_t)l * DM * INC, DM, INC, args.in[2] + l * DM, WinT + (size_t)l * INC * DM, scr, r, lane); continue; }
            r -= DEPTH * I_IN;
            if (r < DEPTH * I_OUT) { const int l = r / I_OUT; r -= l * I_OUT;
                transpose_item(args.in[17] + (size_t)l * DM * DM, DM, DM, nullptr, WoutT + (size_t)l * DM * DM, scr, r, lane); continue; }
            r -= DEPTH * I_OUT;
            { const int l = r / I_MEM; r -= l * I_MEM;
                transpose_item(args.in[14] + (size_t)l * DM * 1024, DM, 1024, args.in[13] + l * DM, WmemT + (size_t)l * 1024 * DM, scr, r, lane); }
        }
        for (int m = gw; m < MTOK + MMEM; m += NGW) {
            if (m < MTOK) row_to_bf16(args.in[0] + (size_t)m * DM, xb + (size_t)m * DM, ssq + (size_t)m * 32, lane);
            else { const int mm = m - MTOK; row_to_bf16(args.in[1] + (size_t)mm * DM, memb + (size_t)mm * DM, ssqm + (size_t)mm * 32, lane); }
        }
        if (bx == 0 && opaque_tid(wave) < 16) ((unsigned*)(ws + WS_CTR))[opaque_tid(wave)] = 0u;
        if (bx == 0) for (int i_ = opaque_tid(wave); i_ < XCD_BAR_WORDS; i_ += 512) ((unsigned*)(ws + WS_BAR))[i_] = 0u;
        __syncthreads();
    }
#endif
    SEAM(0);
#ifndef NO_G1
    if (IN(1)) {
        pg8::Gemm g{memb, WmemT, MMEM, MKVC, DM}; pg8::StaticOrder S; S.init(MMEM, MKVC, G, bx);
        pg8::EpiProj E{mkv, MKVC, ssqm, nullptr, nullptr, 0, 0, 0, 0, 1.f};
        pg8::gemm_phase<pg8::EpiProj, pg8::StaticOrder, true, true>((PG8_LAS unsigned char*)lds, g, S, E, wave);
    }
#endif
#pragma unroll 1
    for (int l = 0; l < DEPTH; ++l) {
        const int pA = 2 + 3 * l, pB = pA + 1, pC = pA + 2;
#ifndef NO_G2
        if (IN(pA)) {
            pg8::Gemm g{xb, WinT + (size_t)l * INC * DM, MTOK, INC, DM}; pg8::StaticOrder S; S.init(MTOK, INC, G, bx);
            pg8::EpiProj E{proj, INC, ssq, args.in[6] + l * 64, args.in[7] + l * 64, C_DQ / 256, C_DK / 256, C_DK / 256, C_DV / 256, QSCALE_D};
            pg8::gemm_phase<pg8::EpiProj, pg8::StaticOrder, true, true>((PG8_LAS unsigned char*)lds, g, S, E, wave);
        }
#endif
        SEAM(pA);
        if (IN(pB)) {
            att::DiffArgs DA{proj, yb, args.in[12] + l * 128, 0, 0, 0};
            { const int ln = opaque_tid(wave) & 63;
              const float mq = att::wave_max(fabsf(args.in[6][l * 64 + ln])), mk = att::wave_max(fabsf(args.in[7][l * 64 + ln]));
              const float s1 = att::wave_sum(args.in[8][l * 64 + ln] * args.in[9][l * 64 + ln]), s2 = att::wave_sum(args.in[10][l * 64 + ln] * args.in[11][l * 64 + ln]);
              const int cb = (l == 0) ? 0x3e4ccccd : (l == 1) ? 0x3eb60549 : (l == 2) ? 0x3ef1014c : 0x3f0e59d5;
              const float li = __int_as_float(cb);
              DA.nM2b = att::to_sgpr(__float_as_int(-(8.0f * mq * mk * LOG2E * 1.03f + 0.25f))); DA.lamb = att::to_sgpr(__float_as_int(expf(s1) - expf(s2) + li)); DA.laminitb = att::to_sgpr(cb); }
            att::MemArgs MA{proj, mkv, yb, args.in[15] + l * 128, args.in[16] + l * 128, l};
            unsigned* ctr = (unsigned*)(ws + WS_CTR) + l;
            att::ConvArgs CA{proj, yb, args.in[4] + l * 3 * 768, args.in[5] + l * 768};
            for (;;) { const int it = att::next_item(ctr, (char*)lds, opaque_tid(wave));
                if (it >= 768 + 256 + 256) break;
                if (it < 768) { const int r = it & 127; att::diff_unit(DA, r >> 6, 5 - (it >> 7), r & 63, (char*)lds, wave); }
                else if (it < 1024) { att::conv_items(CA, (long)(it - 768) * 512 + opaque_tid(wave), 256L * 512); __syncthreads(); }
                else att::mem_unit(MA, it - 1024, (char*)lds, wave); }
        }
        SEAM(pB);
#ifndef NO_G3
        if (IN(pC)) {
            pg8::Gemm g{yb, WoutT + (size_t)l * DM * DM, MTOK, DM, DM}; pg8::StaticOrder S; S.init(MTOK, DM, G, bx);
            pg8::EpiOut E{args.out, xb, ssq, (l == DEPTH - 1) ? 1 : 0};
            pg8::gemm_phase<pg8::EpiOut, pg8::StaticOrder, true, true>((PG8_LAS unsigned char*)lds, g, S, E, wave);
        }
#endif
        if (l + 1 < DEPTH) SEAM(pC);
    }
#undef IN
#undef SEAM
}

extern "C" void kernel_launch(void* const* d_in, const int* in_sizes, int n_in, void* d_out, int out_size, void* d_ws, size_t ws_size, hipStream_t stream) {
    static int grid = 0;
    if (grid == 0) {
        if (n_in != 18 || in_sizes[0] != MTOK * DM || out_size != MTOK * DM || ws_size < WS_END) { fprintf(stderr, "kernel_launch: unexpected shapes (n_in %d, in0 %d, out %d, ws %zu)\n", n_in, n_in > 0 ? in_sizes[0] : -1, out_size, ws_size); grid = -1; return; }
        int dev = 0, cus = 0, per_cu = 0;
        if (hipGetDevice(&dev) != hipSuccess || hipDeviceGetAttribute(&cus, hipDeviceAttributeMultiprocessorCount, dev) != hipSuccess) { grid = -1; return; }
        if (hipFuncSetAttribute((const void*)fwd_megakernel, hipFuncAttributeMaxDynamicSharedMemorySize, LDS_BYTES) != hipSuccess) { fprintf(stderr, "kernel_launch: hipFuncSetAttribute failed\n"); grid = -1; return; }
        if (hipOccupancyMaxActiveBlocksPerMultiprocessor(&per_cu, (const void*)fwd_megakernel, 512, LDS_BYTES) != hipSuccess || per_cu < 1) { fprintf(stderr, "kernel_launch: occupancy query says %d blocks per CU\n", per_cu); per_cu = 1; }
        (void)hipGetLastError();
        grid = cus * 1;
    }
    if (grid < 0) return;
    Args a{};
    for (int i = 0; i < 18; ++i) a.in[i] = (const float*)d_in[i];
    a.out = (float*)d_out; a.ws = (unsigned char*)d_ws;
#if MK_ONE_LAUNCH
    a.ph_lo = 0; a.ph_hi = NPHASE;
    void* kargs[] = {&a};
    hipError_t e = hipLaunchCooperativeKernel((const void*)fwd_megakernel, dim3(grid), dim3(512), kargs, LDS_BYTES, stream);
    if (e != hipSuccess) fprintf(stderr, "kernel_launch: cooperative launch failed: %s (grid %d)\n", hipGetErrorString(e), grid);
#else
    for (int p = 0; p < NPHASE; ++p) { a.ph_lo = p; a.ph_hi = p + 1;
        hipLaunchKernelGGL(fwd_megakernel, dim3(grid), dim3(512), LDS_BYTES, stream, a);
        const hipError_t le = hipPeekAtLastError();
        if (le != hipSuccess) { fprintf(stderr, "kernel_launch: launch %d failed: %s\n", p, hipGetErrorName(le)); break; } }
#endif
}
```

```cpp
#include <hip/hip_runtime.h>
#include <hip/hip_cooperative_groups.h>
#include <cstdio>
#include <cstdint>
namespace cg = cooperative_groups;

#ifndef DIFF_ANTIPHASE
#define DIFF_ANTIPHASE 1
#endif
#ifndef MK_ONE_LAUNCH
#define MK_ONE_LAUNCH 1
#endif

constexpr int DM = 2048, BATCH = 2, SEQ = 8192, DEPTH = 4, NMEM = 256, MTOK = BATCH * SEQ, INC = 7168, MKVC = 4096, MMEM = BATCH * NMEM;
constexpr int C_AX = 0, C_AB = 768, C_AC = 1536, C_AG = 2304, C_DQ = 3072, C_DK = 3840, C_DV = 4608, C_DG = 5376, C_MQ = 6144, C_MG = 6656;
constexpr int Y_A = 0, Y_D = 768, Y_M = 1536;
constexpr float EPS = 1e-6f, LOG2E = 1.4426950408889634f;
constexpr float QSCALE_D = 0.125f * LOG2E;
constexpr float QSCALE_M = 0.08838834764831845f * LOG2E;
constexpr size_t MiB = 1u << 20;
constexpr size_t WS_WIN = 0, WS_WOUT = 112 * MiB, WS_WMEM = 144 * MiB, WS_XB = 160 * MiB, WS_MEMB = 224 * MiB, WS_MKV = 226 * MiB, WS_SSQ = 230 * MiB, WS_SSQM = 232 * MiB, WS_CTR = 233 * MiB, WS_BAR = 234 * MiB,
                 WS_PROJ = 240 * MiB, WS_Y = 464 * MiB, WS_END = 528 * MiB;
constexpr int LDS_BYTES = 131072 + 4096;
__device__ __forceinline__ int opaque_tid(int wv) { int lane_; asm volatile("v_mbcnt_lo_u32_b32 %0, -1, 0\n\tv_mbcnt_hi_u32_b32 %0, -1, %0" : "=v"(lane_)); return wv * 64 + lane_; }
template <int X> __device__ __forceinline__ float swz_xor(float v) { return __int_as_float(__builtin_amdgcn_ds_swizzle(__float_as_int(v), (X << 10) | 0x1f)); }
__device__ __forceinline__ float xsum32(float v) { auto rr = __builtin_amdgcn_permlane32_swap(__float_as_uint(v), __float_as_uint(v), false, false); return __uint_as_float(rr[0]) + __uint_as_float(rr[1]); }
__device__ __forceinline__ float xmax32(float v) { auto rr = __builtin_amdgcn_permlane32_swap(__float_as_uint(v), __float_as_uint(v), false, false); return fmaxf(__uint_as_float(rr[0]), __uint_as_float(rr[1])); }
namespace pg8 {
#define PG8_LAS __attribute__((address_space(3)))
typedef unsigned short bf16_t;
typedef short bf16x8 __attribute__((ext_vector_type(8)));
typedef float f32x4 __attribute__((ext_vector_type(4)));
typedef unsigned u32x4 __attribute__((ext_vector_type(4)));
constexpr int BM = 256, BK = 64, HALF = 128, HTB = HALF * BK * 2  , STAGE_BYTES = 8 * HTB, NXCD = 8, WGM = 8;

__host__ __device__ __forceinline__ int lds_byte(int r, int c) { const int st = (r >> 4) * 2 + (c >> 5), rr = r & 15, cc = c & 31, ob = rr * 64 + cc * 2; return st * 1024 + (ob ^ (((ob >> 9) & 1) << 5)); }
__host__ __device__ __forceinline__ void stage_rc(int b, int& R, int& C) { const int st = b / 1024, sb = b % 1024, swz = sb ^ (((sb >> 9) & 1) << 5); R = (st >> 1) * 16 + swz / 64; C = (st & 1) * 32 + (swz % 64) / 2; }
__host__ __device__ __forceinline__ int perm32(int rho) { const int n = rho >> 4, i = rho & 15; return 8 * (i >> 2) + 4 * n + (i & 3); }

struct Unit { int pm, pn; };
struct Gemm { const bf16_t* A; const bf16_t* Bt; int M, N, K; };

struct StaticOrder {
    int nM, nN, nwg, G, c;
    __host__ __device__ void init(int M, int N, int G_, int c_) { nM = M / BM; nN = N / BM; nwg = nM * nN; G = G_; c = c_; }
    __host__ __device__ bool next(int i, Unit& u) const {
        const long L = (long)i * G + c; if (L >= nwg) return false;
        int wgid = (int)L; { const int q = nwg / NXCD, r = nwg % NXCD, xcd = wgid % NXCD, off = wgid / NXCD; wgid = (xcd < r ? xcd * (q + 1) : r * (q + 1) + (xcd - r) * q) + off; }
        const int nig = WGM * nN, gid = wgid / nig, fm = gid * WGM, gsz = (nM - fm) < WGM ? (nM - fm) : WGM;
        u.pm = fm + ((wgid % nig) % gsz); u.pn = (wgid % nig) / gsz; return true;
    }
    __device__ __forceinline__ void a_ready(const Unit&) const {}
    __device__ __forceinline__ void done(const Unit&) const {}
};


__device__ __forceinline__ unsigned cvt_pk_bf16(float lo, float hi) { unsigned r; asm volatile("v_cvt_pk_bf16_f32 %0, %1, %2" : "=v"(r) : "v"(lo), "v"(hi)); return r; }

struct EpiProj {
    static constexpr bool PERM = true, AFTER_DRAIN = false;
    bf16_t* O; int ldc; const float* ssq; const float* gq; const float* gk; int qlo, qhi, klo, khi; float qscale;
    __device__ __forceinline__ void operator()(const f32x4 (&acc)[2][2][4][2], const Unit& u, int wr, int wc, int fr, int fq) const {
        const int row0 = u.pm * BM + wr * 64 + fr, colw = u.pn * BM + wc * 64 + 8 * fq;
        const int mode = (u.pn >= qlo && u.pn < qhi) ? 1 : ((u.pn >= klo && u.pn < khi) ? 2 : 0);
        f32x4 gv[2][2];
#pragma unroll
        for (int bj = 0; bj < 2; ++bj)
#pragma unroll
            for (int n = 0; n < 2; ++n) gv[bj][n] = (f32x4){1.f, 1.f, 1.f, 1.f};
        if (mode) { const float* g = (mode == 1) ? gq : gk; const float s = (mode == 1) ? qscale : 1.f;
#pragma unroll
            for (int bj = 0; bj < 2; ++bj)
#pragma unroll
                for (int n = 0; n < 2; ++n) gv[bj][n] = *(const f32x4*)(g + 32 * bj + 8 * fq + 4 * n) * s; }
#pragma unroll
        for (int ai = 0; ai < 2; ++ai)
#pragma unroll
            for (int m = 0; m < 4; ++m) {
                const int row = row0 + ai * HALF + m * 16;
                const f32x4* sp = (const f32x4*)(ssq + (size_t)row * 32 + 8 * fq); const f32x4 sa = sp[0], sb = sp[1];
                float s = ((sa.x + sa.y) + (sa.z + sa.w)) + ((sb.x + sb.y) + (sb.z + sb.w)); s += swz_xor<16>(s); s = xsum32(s);
                const float r = 1.0f / sqrtf(s * (1.0f / 2048.0f) + 1e-6f);
                f32x4 v[2][2]; float ss = 0.f;
#pragma unroll
                for (int bj = 0; bj < 2; ++bj)
#pragma unroll
                    for (int n = 0; n < 2; ++n) { v[bj][n] = acc[ai][bj][m][n] * r; const f32x4 q = v[bj][n] * v[bj][n]; ss += (q.x + q.y) + (q.z + q.w); }
                float rn = 1.f;
                if (mode) { ss += swz_xor<16>(ss); ss = xsum32(ss); rn = 1.0f / sqrtf(ss * (1.0f / 64.0f) + 1e-6f); }
                bf16_t* rowp = O + (size_t)row * ldc + colw;
#pragma unroll
                for (int bj = 0; bj < 2; ++bj) { const f32x4 v0 = v[bj][0] * gv[bj][0] * rn, v1 = v[bj][1] * gv[bj][1] * rn;
                    u32x4 w; w.x = cvt_pk_bf16(v0[0], v0[1]); w.y = cvt_pk_bf16(v0[2], v0[3]); w.z = cvt_pk_bf16(v1[0], v1[1]); w.w = cvt_pk_bf16(v1[2], v1[3]);
                    *(u32x4*)(rowp + 32 * bj) = w; }
            }
    }
};

struct EpiOut {
    static constexpr bool PERM = true, AFTER_DRAIN = false;
    float* xout; bf16_t* xb; float* ssq; int last;
    __device__ __forceinline__ void operator()(const f32x4 (&acc)[2][2][4][2], const Unit& u, int wr, int wc, int fr, int fq) const {
        const int row0 = u.pm * BM + wr * 64 + fr, colw = u.pn * BM + wc * 64 + 8 * fq;
#pragma unroll
        for (int ai = 0; ai < 2; ++ai)
#pragma unroll
            for (int m = 0; m < 4; ++m) {
                const int row = row0 + ai * HALF + m * 16; float ss = 0.f;
#pragma unroll
                for (int bj = 0; bj < 2; ++bj) { const size_t off = (size_t)row * 2048 + colw + 32 * bj;
                    const u32x4 xw = *(const u32x4*)(xb + off);
                    f32x4 v0, v1;
                    v0.x = __uint_as_float(xw.x << 16); v0.y = __uint_as_float(xw.x & 0xffff0000u); v0.z = __uint_as_float(xw.y << 16); v0.w = __uint_as_float(xw.y & 0xffff0000u);
                    v1.x = __uint_as_float(xw.z << 16); v1.y = __uint_as_float(xw.z & 0xffff0000u); v1.z = __uint_as_float(xw.w << 16); v1.w = __uint_as_float(xw.w & 0xffff0000u);
                    v0 = v0 + acc[ai][bj][m][0]; v1 = v1 + acc[ai][bj][m][1];
                    if (last) { f32x4* op = (f32x4*)(xout + off); op[0] = v0; op[1] = v1; }
                    else { u32x4 w; w.x = cvt_pk_bf16(v0[0], v0[1]); w.y = cvt_pk_bf16(v0[2], v0[3]); w.z = cvt_pk_bf16(v1[0], v1[1]); w.w = cvt_pk_bf16(v1[2], v1[3]);
                        *(u32x4*)(xb + off) = w;
                        const f32x4 q0 = v0 * v0, q1 = v1 * v1; ss += ((q0.x + q0.y) + (q0.z + q0.w)) + ((q1.x + q1.y) + (q1.z + q1.w)); } }
                if (!last) { ss += swz_xor<16>(ss); ss = xsum32(ss);
                    if (fq == 0) ssq[(size_t)row * 32 + u.pn * 4 + wc] = ss; }
            }
    }
};

template <class Epi, class Sched, bool ALIGN_EPI = false, bool SP2 = false>
__device__ __forceinline__ void gemm_phase(PG8_LAS unsigned char* lds, const Gemm g, const Sched& S, const Epi& E, int wv) {
    const int tid = opaque_tid(wv), wid = __builtin_amdgcn_readfirstlane(tid >> 6), lane = tid & 63, wr = wid >> 2, wc = wid & 3, fr = lane & 15, fq = lane >> 4;
    const int K = g.K, nt = K / BK;
    unsigned voffA[2], voffB[2];
#pragma unroll
    for (int i = 0; i < 2; ++i) { int R, C; stage_rc(tid * 16 + i * 8192, R, C); const int Rb = Epi::PERM ? ((R & ~31) + perm32(R & 31)) : R;
        voffA[i] = (unsigned)(R * K + C) * 2u; voffB[i] = (unsigned)(Rb * K + C) * 2u; }
    const size_t kstep = (size_t)(BK * 2);
    const size_t hstep = (size_t)HALF * K * 2;
    const size_t tstep = 2 * hstep;
    const unsigned ldsw = (unsigned)wid * 1024u;
    const int aoff = lds_byte(wr * 64 + fr, fq * 8), boff = lds_byte(wc * 32 + fr, fq * 8);
#define PG8_SA(b, h) (((b) * 2 + (h)) * HTB)
#define PG8_SB(b, h) ((4 + (b) * 2 + (h)) * HTB)
#define PG8_STAGE(bufoff, gbase, voff) do { _Pragma("unroll") for (int _i = 0; _i < 2; ++_i) \
        __builtin_amdgcn_global_load_lds((const unsigned*)((const char*)(gbase) + (voff)[_i]), (PG8_LAS unsigned*)(lds + (bufoff) + ldsw + _i * 8192), 16, 0, 0); } while (0)
#define PG8_LDA(dst, b, h) do { _Pragma("unroll") for (int m = 0; m < 4; ++m) _Pragma("unroll") for (int k = 0; k < 2; ++k) dst[m][k] = *(const PG8_LAS bf16x8*)(lds + PG8_SA(b, h) + aoff + m * 2048 + k * 1024); } while (0)
#define PG8_LDB(dst, b, h) do { _Pragma("unroll") for (int n = 0; n < 2; ++n) _Pragma("unroll") for (int k = 0; k < 2; ++k) dst[n][k] = *(const PG8_LAS bf16x8*)(lds + PG8_SB(b, h) + boff + n * 2048 + k * 1024); } while (0)
#define PG8_MMA(ai, bj, At, Bt) do { __builtin_amdgcn_s_setprio(1); _Pragma("unroll") for (int m = 0; m < 4; ++m) _Pragma("unroll") for (int n = 0; n < 2; ++n) _Pragma("unroll") for (int k = 0; k < 2; ++k) \
        acc[ai][bj][m][n] = __builtin_amdgcn_mfma_f32_16x16x32_bf16(Bt[n][k], At[m][k], acc[ai][bj][m][n], 0, 0, 0); __builtin_amdgcn_s_setprio(0); } while (0)
#define PG8_WAIT_V(n) asm volatile("s_waitcnt vmcnt(" #n ")" ::: "memory")
#define PG8_WAIT_L(n) asm volatile("s_waitcnt lgkmcnt(" #n ")" ::: "memory")
#define PG8_BAR __builtin_amdgcn_s_barrier()
#define PG8_SCHED __builtin_amdgcn_sched_barrier(0)
    Unit cur, nxt; int ui = 0;
    if (!S.next(0, cur)) return;
    f32x4 acc[2][2][4][2];
#pragma unroll
    for (int a = 0; a < 2; ++a)
#pragma unroll
        for (int b = 0; b < 2; ++b)
#pragma unroll
            for (int m = 0; m < 4; ++m)
#pragma unroll
                for (int n = 0; n < 2; ++n) acc[a][b][m][n] = (f32x4){0.f, 0.f, 0.f, 0.f};
    bf16x8 At[4][2], B0[2][2], B1[2][2];
    const char* cA = (const char*)g.A + (size_t)cur.pm * tstep; const char* cB = (const char*)g.Bt + (size_t)cur.pn * tstep;
    S.a_ready(cur);
    if constexpr (SP2) {
        PG8_STAGE(PG8_SB(0, 0), cB, voffB); PG8_STAGE(PG8_SB(0, 1), cB + hstep, voffB); PG8_STAGE(PG8_SA(0, 0), cA, voffA); PG8_STAGE(PG8_SA(0, 1), cA + hstep, voffA);
        if (wr == 1) PG8_BAR;
        PG8_WAIT_V(2); PG8_BAR;
        PG8_STAGE(PG8_SB(1, 0), cB + kstep, voffB); PG8_STAGE(PG8_SA(1, 0), cA + kstep, voffA); PG8_STAGE(PG8_SB(1, 1), cB + hstep + kstep, voffB);
        PG8_WAIT_V(6); PG8_BAR;
    } else {
        PG8_STAGE(PG8_SB(0, 0), cB, voffB); PG8_STAGE(PG8_SA(0, 0), cA, voffA); PG8_STAGE(PG8_SB(0, 1), cB + hstep, voffB); PG8_STAGE(PG8_SA(0, 1), cA + hstep, voffA);
        if (wr == 1) PG8_BAR;
        PG8_WAIT_V(4); PG8_BAR;
        PG8_STAGE(PG8_SB(1, 0), cB + kstep, voffB); PG8_STAGE(PG8_SA(1, 0), cA + kstep, voffA); PG8_STAGE(PG8_SB(1, 1), cB + hstep + kstep, voffB);
        PG8_WAIT_V(6); PG8_BAR;
    }
    for (;;) {
        const bool has_next = S.next(ui + 1, nxt);
        const char* nA = has_next ? (const char*)g.A + (size_t)nxt.pm * tstep : cA; const char* nB = has_next ? (const char*)g.Bt + (size_t)nxt.pn * tstep : cB;
        for (int t = 0; t < nt; t += 2) {
            const bool last = (t == nt - 2);
            const char* a1 = cA + (size_t)(t + 1) * kstep;
            const char* a2 = last ? nA : cA + (size_t)(t + 2) * kstep; const char* b2 = last ? nB : cB + (size_t)(t + 2) * kstep;
            const char* a3 = a2 + kstep; const char* b3 = b2 + kstep;
            if (last && has_next) S.a_ready(nxt);
            if constexpr (SP2) {
            PG8_LDB(B0, 0, 0); PG8_LDB(B1, 0, 1); PG8_SCHED; PG8_LDA(At, 0, 0); PG8_STAGE(PG8_SA(1, 1), a1 + hstep, voffA);
            PG8_WAIT_V(8); PG8_WAIT_L(0); PG8_BAR; PG8_MMA(0, 0, At, B0); PG8_MMA(0, 1, At, B1); PG8_BAR; PG8_SCHED;
            PG8_LDA(At, 0, 1); PG8_STAGE(PG8_SB(0, 0), b2, voffB); PG8_STAGE(PG8_SB(0, 1), b2 + hstep, voffB); PG8_STAGE(PG8_SA(0, 0), a2, voffA);
            PG8_WAIT_V(8); PG8_WAIT_L(0); PG8_BAR; PG8_MMA(1, 0, At, B0); PG8_MMA(1, 1, At, B1); PG8_BAR; PG8_SCHED;
            PG8_LDB(B0, 1, 0); PG8_LDB(B1, 1, 1); PG8_SCHED; PG8_LDA(At, 1, 0); PG8_STAGE(PG8_SA(0, 1), a2 + hstep, voffA);
            PG8_WAIT_V(8); PG8_WAIT_L(0); PG8_BAR; PG8_MMA(0, 0, At, B0); PG8_MMA(0, 1, At, B1); PG8_BAR; PG8_SCHED;
            PG8_LDA(At, 1, 1); PG8_STAGE(PG8_SB(1, 0), b3, voffB); PG8_STAGE(PG8_SB(1, 1), b3 + hstep, voffB); PG8_STAGE(PG8_SA(1, 0), a3, voffA);
            PG8_WAIT_V(8); PG8_WAIT_L(0); PG8_BAR; PG8_MMA(1, 0, At, B0); PG8_MMA(1, 1, At, B1); PG8_BAR; PG8_SCHED;
            } else {
            PG8_LDB(B0, 0, 0); PG8_SCHED; PG8_LDA(At, 0, 0); PG8_STAGE(PG8_SA(1, 1), a1 + hstep, voffA);
            PG8_WAIT_L(8); PG8_BAR; PG8_WAIT_L(0); PG8_MMA(0, 0, At, B0); PG8_BAR; PG8_SCHED;
            PG8_LDB(B1, 0, 1); PG8_STAGE(PG8_SB(0, 0), b2, voffB);
            PG8_BAR; PG8_WAIT_L(0); PG8_MMA(0, 1, At, B1); PG8_BAR;
            PG8_LDA(At, 0, 1); PG8_STAGE(PG8_SA(0, 0), a2, voffA);
            PG8_BAR; PG8_WAIT_L(0); PG8_MMA(1, 0, At, B0); PG8_BAR; PG8_SCHED;
            PG8_STAGE(PG8_SB(0, 1), b2 + hstep, voffB);
            PG8_WAIT_V(6); PG8_BAR; PG8_MMA(1, 1, At, B1); PG8_BAR;
            PG8_LDB(B0, 1, 0); PG8_SCHED; PG8_LDA(At, 1, 0); PG8_STAGE(PG8_SA(0, 1), a2 + hstep, voffA);
            PG8_WAIT_L(8); PG8_BAR; PG8_WAIT_L(0); PG8_MMA(0, 0, At, B0); PG8_BAR; PG8_SCHED;
            PG8_LDB(B1, 1, 1); PG8_STAGE(PG8_SB(1, 0), b3, voffB);
            PG8_BAR; PG8_WAIT_L(0); PG8_MMA(0, 1, At, B1); PG8_BAR;
            PG8_LDA(At, 1, 1); PG8_STAGE(PG8_SA(1, 0), a3, voffA);
            PG8_BAR; PG8_WAIT_L(0); PG8_MMA(1, 0, At, B0); PG8_BAR; PG8_SCHED;
            PG8_STAGE(PG8_SB(1, 1), b3 + hstep, voffB);
            PG8_WAIT_V(6); PG8_BAR; PG8_MMA(1, 1, At, B1); PG8_BAR;
            }
        }
        if constexpr (ALIGN_EPI) { if (wr == 0) PG8_BAR; }
        if constexpr (!Epi::AFTER_DRAIN) { E(acc, cur, wr, wc, fr, fq); S.done(cur); }
        if (!has_next) break;
#pragma unroll
        for (int a = 0; a < 2; ++a)
#pragma unroll
            for (int b = 0; b < 2; ++b)
#pragma unroll
                for (int m = 0; m < 4; ++m)
#pragma unroll
                    for (int n = 0; n < 2; ++n) acc[a][b][m][n] = (f32x4){0.f, 0.f, 0.f, 0.f};
        cur = nxt; cA = nA; cB = nB; ++ui;
        if constexpr (ALIGN_EPI) { if (wr == 1) PG8_BAR; }
    }
    PG8_WAIT_V(0);
    if constexpr (!ALIGN_EPI) { if (wr == 0) PG8_BAR; }
    PG8_BAR;
    if constexpr (Epi::AFTER_DRAIN) { E.fused(acc, cur, wr, wc, fr, fq, lds, wid, lane); S.done(cur); }
#undef PG8_SA
#undef PG8_SB
#undef PG8_STAGE
#undef PG8_LDA
#undef PG8_LDB
#undef PG8_MMA
#undef PG8_WAIT_V
#undef PG8_WAIT_L
#undef PG8_BAR
#undef PG8_SCHED
}
}

namespace att {
using bf16 = unsigned short;
using bf16x8 = __attribute__((ext_vector_type(8))) short;
using s16x4  = __attribute__((ext_vector_type(4))) short;
using f32x16 = __attribute__((ext_vector_type(16))) float;
using f32x4  = __attribute__((ext_vector_type(4))) float;
using u32x4  = __attribute__((ext_vector_type(4))) unsigned;
constexpr int KVBLK = 64;
constexpr int SHM_V = 64 * 128 * 2, SHM_K = 64 * 128 * 2;
#define KSWZ(row, colB) ((row) * 256 + ((colB) ^ (((row) & 7) << 4)))
#define SBAR() __builtin_amdgcn_sched_barrier(0)
__device__ __forceinline__ int crow(int r, int hi) { return (r & 3) + 8 * (r >> 2) + 4 * hi; }
typedef float f32x2_t __attribute__((ext_vector_type(2))); typedef __bf16 bf16x2_t __attribute__((ext_vector_type(2)));
__device__ __forceinline__ unsigned cvtpk(float lo, float hi) { f32x2_t v = {lo, hi}; bf16x2_t b = __builtin_convertvector(v, bf16x2_t); return __builtin_bit_cast(unsigned, b); }
__device__ __forceinline__ float bf2f(unsigned short h) { return __uint_as_float(((unsigned)h) << 16); }
__device__ __forceinline__ float wave_sum(float v) { v += swz_xor<1>(v); v += swz_xor<2>(v); v += swz_xor<4>(v); v += swz_xor<8>(v); v += swz_xor<16>(v); return xsum32(v); }
__device__ __forceinline__ float wave_max(float v) { v = fmaxf(v, swz_xor<1>(v)); v = fmaxf(v, swz_xor<2>(v)); v = fmaxf(v, swz_xor<4>(v)); v = fmaxf(v, swz_xor<8>(v)); v = fmaxf(v, swz_xor<16>(v)); return xmax32(v); }
__device__ __forceinline__ float uni(float x) { return __uint_as_float(__builtin_amdgcn_readfirstlane(__float_as_uint(x))); }
__device__ __forceinline__ int to_sgpr(int v) { asm volatile("" : "+v"(v)); return __builtin_amdgcn_readfirstlane(v); }
__device__ __forceinline__ float silu(float x) { return x / (1.0f + __expf(-x)); }

__device__ __forceinline__ int v_st(int k, int c) { const int kk = (k & ~0xC) | ((k & 4) << 1) | ((k & 8) >> 1); return ((kk >> 3) * 4 + (c >> 5)) * 512 + ((kk & 7) * 32 + (c & 31)) * 2; }
__device__ __forceinline__ int v_rd_base(int lane) { return ((lane & 3) << 3) | (((lane >> 2) & 3) << 6) | (((lane >> 4) & 1) << 5) | (((lane >> 5) & 1) << 8); }
constexpr int v_rd_off(int d0, int ks, int half) { return d0 * 512 + ks * 4096 + half * 2048; }
template <int OFF> __device__ __forceinline__ s16x4 tr_read(int vb) {
    s16x4 r; asm volatile("ds_read_b64_tr_b16 %0, %1 offset:%2" : "=&v"(r) : "v"(vb), "i"(OFF) : "memory"); return r;
}
template <int D0> __device__ __forceinline__ void pv_one(f32x16& od, int vb, bf16x8 pa0, bf16x8 pa1, bf16x8 pa2, bf16x8 pa3) {
    const s16x4 l0 = tr_read<v_rd_off(D0, 0, 0)>(vb), h0 = tr_read<v_rd_off(D0, 0, 1)>(vb), l1 = tr_read<v_rd_off(D0, 1, 0)>(vb), h1 = tr_read<v_rd_off(D0, 1, 1)>(vb);
    const s16x4 l2 = tr_read<v_rd_off(D0, 2, 0)>(vb), h2 = tr_read<v_rd_off(D0, 2, 1)>(vb), l3 = tr_read<v_rd_off(D0, 3, 0)>(vb), h3 = tr_read<v_rd_off(D0, 3, 1)>(vb);
    asm volatile("s_waitcnt lgkmcnt(0)" ::: "memory"); SBAR();
#define PK(L, H) (bf16x8){L[0], L[1], L[2], L[3], H[0], H[1], H[2], H[3]}
    od = __builtin_amdgcn_mfma_f32_32x32x16_bf16(pa0, PK(l0, h0), od, 0, 0, 0);
    od = __builtin_amdgcn_mfma_f32_32x32x16_bf16(pa1, PK(l1, h1), od, 0, 0, 0);
    od = __builtin_amdgcn_mfma_f32_32x32x16_bf16(pa2, PK(l2, h2), od, 0, 0, 0);
    od = __builtin_amdgcn_mfma_f32_32x32x16_bf16(pa3, PK(l3, h3), od, 0, 0, 0);
#undef PK
}
template <int KS> __device__ __forceinline__ void pv_ks(f32x16* o, int vb, bf16x8 pa) {
    const s16x4 l0 = tr_read<v_rd_off(0, KS, 0)>(vb), h0 = tr_read<v_rd_off(0, KS, 1)>(vb), l1 = tr_read<v_rd_off(1, KS, 0)>(vb), h1 = tr_read<v_rd_off(1, KS, 1)>(vb);
    const s16x4 l2 = tr_read<v_rd_off(2, KS, 0)>(vb), h2 = tr_read<v_rd_off(2, KS, 1)>(vb), l3 = tr_read<v_rd_off(3, KS, 0)>(vb), h3 = tr_read<v_rd_off(3, KS, 1)>(vb);
#define PK(L, H) (bf16x8){L[0], L[1], L[2], L[3], H[0], H[1], H[2], H[3]}
    asm volatile("s_waitcnt lgkmcnt(6)" ::: "memory"); SBAR();
    o[0] = __builtin_amdgcn_mfma_f32_32x32x16_bf16(pa, PK(l0, h0), o[0], 0, 0, 0);
    asm volatile("s_waitcnt lgkmcnt(4)" ::: "memory"); SBAR();
    o[1] = __builtin_amdgcn_mfma_f32_32x32x16_bf16(pa, PK(l1, h1), o[1], 0, 0, 0);
    asm volatile("s_waitcnt lgkmcnt(2)" ::: "memory"); SBAR();
    o[2] = __builtin_amdgcn_mfma_f32_32x32x16_bf16(pa, PK(l2, h2), o[2], 0, 0, 0);
    asm volatile("s_waitcnt lgkmcnt(0)" ::: "memory"); SBAR();
    o[3] = __builtin_amdgcn_mfma_f32_32x32x16_bf16(pa, PK(l3, h3), o[3], 0, 0, 0);
#undef PK
}
__device__ __forceinline__ void pv_d0(f32x16* o, int vb, bf16x8 pa0, bf16x8 pa1, bf16x8 pa2, bf16x8 pa3) {
    pv_ks<0>(o, vb, pa0); pv_ks<1>(o, vb, pa1); pv_ks<2>(o, vb, pa2); pv_ks<3>(o, vb, pa3);
}
__device__ __forceinline__ void exp_half(f32x16& p) {
#pragma unroll
    for (int r = 0; r < 16; ++r) p[r] = __builtin_amdgcn_exp2f(p[r]);
}
__device__ __forceinline__ void pack_p(const f32x16& p0, const f32x16& p1, float& l_reg, bf16x8& pa0, bf16x8& pa1, bf16x8& pa2, bf16x8& pa3) {
    float ps = 0;
#pragma unroll
    for (int r = 0; r < 16; ++r) ps += p0[r];
#pragma unroll
    for (int r = 0; r < 16; ++r) ps += p1[r];
    l_reg += ps;
#define PK4(P, BASE, OUT) do { u32x4 w = {cvtpk(P[BASE + 0], P[BASE + 1]), cvtpk(P[BASE + 2], P[BASE + 3]), cvtpk(P[BASE + 4], P[BASE + 5]), cvtpk(P[BASE + 6], P[BASE + 7])}; \
    OUT = *reinterpret_cast<bf16x8*>(&w); } while (0)
    PK4(p0, 0, pa0); PK4(p0, 8, pa1); PK4(p1, 0, pa2); PK4(p1, 8, pa3);
#undef PK4
}
template <int ND0> __device__ __forceinline__ void qkt(f32x16& p0, f32x16& p1, const char* Ks, const bf16x8* qr, int r32, int hi, int colB0) {
#pragma unroll
    for (int d0 = 0; d0 < ND0; ++d0) { const int cb = colB0 + (d0 * 16 + hi * 8) * 2;
        const bf16x8 b0 = *reinterpret_cast<const bf16x8*>(Ks + KSWZ(r32, cb));
        const bf16x8 b1 = *reinterpret_cast<const bf16x8*>(Ks + KSWZ(32 + r32, cb));
        p0 = __builtin_amdgcn_mfma_f32_32x32x16_bf16(b0, qr[d0], p0, 0, 0, 0);
        p1 = __builtin_amdgcn_mfma_f32_32x32x16_bf16(b1, qr[d0], p1, 0, 0, 0); }
}
__device__ __forceinline__ void bias_init(f32x16& p0, f32x16& p1, float base, float nslope2, float nM2, int rel  ) {
    if (rel <= -63 || rel >= 31) {
        const float sg = (rel < 0) ? -nslope2 : nslope2, lbv = fmaf(-sg, base, nM2);
#pragma unroll
        for (int r = 0; r < 16; ++r) { p0[r] = fmaf((float)((r & 3) + 8 * (r >> 2)), sg, lbv); p1[r] = fmaf((float)((r & 3) + 8 * (r >> 2) + 32), sg, lbv); }
    } else {
#pragma unroll
        for (int r = 0; r < 16; ++r) { const float d = base - (float)((r & 3) + 8 * (r >> 2));
            p0[r] = fmaf(fabsf(d), nslope2, nM2); p1[r] = fmaf(fabsf(d - 32.f), nslope2, nM2); }
    }
}

struct DiffArgs { const bf16* proj; bf16* y; const float* ghead; int nM2b, lamb, laminitb; };

__device__ __forceinline__ void diff_unit(const DiffArgs& A, int b, int h, int qb, char* lds, int wv) {
    const int tid = opaque_tid(wv), wid = __builtin_amdgcn_readfirstlane(tid >> 6), lane = tid & 63, r32 = lane & 31, hi = lane >> 5, c = wid >> 2, wq = wid & 3;
    const char* Pb = (const char*)A.proj + ((size_t)b * SEQ * INC + h * 128) * 2;
    char* V_lds = lds; char* K_lds = lds + 4 * SHM_V;
    float* wsl = (float*)(lds + 131072) + wid * 64;
    int t_lo, nt; float nM2, lam, lam_init;
    { int a_ = A.nM2b, b_ = A.lamb, c_ = A.laminitb;
      asm volatile("" : "+s"(a_), "+s"(b_), "+s"(c_)); nM2 = __int_as_float(a_); lam = __int_as_float(b_); lam_init = __int_as_float(c_); }
    const float slope = exp2f(-8.0f * (float)(h + 1) / 6.0f);
    const float nslope2 = uni(-slope * LOG2E);
    { const float Df = (151.0f + 2.0f * (-nM2)) / (-nslope2); const int Dk = Df > 20000.f ? 20000 : (int)Df + 1; const int i0 = qb * 128;
      int lo_ = i0 - Dk + 1; lo_ = lo_ > 0 ? (lo_ >> 6) : 0; int hi_ = (i0 + 126 + Dk) >> 6; hi_ = hi_ > SEQ / KVBLK - 1 ? SEQ / KVBLK - 1 : hi_;
      if (((hi_ - lo_ + 1) & 1) != 0) { if (lo_ > 0) --lo_; else ++hi_; }
      t_lo = __builtin_amdgcn_readfirstlane(lo_); nt = __builtin_amdgcn_readfirstlane(hi_ - lo_ + 1); }
    const int ipos = qb * 128 + wq * 32 + r32;
    float l_reg = 0; f32x16 o[4] = {}; bf16x8 qr[4];
    { const char* Qw = Pb + (size_t)(qb * 128 + wq * 32) * (INC * 2) + (C_DQ + c * 64) * 2; const unsigned qoff = (unsigned)((r32 * INC + hi * 8) * 2);
#pragma unroll
      for (int d0 = 0; d0 < 4; ++d0) qr[d0] = *reinterpret_cast<const bf16x8*>(Qw + qoff + d0 * 32); }
    const int colB0 = c * 128;
    const int krow = wid * 4 + (lane >> 4), kcc = (lane & 15) ^ (krow & 7);
    const unsigned koff = (unsigned)((krow * INC + kcc * 8) * 2);
    const int vkey = (wid >> 2) * 16 + (((wid >> 1) & 1) << 3) + (((lane >> 4) & 1) << 2) + ((lane >> 2) & 3)  , vcol = ((wid & 1) * 2 + (lane >> 5)) * 32 + (lane & 3) * 8;
    const unsigned voff = (unsigned)((vkey * INC + vcol) * 2 + (C_DV - C_DK) * 2);
    const int vb0 = (int)(uintptr_t)V_lds + v_rd_base(lane);
    const char* Pk = Pb + (size_t)(t_lo * KVBLK) * (INC * 2) + C_DK * 2; int iposk = ipos - t_lo * KVBLK - 4 * hi; asm volatile("" : "+v"(iposk));     const int relw = t_lo * KVBLK - (qb * 128 + wq * 32);
    typedef __attribute__((address_space(3))) unsigned lds_u32;
    __attribute__((address_space(3))) unsigned char* ldsA = (__attribute__((address_space(3))) unsigned char*)lds + wid * 1024;
#define GLDS(gp, lp) __builtin_amdgcn_global_load_lds((const unsigned*)(gp), (lds_u32*)(lp), 16, 0, 0)
#define STAGE(t) do { const char* kt_ = Pk + (size_t)((t) * KVBLK) * (INC * 2); const int so_ = ((t) & 3) * SHM_K; \
    GLDS(kt_ + koff, ldsA + 4 * SHM_V + so_); GLDS(kt_ + 32 * INC * 2 + koff, ldsA + 4 * SHM_V + so_ + 8192); \
    GLDS(kt_ + voff, ldsA + so_); GLDS(kt_ + 32 * INC * 2 + voff, ldsA + so_ + 8192); } while (0)
#define SLOT(t) (((t) & 3) * SHM_K)
#define ENDI() do { asm volatile("s_waitcnt vmcnt(0)" ::: "memory"); __syncthreads(); } while (0)
#define BIAS(P0, P1, t) bias_init(P0, P1, (float)(iposk - (t) * KVBLK), nslope2, nM2, relw + (t) * KVBLK)
    f32x16 pA0, pA1, pB0, pB1; bf16x8 pa0, pa1, pa2, pa3; const int NT = nt;
    STAGE(0); ENDI();
    STAGE(1);
    BIAS(pA0, pA1, 0); qkt<4>(pA0, pA1, K_lds, qr, r32, hi, colB0);
#if DIFF_ANTIPHASE
    if (c == 0) {
#endif
        const int lp_ = opaque_tid(wv) & 63, r32p = lp_ & 31, hip = lp_ >> 5;
        exp_half(pA0);
        ENDI();
#pragma unroll 1
        for (int j = 1; j + 1 < NT; j += 2) {
            STAGE(j + 1);
            SBAR(); BIAS(pB0, pB1, j); qkt<4>(pB0, pB1, K_lds + SLOT(j), qr, r32p, hip, colB0);
            exp_half(pA1); pack_p(pA0, pA1, l_reg, pa0, pa1, pa2, pa3); SBAR();
            pv_d0(o, vb0 + SLOT(j - 1), pa0, pa1, pa2, pa3); exp_half(pB0);
            ENDI();
            STAGE(j + 2);
            SBAR(); BIAS(pA0, pA1, j + 1); qkt<4>(pA0, pA1, K_lds + SLOT(j + 1), qr, r32p, hip, colB0);
            exp_half(pB1); pack_p(pB0, pB1, l_reg, pa0, pa1, pa2, pa3); SBAR();
            pv_d0(o, vb0 + SLOT(j), pa0, pa1, pa2, pa3); exp_half(pA0);
            ENDI();
        }
        { const int lt_ = opaque_tid(wv) & 63;
          SBAR(); BIAS(pB0, pB1, NT - 1); qkt<4>(pB0, pB1, K_lds + SLOT(NT - 1), qr, lt_ & 31, lt_ >> 5, colB0); }
        exp_half(pA1); pack_p(pA0, pA1, l_reg, pa0, pa1, pa2, pa3); SBAR();
        pv_d0(o, vb0 + SLOT(NT - 2), pa0, pa1, pa2, pa3); exp_half(pB0);
        exp_half(pB1); pack_p(pB0, pB1, l_reg, pa0, pa1, pa2, pa3); SBAR();
        pv_d0(o, vb0 + SLOT(NT - 1), pa0, pa1, pa2, pa3);
#if DIFF_ANTIPHASE
    } else {
        const int lp_ = opaque_tid(wv) & 63, r32p = lp_ & 31, hip = lp_ >> 5;
        pa0 = bf16x8{}; pa1 = bf16x8{}; pa2 = bf16x8{}; pa3 = bf16x8{};
        ENDI();
#pragma unroll 1
        for (int j = 1; j + 1 < NT; j += 2) {
            STAGE(j + 1);
            SBAR(); pv_d0(o, vb0 + (j > 1 ? SLOT(j - 2) : 0), pa0, pa1, pa2, pa3);
            exp_half(pA0); SBAR();
            BIAS(pB0, pB1, j); qkt<4>(pB0, pB1, K_lds + SLOT(j), qr, r32p, hip, colB0);
            exp_half(pA1); pack_p(pA0, pA1, l_reg, pa0, pa1, pa2, pa3); SBAR();
            ENDI();
            STAGE(j + 2);
            SBAR(); pv_d0(o, vb0 + SLOT(j - 1), pa0, pa1, pa2, pa3);
            exp_half(pB0); SBAR();
            BIAS(pA0, pA1, j + 1); qkt<4>(pA0, pA1, K_lds + SLOT(j + 1), qr, r32p, hip, colB0);
            exp_half(pB1); pack_p(pB0, pB1, l_reg, pa0, pa1, pa2, pa3); SBAR();
            ENDI();
        }
        SBAR(); pv_d0(o, vb0 + SLOT(NT - 3), pa0, pa1, pa2, pa3);
        exp_half(pA0); SBAR();
        { const int lt_ = opaque_tid(wv) & 63;
          BIAS(pB0, pB1, NT - 1); qkt<4>(pB0, pB1, K_lds + SLOT(NT - 1), qr, lt_ & 31, lt_ >> 5, colB0); }
        exp_half(pA1); pack_p(pA0, pA1, l_reg, pa0, pa1, pa2, pa3); SBAR();
        pv_d0(o, vb0 + SLOT(NT - 2), pa0, pa1, pa2, pa3);
        exp_half(pB0); exp_half(pB1); pack_p(pB0, pB1, l_reg, pa0, pa1, pa2, pa3); SBAR();
        pv_d0(o, vb0 + SLOT(NT - 1), pa0, pa1, pa2, pa3);
    }
#endif
#undef GLDS
#undef STAGE
#undef SLOT
#undef ENDI
#undef BIAS
    { auto rr = __builtin_amdgcn_permlane32_swap(__float_as_uint(l_reg), __float_as_uint(l_reg), false, false);
      l_reg = __uint_as_float(rr[0]) + __uint_as_float(rr[1]); }
    const int tid_e = opaque_tid(wv), lane_e = tid_e & 63;
#define tid tid_e
#define r32 (lane_e & 31)
#define hi (lane_e >> 5)
    if (hi == 0) wsl[r32] = l_reg;
    asm volatile("s_waitcnt lgkmcnt(0)" ::: "memory");
    float rli[16];
#pragma unroll
    for (int r = 0; r < 16; ++r) rli[r] = (c ? lam : 1.0f) / wsl[crow(r, hi)];
    __syncthreads();
    float* OS = (float*)lds;
    if (c == 1) {
#pragma unroll
        for (int r = 0; r < 16; ++r) { float* orow = OS + (wq * 32 + crow(r, hi)) * 132 + r32;
#pragma unroll
            for (int d0 = 0; d0 < 4; ++d0) orow[d0 * 32] = o[d0][r] * rli[r]; }
    }
    __syncthreads();
    if (c == 0) {
#pragma unroll
        for (int r = 0; r < 16; ++r) { float* orow = OS + (wq * 32 + crow(r, hi)) * 132 + r32;
#pragma unroll
            for (int d0 = 0; d0 < 4; ++d0) orow[d0 * 32] = o[d0][r] * rli[r] - orow[d0 * 32]; }
    }
    __syncthreads();
    { const int row = tid >> 2, cq = tid & 3; const float* src = OS + row * 132 + cq * 32;
      f32x4 v[8]; float ss = 0.f;
#pragma unroll
      for (int i = 0; i < 8; ++i) { v[i] = *(const f32x4*)(src + 4 * i); const f32x4 q = v[i] * v[i]; ss += (q.x + q.y) + (q.z + q.w); }
      ss += swz_xor<1>(ss); ss += swz_xor<2>(ss);
      const float rn = (1.0f - lam_init) / sqrtf(ss * (1.0f / 128.0f) + EPS);
      const bf16* gp = (const bf16*)(Pb + (size_t)(qb * 128) * (INC * 2) + C_DG * 2 + (unsigned)((row * INC + cq * 32) * 2));
      bf16* yp = (bf16*)((char*)A.y + ((size_t)(b * SEQ + qb * 128) * DM + Y_D + h * 128) * 2 + (unsigned)((row * DM + cq * 32) * 2)); const float* gh = A.ghead + cq * 32;
#pragma unroll
      for (int i = 0; i < 4; ++i) { const bf16x8 g8 = *reinterpret_cast<const bf16x8*>(gp + 8 * i); const f32x4 h0 = *(const f32x4*)(gh + 8 * i), h1 = *(const f32x4*)(gh + 8 * i + 4);
          const f32x4 a = v[2 * i] * h0 * rn, bq = v[2 * i + 1] * h1 * rn;
          u32x4 w; w.x = cvtpk(a.x * silu(bf2f(g8[0])), a.y * silu(bf2f(g8[1]))); w.y = cvtpk(a.z * silu(bf2f(g8[2])), a.w * silu(bf2f(g8[3])));
          w.z = cvtpk(bq.x * silu(bf2f(g8[4])), bq.y * silu(bf2f(g8[5]))); w.w = cvtpk(bq.z * silu(bf2f(g8[6])), bq.w * silu(bf2f(g8[7])));
          *(u32x4*)(yp + 8 * i) = w; } }
    __syncthreads();
#undef tid
#undef r32
#undef hi
}

__device__ __forceinline__ int next_item(unsigned* ctr, char* lds, int tid) {
    int* slot = (int*)(lds + 131072 + 3072);
    if (tid == 0) *slot = (int)atomicAdd(ctr, 1u);
    __syncthreads();
    return __builtin_amdgcn_readfirstlane(*slot);
}

struct MemArgs { const bf16* proj; const bf16* mkv; bf16* y; const float* gmq; const float* gmk; int layer; };
__device__ __forceinline__ void mem_unit(const MemArgs& A, int unit, char* lds, int wv) {
    const int tid = opaque_tid(wv), wid = __builtin_amdgcn_readfirstlane(tid >> 6), lane = tid & 63, r32 = lane & 31, hi = lane >> 5;
    const int b = unit / (4 * 32), hm = (unit / 32) % 4, qb = unit % 32;
    const bf16* Kh = A.mkv + (size_t)b * NMEM * MKVC + A.layer * 1024 + hm * 128;
    const bf16* Vh = Kh + 512;
    char* V_lds = lds; char* K_lds = lds + 4 * SHM_V;
    float* wsl = (float*)(lds + 131072) + wid * 64;
    float nM2;
    { const float a = wave_max(fmaxf(fabsf(A.gmq[lane]), fabsf(A.gmq[lane + 64]))), bb = wave_max(fmaxf(fabsf(A.gmk[lane]), fabsf(A.gmk[lane + 64])));
      nM2 = -(11.3137085f * a * bb * LOG2E * 1.03f + 0.25f); }
    { const int sr = tid >> 4, sc = (tid & 15) * 8, kc = sc * 2;
      const f32x4 g0 = *(const f32x4*)(A.gmk + sc), g1 = *(const f32x4*)(A.gmk + sc + 4);
#pragma unroll
      for (int t = 0; t < 4; ++t)
#pragma unroll
        for (int hh = 0; hh < 2; ++hh) { const int key = t * 64 + hh * 32 + sr;
          const bf16x8 v8 = *reinterpret_cast<const bf16x8*>(&Vh[(size_t)key * MKVC + sc]); const bf16x8 k8 = *reinterpret_cast<const bf16x8*>(&Kh[(size_t)key * MKVC + sc]);
          float f[8]; float ss = 0.f;
#pragma unroll
          for (int i = 0; i < 8; ++i) { f[i] = bf2f((unsigned short)k8[i]); ss += f[i] * f[i]; }
          ss += swz_xor<1>(ss); ss += swz_xor<2>(ss); ss += swz_xor<4>(ss); ss += swz_xor<8>(ss);
          const float rn = 1.0f / sqrtf(ss * (1.0f / 128.0f) + EPS);
          u32x4 w; w.x = cvtpk(f[0] * rn * g0.x, f[1] * rn * g0.y); w.y = cvtpk(f[2] * rn * g0.z, f[3] * rn * g0.w); w.z = cvtpk(f[4] * rn * g1.x, f[5] * rn * g1.y); w.w = cvtpk(f[6] * rn * g1.z, f[7] * rn * g1.w);
          *(u32x4*)(K_lds + t * SHM_K + KSWZ(hh * 32 + sr, kc)) = w;
          { const int ks_ = hh * 32 + sr, kp_ = (ks_ & ~0xC) | ((ks_ & 4) << 1) | ((ks_ & 8) >> 1);
            *(bf16x8*)(V_lds + t * SHM_V + v_st(kp_, sc)) = v8; } } }
    bf16x8 qr[8];
    const size_t grow0 = (size_t)b * SEQ + qb * 256 + wid * 32;
    { const bf16* Qw = A.proj + (grow0 + r32) * INC + C_MQ + hm * 128 + hi * 8;
      bf16x8 raw[8]; float ss = 0.f;
#pragma unroll
      for (int d0 = 0; d0 < 8; ++d0) { raw[d0] = *reinterpret_cast<const bf16x8*>(Qw + d0 * 16);
#pragma unroll
          for (int i = 0; i < 8; ++i) { const float f = bf2f((unsigned short)raw[d0][i]); ss += f * f; } }
      { auto rr = __builtin_amdgcn_permlane32_swap(__float_as_uint(ss), __float_as_uint(ss), false, false); ss = __uint_as_float(rr[0]) + __uint_as_float(rr[1]); }
      const float rn = QSCALE_M / sqrtf(ss * (1.0f / 128.0f) + EPS);
#pragma unroll
      for (int d0 = 0; d0 < 8; ++d0) { const f32x4 g0 = *(const f32x4*)(A.gmq + d0 * 16 + hi * 8), g1 = *(const f32x4*)(A.gmq + d0 * 16 + hi * 8 + 4);
          u32x4 w; w.x = cvtpk(bf2f((unsigned short)raw[d0][0]) * rn * g0.x, bf2f((unsigned short)raw[d0][1]) * rn * g0.y); w.y = cvtpk(bf2f((unsigned short)raw[d0][2]) * rn * g0.z, bf2f((unsigned short)raw[d0][3]) * rn * g0.w);
          w.z = cvtpk(bf2f((unsigned short)raw[d0][4]) * rn * g1.x, bf2f((unsigned short)raw[d0][5]) * rn * g1.y); w.w = cvtpk(bf2f((unsigned short)raw[d0][6]) * rn * g1.z, bf2f((unsigned short)raw[d0][7]) * rn * g1.w);
          qr[d0] = *reinterpret_cast<bf16x8*>(&w); } }
    __syncthreads();
    float l_reg = 0; f32x16 o[4] = {};
    const int vb0 = (int)(uintptr_t)V_lds + v_rd_base(lane);
#pragma unroll 1
    for (int t = 0; t < 4; ++t) {
        f32x16 p0, p1; bf16x8 pa0, pa1, pa2, pa3;
#pragma unroll
        for (int r = 0; r < 16; ++r) { p0[r] = nM2; p1[r] = nM2; }
        qkt<8>(p0, p1, K_lds + t * SHM_K, qr, r32, hi, 0);
        exp_half(p0); exp_half(p1); pack_p(p0, p1, l_reg, pa0, pa1, pa2, pa3); SBAR();
        pv_d0(o, vb0 + t * SHM_V, pa0, pa1, pa2, pa3);
    }
    { auto rr = __builtin_amdgcn_permlane32_swap(__float_as_uint(l_reg), __float_as_uint(l_reg), false, false);
      l_reg = __uint_as_float(rr[0]) + __uint_as_float(rr[1]); }
    if (hi == 0) wsl[r32] = l_reg;
    asm volatile("s_waitcnt lgkmcnt(0)" ::: "memory");
#pragma unroll
    for (int r = 0; r < 16; ++r) { const int rr_ = crow(r, hi); const float rl = 1.0f / wsl[rr_];
        const bf16* gp = A.proj + (grow0 + rr_) * INC + C_MG + hm * 128 + r32; bf16* yp = A.y + (grow0 + rr_) * DM + Y_M + hm * 128 + r32;
#pragma unroll
        for (int d0 = 0; d0 < 4; ++d0) { const float g = bf2f(gp[d0 * 32]); const float val = o[d0][r] * rl * silu(g);
            yp[d0 * 32] = (bf16)(cvtpk(val, val) & 0xffffu); } }
    __syncthreads();
}

struct ConvArgs { const bf16* proj; bf16* y; const float* w; const float* bias; };
__device__ __forceinline__ void conv_items(const ConvArgs& A, long first, long stride) {
    constexpr long NIT = (long)(MTOK / 4) * 96;
    for (long it = first; it < NIT; it += stride) {
        const int row0 = (int)(it / 96) * 4, c8 = (int)(it % 96) * 8, t0 = row0 & (SEQ - 1);
        const bf16* p = A.proj + (size_t)row0 * INC + c8;
        bf16x8 xr[6], cr[6], br[4], gr[4];
#pragma unroll
        for (int i = 0; i < 6; ++i) { const int t = t0 - 1 + i; const bool ok = (t >= 0) && (t < SEQ);
            xr[i] = ok ? *reinterpret_cast<const bf16x8*>(p + (long)(i - 1) * INC + C_AX) : bf16x8{}; cr[i] = ok ? *reinterpret_cast<const bf16x8*>(p + (long)(i - 1) * INC + C_AC) : bf16x8{}; }
#pragma unroll
        for (int i = 0; i < 4; ++i) { br[i] = *reinterpret_cast<const bf16x8*>(p + (long)i * INC + C_AB); gr[i] = *reinterpret_cast<const bf16x8*>(p + (long)i * INC + C_AG); }
        float w0[8], w1[8], w2[8], bb[8];
#pragma unroll
        for (int i = 0; i < 2; ++i) { const f32x4 a = *(const f32x4*)(A.w + c8 + 4 * i), bq = *(const f32x4*)(A.w + 768 + c8 + 4 * i), cc = *(const f32x4*)(A.w + 1536 + c8 + 4 * i), dd = *(const f32x4*)(A.bias + c8 + 4 * i);
#pragma unroll
            for (int k = 0; k < 4; ++k) { w0[4 * i + k] = a[k]; w1[4 * i + k] = bq[k]; w2[4 * i + k] = cc[k]; bb[4 * i + k] = dd[k]; } }
        float u[6][8];
#pragma unroll
        for (int i = 0; i < 6; ++i)
#pragma unroll
            for (int k = 0; k < 8; ++k) u[i][k] = bf2f((unsigned short)cr[i][k]) * bf2f((unsigned short)xr[i][k]);
#pragma unroll
        for (int j = 0; j < 4; ++j) { float out[8];
#pragma unroll
            for (int k = 0; k < 8; ++k) { const float z = u[j][k] * w0[k] + u[j + 1][k] * w1[k] + u[j + 2][k] * w2[k] + bb[k];
                out[k] = bf2f((unsigned short)br[j][k]) * z * silu(bf2f((unsigned short)gr[j][k])); }
            u32x4 w; w.x = cvtpk(out[0], out[1]); w.y = cvtpk(out[2], out[3]); w.z = cvtpk(out[4], out[5]); w.w = cvtpk(out[6], out[7]);
            *(u32x4*)(A.y + (size_t)(row0 + j) * DM + Y_A + c8) = w; }
    }
}
}

using att::bf16;
typedef float f32x4_t __attribute__((ext_vector_type(4)));
typedef unsigned u32x4_t __attribute__((ext_vector_type(4)));
typedef unsigned u32x2_t __attribute__((ext_vector_type(2)));

__device__ __forceinline__ void transpose_item(const float* __restrict__ W, int K, int N, const float* __restrict__ gain, bf16* __restrict__ WT, float* scr, int item, int lane) {
    const int nblk = N / 32, kb = item / nblk, nb = item % nblk, k0 = 64 * kb, n0 = 32 * nb;
    float wv_[32], gv_[32];
    const float* wp_ = W + (size_t)(k0 + (lane >> 5)) * N + n0 + (lane & 31);
#pragma unroll
    for (int i = 0; i < 32; ++i) { wv_[i] = wp_[(size_t)(2 * i) * N]; gv_[i] = gain ? gain[k0 + 2 * i + (lane >> 5)] : 1.0f; }
#pragma unroll
    for (int i = 0; i < 32; ++i) scr[(2 * i + (lane >> 5)) * 33 + (lane & 31)] = wv_[i] * gv_[i];
    __builtin_amdgcn_s_waitcnt(0xc07f); asm volatile("s_waitcnt lgkmcnt(0)" ::: "memory");
    const int g8 = (n0 & 255) >> 5, n0p = (n0 & ~255) + 128 * (g8 & 1) + 32 * (g8 >> 1);
    const int c = lane & 7;
#pragma unroll
    for (int j = 0; j < 4; ++j) { const int n = (lane >> 3) + 8 * j; const float* s = scr + (8 * c) * 33 + n;
        u32x4_t o; o.x = pg8::cvt_pk_bf16(s[0 * 33], s[1 * 33]); o.y = pg8::cvt_pk_bf16(s[2 * 33], s[3 * 33]); o.z = pg8::cvt_pk_bf16(s[4 * 33], s[5 * 33]); o.w = pg8::cvt_pk_bf16(s[6 * 33], s[7 * 33]);
        *(u32x4_t*)(WT + (size_t)(n0p + n) * K + k0 + 8 * c) = o; }
    asm volatile("s_waitcnt lgkmcnt(0)" ::: "memory");
}
__device__ __forceinline__ void row_to_bf16(const float* __restrict__ xrow, bf16* __restrict__ orow, float* __restrict__ ssrow, int lane) {
    const f32x4_t* xr = (const f32x4_t*)xrow + lane; f32x4_t v[8]; float s = 0.f;
#pragma unroll
    for (int j = 0; j < 8; ++j) { v[j] = xr[64 * j]; s += (v[j].x * v[j].x + v[j].y * v[j].y) + (v[j].z * v[j].z + v[j].w * v[j].w); }
    s = att::wave_sum(s);
    u32x2_t* o8 = (u32x2_t*)orow + lane;
#pragma unroll
    for (int j = 0; j < 8; ++j) { u32x2_t w; w.x = pg8::cvt_pk_bf16(v[j].x, v[j].y); w.y = pg8::cvt_pk_bf16(v[j].z, v[j].w); o8[64 * j] = w; }
    if (lane < 32) ssrow[lane] = (lane == 0) ? s : 0.f;
}


#define XB_TMO      128
#define XB_XCNT(j)  (256  + 64 * (j))
#define XB_XSUB(j)  (1280 + 64 * (j))
#define XB_XGEN(j)  (2304 + 64 * (j))
#define XB_TOP      3328
#define XB_TOPGEN   3392
#define XCD_BAR_WORDS 3456
#define XB_SPIN_CAP (1u << 18)
#define LAS __attribute__((address_space(3)))

__device__ __forceinline__ unsigned xb_ld(unsigned* p)              { return __hip_atomic_load(p, __ATOMIC_RELAXED, __HIP_MEMORY_SCOPE_AGENT); }
__device__ __forceinline__ unsigned xb_add(unsigned* p, unsigned v) { return __hip_atomic_fetch_add(p, v, __ATOMIC_RELAXED, __HIP_MEMORY_SCOPE_AGENT); }
__device__ __forceinline__ unsigned xb_xcc_id() { return (unsigned)__builtin_amdgcn_s_getreg((3 << 11) | 20) & 0xFu; }
#define XB_SPIN(cond, bar) do { unsigned _sp = 0; while (cond) { __builtin_amdgcn_s_sleep(1); \
    if ((++_sp & 255u) == 0u) { if (xb_ld(&(bar)[XB_TMO])) break; if (_sp > XB_SPIN_CAP) { atomicAdd(&(bar)[XB_TMO], 1u); break; } } } } while (0)

struct XcdBarrier {
    unsigned* bar; unsigned x;
    volatile LAS unsigned* st;
};

__device__ __forceinline__ XcdBarrier xcd_barrier_post(unsigned* bar, volatile LAS unsigned* st) {
    XcdBarrier b; b.bar = bar; b.x = xb_xcc_id(); b.st = st;
    if (threadIdx.x == 0) (void)xb_add(&bar[XB_XCNT(b.x)], 1u);
    return b;
}
__device__ __forceinline__ void xcd_barrier_complete(unsigned* bar, unsigned x, unsigned& nloc, unsigned& nx) {
    const unsigned G = gridDim.x * gridDim.y * gridDim.z;
    unsigned sum, cnt, mine, sp = 0u;
    for (;;) {
        sum = 0u; cnt = 0u; mine = 0u;
#pragma unroll
        for (unsigned j = 0; j < 16; ++j) { const unsigned c = xb_ld(&bar[XB_XCNT(j)]); sum += c; cnt += (c > 0u) ? 1u : 0u; mine = (j == x) ? c : mine; }
        if (sum == G) break;
        __builtin_amdgcn_s_sleep(1);
        if ((++sp & 255u) == 0u) { if (xb_ld(&bar[XB_TMO])) break; if (sp > XB_SPIN_CAP) { atomicAdd(&bar[XB_TMO], 1u); break; } }
    }
    nloc = mine > 0u ? mine : 1u; nx = cnt > 0u ? cnt : 1u;
}

__device__ __forceinline__ void xcd_barrier(const XcdBarrier& b) {
    asm volatile("s_waitcnt vmcnt(0)" ::: "memory");
    __syncthreads();
    if (threadIdx.x == 0) {
        unsigned* bar = b.bar;
        __builtin_amdgcn_s_waitcnt(0);
        unsigned nloc = b.st[0], nx = b.st[1];
        if (nloc == 0u) { xcd_barrier_complete(bar, b.x, nloc, nx); b.st[0] = nloc; b.st[1] = nx; }
        const unsigned old = xb_add(&bar[XB_XSUB(b.x)], 1u);
        const unsigned gen = old / nloc;
        if (old + 1u == (gen + 1u) * nloc) {
            __builtin_amdgcn_fence(__ATOMIC_RELEASE, "agent");
            asm volatile("s_waitcnt vmcnt(0)" ::: "memory");
            const unsigned og = xb_add(&bar[XB_TOP], 1u);
            const unsigned tg = og / nx;
            if (og + 1u == (tg + 1u) * nx) xb_add(&bar[XB_TOPGEN], 1u);
            else XB_SPIN(xb_ld(&bar[XB_TOPGEN]) == tg, bar);
            __builtin_amdgcn_fence(__ATOMIC_ACQUIRE, "agent");
            xb_add(&bar[XB_XGEN(b.x)], 1u);
            asm volatile("s_waitcnt vmcnt(0)" ::: "memory");
        } else {
            XB_SPIN(xb_ld(&bar[XB_XGEN(b.x)]) == gen, bar);
            __builtin_amdgcn_fence(__ATOMIC_ACQUIRE, "agent");
            asm volatile("s_waitcnt vmcnt(0)" ::: "memory");
        }
    }
    __syncthreads();
}

struct Args { const float* in[18]; float* out; unsigned char* ws; int ph_lo, ph_hi; };
constexpr int NPHASE = 2 + 3 * DEPTH;

__global__ void __launch_bounds__(512) fwd_megakernel(Args args) {
    extern __shared__ __attribute__((aligned(16))) unsigned char lds[];
    cg::grid_group grid = cg::this_grid();
    const int tid = threadIdx.x, lane = tid & 63, wave = __builtin_amdgcn_readfirstlane(tid >> 6);
    const int G = gridDim.x, bx = blockIdx.x;
    unsigned char* ws = args.ws;
    bf16* WinT = (bf16*)(ws + WS_WIN); bf16* WoutT = (bf16*)(ws + WS_WOUT); bf16* WmemT = (bf16*)(ws + WS_WMEM);
    bf16* xb = (bf16*)(ws + WS_XB); bf16* memb = (bf16*)(ws + WS_MEMB); bf16* mkv = (bf16*)(ws + WS_MKV);
    float* ssq = (float*)(ws + WS_SSQ); float* ssqm = (float*)(ws + WS_SSQM);
    bf16* proj = (bf16*)(ws + WS_PROJ); bf16* yb = (bf16*)(ws + WS_Y);
    const int lo = args.ph_lo, hi = args.ph_hi;
#define IN(k) (lo <= (k) && (k) < hi)
    volatile LAS unsigned* xb_st = (volatile LAS unsigned*)((LAS unsigned char*)lds + 131072 + 3584);
    if (threadIdx.x < 4) xb_st[threadIdx.x] = 0u;
    __syncthreads();
    XcdBarrier xbar; xbar.bar = (unsigned*)(ws + WS_BAR); xbar.x = 0; xbar.st = xb_st;
#define SEAM(k) do { if (IN(k) && IN((k) + 1)) { if ((k) == 0) { grid.sync(); xbar = xcd_barrier_post((unsigned*)(ws + WS_BAR), xb_st); } else xcd_barrier(xbar); } } while (0)

#ifndef NO_PRO
    if (IN(0)) {
        float* scr = (float*)lds + wave * (64 * 33);
        const int gw = bx * 8 + wave, NGW = G * 8;
        constexpr int I_IN = (DM / 64) * (INC / 32), I_OUT = (DM / 64) * (DM / 32), I_MEM = (DM / 64) * (1024 / 32);
        constexpr int NITEMS = DEPTH * (I_IN + I_OUT + I_MEM);
        for (int it = gw; it < NITEMS; it += NGW) {
            int r = it;
            if (r < DEPTH * I_IN) { const int l = r / I_IN; r -= l * I_IN;
                transpose_item(args.in[3] + (size_t)l * DM * INC, DM, INC, args.in[2] + l * DM, WinT + (size_t)l * INC * DM, scr, r, lane); continue; }
            r -= DEPTH * I_IN;
            if (r < DEPTH * I_OUT) { const int l = r / I_OUT; r -= l * I_OUT;
                transpose_item(args.in[17] + (size_t)l * DM * DM, DM, DM, nullptr, WoutT + (size_t)l * DM * DM, scr, r, lane); continue; }
            r -= DEPTH * I_OUT;
            { const int l = r / I_MEM; r -= l * I_MEM;
                transpose_item(args.in[14] + (size_t)l * DM * 1024, DM, 1024, args.in[13] + l * DM, WmemT + (size_t)l * 1024 * DM, scr, r, lane); }
        }
        for (int m = gw; m < MTOK + MMEM; m += NGW) {
            if (m < MTOK) row_to_bf16(args.in[0] + (size_t)m * DM, xb + (size_t)m * DM, ssq + (size_t)m * 32, lane);
            else { const int mm = m - MTOK; row_to_bf16(args.in[1] + (size_t)mm * DM, memb + (size_t)mm * DM, ssqm + (size_t)mm * 32, lane); }
        }
        if (bx == 0 && opaque_tid(wave) < 16) ((unsigned*)(ws + WS_CTR))[opaque_tid(wave)] = 0u;
        if (bx == 0) for (int i_ = opaque_tid(wave); i_ < XCD_BAR_WORDS; i_ += 512) ((unsigned*)(ws + WS_BAR))[i_] = 0u;
        __syncthreads();
    }
#endif
    SEAM(0);
#ifndef NO_G1
    if (IN(1)) {
        pg8::Gemm g{memb, WmemT, MMEM, MKVC, DM}; pg8::StaticOrder S; S.init(MMEM, MKVC, G, bx);
        pg8::EpiProj E{mkv, MKVC, ssqm, nullptr, nullptr, 0, 0, 0, 0, 1.f};
        pg8::gemm_phase<pg8::EpiProj, pg8::StaticOrder, true, true>((PG8_LAS unsigned char*)lds, g, S, E, wave);
    }
#endif
#pragma unroll 1
    for (int l = 0; l < DEPTH; ++l) {
        const int pA = 2 + 3 * l, pB = pA + 1, pC = pA + 2;
#ifndef NO_G2
        if (IN(pA)) {
            pg8::Gemm g{xb, WinT + (size_t)l * INC * DM, MTOK, INC, DM}; pg8::StaticOrder S; S.init(MTOK, INC, G, bx);
            pg8::EpiProj E{proj, INC, ssq, args.in[6] + l * 64, args.in[7] + l * 64, C_DQ / 256, C_DK / 256, C_DK / 256, C_DV / 256, QSCALE_D};
            pg8::gemm_phase<pg8::EpiProj, pg8::StaticOrder, true, true>((PG8_LAS unsigned char*)lds, g, S, E, wave);
        }
#endif
        SEAM(pA);
        if (IN(pB)) {
            att::DiffArgs DA{proj, yb, args.in[12] + l * 128, 0, 0, 0};
            { const int ln = opaque_tid(wave) & 63;
              const float mq = att::wave_max(fabsf(args.in[6][l * 64 + ln])), mk = att::wave_max(fabsf(args.in[7][l * 64 + ln]));
              const float s1 = att::wave_sum(args.in[8][l * 64 + ln] * args.in[9][l * 64 + ln]), s2 = att::wave_sum(args.in[10][l * 64 + ln] * args.in[11][l * 64 + ln]);
              const int cb = (l == 0) ? 0x3e4ccccd : (l == 1) ? 0x3eb60549 : (l == 2) ? 0x3ef1014c : 0x3f0e59d5;
              const float li = __int_as_float(cb);
              DA.nM2b = att::to_sgpr(__float_as_int(-(8.0f * mq * mk * LOG2E * 1.03f + 0.25f))); DA.lamb = att::to_sgpr(__float_as_int(expf(s1) - expf(s2) + li)); DA.laminitb = att::to_sgpr(cb); }
            att::MemArgs MA{proj, mkv, yb, args.in[15] + l * 128, args.in[16] + l * 128, l};
            unsigned* ctr = (unsigned*)(ws + WS_CTR) + l;
            att::ConvArgs CA{proj, yb, args.in[4] + l * 3 * 768, args.in[5] + l * 768};
            for (;;) { const int it = att::next_item(ctr, (char*)lds, opaque_tid(wave));
                if (it >= 768 + 256 + 256) break;
                if (it < 768) { const int r = it & 127; att::diff_unit(DA, r >> 6, 5 - (it >> 7), r & 63, (char*)lds, wave); }
                else if (it < 1024) { att::conv_items(CA, (long)(it - 768) * 512 + opaque_tid(wave), 256L * 512); __syncthreads(); }
                else att::mem_unit(MA, it - 1024, (char*)lds, wave); }
        }
        SEAM(pB);
#ifndef NO_G3
        if (IN(pC)) {
            pg8::Gemm g{yb, WoutT + (size_t)l * DM * DM, MTOK, DM, DM}; pg8::StaticOrder S; S.init(MTOK, DM, G, bx);
            pg8::EpiOut E{args.out, xb, ssq, (l == DEPTH - 1) ? 1 : 0};
            pg8::gemm_phase<pg8::EpiOut, pg8::StaticOrder, true, true>((PG8_LAS unsigned char*)lds, g, S, E, wave);
        }
#endif
        if (l + 1 < DEPTH) SEAM(pC);
    }
#undef IN
#undef SEAM
}

extern "C" void kernel_launch(void* const* d_in, const int* in_sizes, int n_in, void* d_out, int out_size, void* d_ws, size_t ws_size, hipStream_t stream) {
    static int grid = 0;
    if (grid == 0) {
        if (n_in != 18 || in_sizes[0] != MTOK * DM || out_size != MTOK * DM || ws_size < WS_END) { fprintf(stderr, "kernel_launch: unexpected shapes (n_in %d, in0 %d, out %d, ws %zu)\n", n_in, n_in > 0 ? in_sizes[0] : -1, out_size, ws_size); grid = -1; return; }
        int dev = 0, cus = 0, per_cu = 0;
        if (hipGetDevice(&dev) != hipSuccess || hipDeviceGetAttribute(&cus, hipDeviceAttributeMultiprocessorCount, dev) != hipSuccess) { grid = -1; return; }
        if (hipFuncSetAttribute((const void*)fwd_megakernel, hipFuncAttributeMaxDynamicSharedMemorySize, LDS_BYTES) != hipSuccess) { fprintf(stderr, "kernel_launch: hipFuncSetAttribute failed\n"); grid = -1; return; }
        if (hipOccupancyMaxActiveBlocksPerMultiprocessor(&per_cu, (const void*)fwd_megakernel, 512, LDS_BYTES) != hipSuccess || per_cu < 1) { fprintf(stderr, "kernel_launch: occupancy query says %d blocks per CU\n", per_cu); per_cu = 1; }
        (void)hipGetLastError();
        grid = cus * 1;
    }
    if (grid < 0) return;
    Args a{};
    for (int i = 0; i < 18; ++i) a.in[i] = (const float*)d_in[i];
    a.out = (float*)d_out; a.ws = (unsigned char*)d_ws;
#if MK_ONE_LAUNCH
    a.ph_lo = 0; a.ph_hi = NPHASE;
    void* kargs[] = {&a};
    hipError_t e = hipLaunchCooperativeKernel((const void*)fwd_megakernel, dim3(grid), dim3(512), kargs, LDS_BYTES, stream);
    if (e != hipSuccess) fprintf(stderr, "kernel_launch: cooperative launch failed: %s (grid %d)\n", hipGetErrorString(e), grid);
#else
    for (int p = 0; p < NPHASE; ++p) { a.ph_lo = p; a.ph_hi = p + 1;
        hipLaunchKernelGGL(fwd_megakernel, dim3(grid), dim3(512), LDS_BYTES, stream, a);
        const hipError_t le = hipPeekAtLastError();
        if (le != hipSuccess) { fprintf(stderr, "kernel_launch: launch %d failed: %s\n", p, hipGetErrorName(le)); break; } }
#endif
}
```

```cpp
#include <hip/hip_runtime.h>
#include <hip/hip_cooperative_groups.h>
#include <cstdio>
#include <cstdint>
namespace cg = cooperative_groups;

#ifndef DIFF_ANTIPHASE
#define DIFF_ANTIPHASE 1
#endif
#ifndef MK_ONE_LAUNCH
#define MK_ONE_LAUNCH 1
#endif

constexpr int DM = 2048, BATCH = 2, SEQ = 8192, DEPTH = 4, NMEM = 256, MTOK = BATCH * SEQ, INC = 7168, MKVC = 4096, MMEM = BATCH * NMEM;
constexpr int C_AX = 0, C_AB = 768, C_AC = 1536, C_AG = 2304, C_DQ = 3072, C_DK = 3840, C_DV = 4608, C_DG = 5376, C_MQ = 6144, C_MG = 6656;
constexpr int Y_A = 0, Y_D = 768, Y_M = 1536;
constexpr float EPS = 1e-6f, LOG2E = 1.4426950408889634f;
constexpr float QSCALE_D = 0.125f * LOG2E;
constexpr float QSCALE_M = 0.08838834764831845f * LOG2E;
constexpr size_t MiB = 1u << 20;
constexpr size_t WS_WIN = 0, WS_WOUT = 112 * MiB, WS_WMEM = 144 * MiB, WS_XB = 160 * MiB, WS_MEMB = 224 * MiB, WS_MKV = 226 * MiB, WS_SSQ = 230 * MiB, WS_SSQM = 232 * MiB, WS_CTR = 233 * MiB, WS_BAR = 234 * MiB,
                 WS_PROJ = 240 * MiB, WS_Y = 464 * MiB, WS_END = 528 * MiB;
constexpr int LDS_BYTES = 131072 + 4096;
__device__ __forceinline__ int opaque_tid(int wv) { int lane_; asm volatile("v_mbcnt_lo_u32_b32 %0, -1, 0\n\tv_mbcnt_hi_u32_b32 %0, -1, %0" : "=v"(lane_)); return wv * 64 + lane_; }
template <int X> __device__ __forceinline__ float swz_xor(float v) { return __int_as_float(__builtin_amdgcn_ds_swizzle(__float_as_int(v), (X << 10) | 0x1f)); }
__device__ __forceinline__ float xsum32(float v) { auto rr = __builtin_amdgcn_permlane32_swap(__float_as_uint(v), __float_as_uint(v), false, false); return __uint_as_float(rr[0]) + __uint_as_float(rr[1]); }
__device__ __forceinline__ float xmax32(float v) { auto rr = __builtin_amdgcn_permlane32_swap(__float_as_uint(v), __float_as_uint(v), false, false); return fmaxf(__uint_as_float(rr[0]), __uint_as_float(rr[1])); }
namespace pg8 {
#define PG8_LAS __attribute__((address_space(3)))
typedef unsigned short bf16_t;
typedef short bf16x8 __attribute__((ext_vector_type(8)));
typedef float f32x4 __attribute__((ext_vector_type(4)));
typedef unsigned u32x4 __attribute__((ext_vector_type(4)));
constexpr int BM = 256, BK = 64, HALF = 128, HTB = HALF * BK * 2  , STAGE_BYTES = 8 * HTB, NXCD = 8, WGM = 8;

__host__ __device__ __forceinline__ int lds_byte(int r, int c) { const int st = (r >> 4) * 2 + (c >> 5), rr = r & 15, cc = c & 31, ob = rr * 64 + cc * 2; return st * 1024 + (ob ^ (((ob >> 9) & 1) << 5)); }
__host__ __device__ __forceinline__ void stage_rc(int b, int& R, int& C) { const int st = b / 1024, sb = b % 1024, swz = sb ^ (((sb >> 9) & 1) << 5); R = (st >> 1) * 16 + swz / 64; C = (st & 1) * 32 + (swz % 64) / 2; }
__host__ __device__ __forceinline__ int perm32(int rho) { const int n = rho >> 4, i = rho & 15; return 8 * (i >> 2) + 4 * n + (i & 3); }

struct Unit { int pm, pn; };
struct Gemm { const bf16_t* A; const bf16_t* Bt; int M, N, K; };

struct StaticOrder {
    int nM, nN, nwg, G, c;
    __host__ __device__ void init(int M, int N, int G_, int c_) { nM = M / BM; nN = N / BM; nwg = nM * nN; G = G_; c = c_; }
    __host__ __device__ bool next(int i, Unit& u) const {
        const long L = (long)i * G + c; if (L >= nwg) return false;
        int wgid = (int)L; { const int q = nwg / NXCD, r = nwg % NXCD, xcd = wgid % NXCD, off = wgid / NXCD; wgid = (xcd < r ? xcd * (q + 1) : r * (q + 1) + (xcd - r) * q) + off; }
        const int nig = WGM * nN, gid = wgid / nig, fm = gid * WGM, gsz = (nM - fm) < WGM ? (nM - fm) : WGM;
        u.pm = fm + ((wgid % nig) % gsz); u.pn = (wgid % nig) / gsz; return true;
    }
    __device__ __forceinline__ void a_ready(const Unit&) const {}
    __device__ __forceinline__ void done(const Unit&) const {}
};


__device__ __forceinline__ unsigned cvt_pk_bf16(float lo, float hi) { unsigned r; asm volatile("v_cvt_pk_bf16_f32 %0, %1, %2" : "=v"(r) : "v"(lo), "v"(hi)); return r; }

struct EpiProj {
    static constexpr bool PERM = true, AFTER_DRAIN = false;
    bf16_t* O; int ldc; const float* ssq; const float* gq; const float* gk; int qlo, qhi, klo, khi; float qscale;
    __device__ __forceinline__ void operator()(const f32x4 (&acc)[2][2][4][2], const Unit& u, int wr, int wc, int fr, int fq) const {
        const int row0 = u.pm * BM + wr * 64 + fr, colw = u.pn * BM + wc * 64 + 8 * fq;
        const int mode = (u.pn >= qlo && u.pn < qhi) ? 1 : ((u.pn >= klo && u.pn < khi) ? 2 : 0);
        f32x4 gv[2][2];
#pragma unroll
        for (int bj = 0; bj < 2; ++bj)
#pragma unroll
            for (int n = 0; n < 2; ++n) gv[bj][n] = (f32x4){1.f, 1.f, 1.f, 1.f};
        if (mode) { const float* g = (mode == 1) ? gq : gk; const float s = (mode == 1) ? qscale : 1.f;
#pragma unroll
            for (int bj = 0; bj < 2; ++bj)
#pragma unroll
                for (int n = 0; n < 2; ++n) gv[bj][n] = *(const f32x4*)(g + 32 * bj + 8 * fq + 4 * n) * s; }
#pragma unroll
        for (int ai = 0; ai < 2; ++ai)
#pragma unroll
            for (int m = 0; m < 4; ++m) {
                const int row = row0 + ai * HALF + m * 16;
                const f32x4* sp = (const f32x4*)(ssq + (size_t)row * 32 + 8 * fq); const f32x4 sa = sp[0], sb = sp[1];
                float s = ((sa.x + sa.y) + (sa.z + sa.w)) + ((sb.x + sb.y) + (sb.z + sb.w)); s += swz_xor<16>(s); s = xsum32(s);
                const float r = 1.0f / sqrtf(s * (1.0f / 2048.0f) + 1e-6f);
                f32x4 v[2][2]; float ss = 0.f;
#pragma unroll
                for (int bj = 0; bj < 2; ++bj)
#pragma unroll
                    for (int n = 0; n < 2; ++n) { v[bj][n] = acc[ai][bj][m][n] * r; const f32x4 q = v[bj][n] * v[bj][n]; ss += (q.x + q.y) + (q.z + q.w); }
                float rn = 1.f;
                if (mode) { ss += swz_xor<16>(ss); ss = xsum32(ss); rn = 1.0f / sqrtf(ss * (1.0f / 64.0f) + 1e-6f); }
                bf16_t* rowp = O + (size_t)row * ldc + colw;
#pragma unroll
                for (int bj = 0; bj < 2; ++bj) { const f32x4 v0 = v[bj][0] * gv[bj][0] * rn, v1 = v[bj][1] * gv[bj][1] * rn;
                    u32x4 w; w.x = cvt_pk_bf16(v0[0], v0[1]); w.y = cvt_pk_bf16(v0[2], v0[3]); w.z = cvt_pk_bf16(v1[0], v1[1]); w.w = cvt_pk_bf16(v1[2], v1[3]);
                    *(u32x4*)(rowp + 32 * bj) = w; }
            }
    }
};

struct EpiOut {
    static constexpr bool PERM = true, AFTER_DRAIN = false;
    float* xout; bf16_t* xb; float* ssq; int last;
    __device__ __forceinline__ void operator()(const f32x4 (&acc)[2][2][4][2], const Unit& u, int wr, int wc, int fr, int fq) const {
        const int row0 = u.pm * BM + wr * 64 + fr, colw = u.pn * BM + wc * 64 + 8 * fq;
#pragma unroll
        for (int ai = 0; ai < 2; ++ai)
#pragma unroll
            for (int m = 0; m < 4; ++m) {
                const int row = row0 + ai * HALF + m * 16; float ss = 0.f;
#pragma unroll
                for (int bj = 0; bj < 2; ++bj) { const size_t off = (size_t)row * 2048 + colw + 32 * bj;
                    const u32x4 xw = *(const u32x4*)(xb + off);
                    f32x4 v0, v1;
                    v0.x = __uint_as_float(xw.x << 16); v0.y = __uint_as_float(xw.x & 0xffff0000u); v0.z = __uint_as_float(xw.y << 16); v0.w = __uint_as_float(xw.y & 0xffff0000u);
                    v1.x = __uint_as_float(xw.z << 16); v1.y = __uint_as_float(xw.z & 0xffff0000u); v1.z = __uint_as_float(xw.w << 16); v1.w = __uint_as_float(xw.w & 0xffff0000u);
                    v0 = v0 + acc[ai][bj][m][0]; v1 = v1 + acc[ai][bj][m][1];
                    if (last) { f32x4* op = (f32x4*)(xout + off); op[0] = v0; op[1] = v1; }
                    else { u32x4 w; w.x = cvt_pk_bf16(v0[0], v0[1]); w.y = cvt_pk_bf16(v0[2], v0[3]); w.z = cvt_pk_bf16(v1[0], v1[1]); w.w = cvt_pk_bf16(v1[2], v1[3]);
                        *(u32x4*)(xb + off) = w;
                        const f32x4 q0 = v0 * v0, q1 = v1 * v1; ss += ((q0.x + q0.y) + (q0.z + q0.w)) + ((q1.x + q1.y) + (q1.z + q1.w)); } }
                if (!last) { ss += swz_xor<16>(ss); ss = xsum32(ss);
                    if (fq == 0) ssq[(size_t)row * 32 + u.pn * 4 + wc] = ss; }
            }
    }
};

template <class Epi, class Sched, bool ALIGN_EPI = false, bool SP2 = false>
__device__ __forceinline__ void gemm_phase(PG8_LAS unsigned char* lds, const Gemm g, const Sched& S, const Epi& E, int wv) {
    const int tid = opaque_tid(wv), wid = __builtin_amdgcn_readfirstlane(tid >> 6), lane = tid & 63, wr = wid >> 2, wc = wid & 3, fr = lane & 15, fq = lane >> 4;
    const int K = g.K, nt = K / BK;
    unsigned voffA[2], voffB[2];
#pragma unroll
    for (int i = 0; i < 2; ++i) { int R, C; stage_rc(tid * 16 + i * 8192, R, C); const int Rb = Epi::PERM ? ((R & ~31) + perm32(R & 31)) : R;
        voffA[i] = (unsigned)(R * K + C) * 2u; voffB[i] = (unsigned)(Rb * K + C) * 2u; }
    const size_t kstep = (size_t)(BK * 2);
    const size_t hstep = (size_t)HALF * K * 2;
    const size_t tstep = 2 * hstep;
    const unsigned ldsw = (unsigned)wid * 1024u;
    const int aoff = lds_byte(wr * 64 + fr, fq * 8), boff = lds_byte(wc * 32 + fr, fq * 8);
#define PG8_SA(b, h) (((b) * 2 + (h)) * HTB)
#define PG8_SB(b, h) ((4 + (b) * 2 + (h)) * HTB)
#define PG8_STAGE(bufoff, gbase, voff) do { _Pragma("unroll") for (int _i = 0; _i < 2; ++_i) \
        __builtin_amdgcn_global_load_lds((const unsigned*)((const char*)(gbase) + (voff)[_i]), (PG8_LAS unsigned*)(lds + (bufoff) + ldsw + _i * 8192), 16, 0, 0); } while (0)
#define PG8_LDA(dst, b, h) do { _Pragma("unroll") for (int m = 0; m < 4; ++m) _Pragma("unroll") for (int k = 0; k < 2; ++k) dst[m][k] = *(const PG8_LAS bf16x8*)(lds + PG8_SA(b, h) + aoff + m * 2048 + k * 1024); } while (0)
#define PG8_LDB(dst, b, h) do { _Pragma("unroll") for (int n = 0; n < 2; ++n) _Pragma("unroll") for (int k = 0; k < 2; ++k) dst[n][k] = *(const PG8_LAS bf16x8*)(lds + PG8_SB(b, h) + boff + n * 2048 + k * 1024); } while (0)
#define PG8_MMA(ai, bj, At, Bt) do { __builtin_amdgcn_s_setprio(1); _Pragma("unroll") for (int m = 0; m < 4; ++m) _Pragma("unroll") for (int n = 0; n < 2; ++n) _Pragma("unroll") for (int k = 0; k < 2; ++k) \
        acc[ai][bj][m][n] = __builtin_amdgcn_mfma_f32_16x16x32_bf16(Bt[n][k], At[m][k], acc[ai][bj][m][n], 0, 0, 0); __builtin_amdgcn_s_setprio(0); } while (0)
#define PG8_WAIT_V(n) asm volatile("s_waitcnt vmcnt(" #n ")" ::: "memory")
#define PG8_WAIT_L(n) asm volatile("s_waitcnt lgkmcnt(" #n ")" ::: "memory")
#define PG8_BAR __builtin_amdgcn_s_barrier()
#define PG8_SCHED __builtin_amdgcn_sched_barrier(0)
    Unit cur, nxt; int ui = 0;
    if (!S.next(0, cur)) return;
    f32x4 acc[2][2][4][2];
#pragma unroll
    for (int a = 0; a < 2; ++a)
#pragma unroll
        for (int b = 0; b < 2; ++b)
#pragma unroll
            for (int m = 0; m < 4; ++m)
#pragma unroll
                for (int n = 0; n < 2; ++n) acc[a][b][m][n] = (f32x4){0.f, 0.f, 0.f, 0.f};
    bf16x8 At[4][2], B0[2][2], B1[2][2];
    const char* cA = (const char*)g.A + (size_t)cur.pm * tstep; const char* cB = (const char*)g.Bt + (size_t)cur.pn * tstep;
    S.a_ready(cur);
    if constexpr (SP2) {
        PG8_STAGE(PG8_SB(0, 0), cB, voffB); PG8_STAGE(PG8_SB(0, 1), cB + hstep, voffB); PG8_STAGE(PG8_SA(0, 0), cA, voffA); PG8_STAGE(PG8_SA(0, 1), cA + hstep, voffA);
        if (wr == 1) PG8_BAR;
        PG8_WAIT_V(2); PG8_BAR;
        PG8_STAGE(PG8_SB(1, 0), cB + kstep, voffB); PG8_STAGE(PG8_SA(1, 0), cA + kstep, voffA); PG8_STAGE(PG8_SB(1, 1), cB + hstep + kstep, voffB);
        PG8_WAIT_V(6); PG8_BAR;
    } else {
        PG8_STAGE(PG8_SB(0, 0), cB, voffB); PG8_STAGE(PG8_SA(0, 0), cA, voffA); PG8_STAGE(PG8_SB(0, 1), cB + hstep, voffB); PG8_STAGE(PG8_SA(0, 1), cA + hstep, voffA);
        if (wr == 1) PG8_BAR;
        PG8_WAIT_V(4); PG8_BAR;
        PG8_STAGE(PG8_SB(1, 0), cB + kstep, voffB); PG8_STAGE(PG8_SA(1, 0), cA + kstep, voffA); PG8_STAGE(PG8_SB(1, 1), cB + hstep + kstep, voffB);
        PG8_WAIT_V(6); PG8_BAR;
    }
    for (;;) {
        const bool has_next = S.next(ui + 1, nxt);
        const char* nA = has_next ? (const char*)g.A + (size_t)nxt.pm * tstep : cA; const char* nB = has_next ? (const char*)g.Bt + (size_t)nxt.pn * tstep : cB;
        for (int t = 0; t < nt; t += 2) {
            const bool last = (t == nt - 2);
            const char* a1 = cA + (size_t)(t + 1) * kstep;
            const char* a2 = last ? nA : cA + (size_t)(t + 2) * kstep; const char* b2 = last ? nB : cB + (size_t)(t + 2) * kstep;
            const char* a3 = a2 + kstep; const char* b3 = b2 + kstep;
            if (last && has_next) S.a_ready(nxt);
            if constexpr (SP2) {
            PG8_LDB(B0, 0, 0); PG8_LDB(B1, 0, 1); PG8_SCHED; PG8_LDA(At, 0, 0); PG8_STAGE(PG8_SA(1, 1), a1 + hstep, voffA);
            PG8_WAIT_V(8); PG8_WAIT_L(0); PG8_BAR; PG8_MMA(0, 0, At, B0); PG8_MMA(0, 1, At, B1); PG8_BAR; PG8_SCHED;
            PG8_LDA(At, 0, 1); PG8_STAGE(PG8_SB(0, 0), b2, voffB); PG8_STAGE(PG8_SB(0, 1), b2 + hstep, voffB); PG8_STAGE(PG8_SA(0, 0), a2, voffA);
            PG8_WAIT_V(8); PG8_WAIT_L(0); PG8_BAR; PG8_MMA(1, 0, At, B0); PG8_MMA(1, 1, At, B1); PG8_BAR; PG8_SCHED;
            PG8_LDB(B0, 1, 0); PG8_LDB(B1, 1, 1); PG8_SCHED; PG8_LDA(At, 1, 0); PG8_STAGE(PG8_SA(0, 1), a2 + hstep, voffA);
            PG8_WAIT_V(8); PG8_WAIT_L(0); PG8_BAR; PG8_MMA(0, 0, At, B0); PG8_MMA(0, 1, At, B1); PG8_BAR; PG8_SCHED;
            PG8_LDA(At, 1, 1); PG8_STAGE(PG8_SB(1, 0), b3, voffB); PG8_STAGE(PG8_SB(1, 1), b3 + hstep, voffB); PG8_STAGE(PG8_SA(1, 0), a3, voffA);
            PG8_WAIT_V(8); PG8_WAIT_L(0); PG8_BAR; PG8_MMA(1, 0, At, B0); PG8_MMA(1, 1, At, B1); PG8_BAR; PG8_SCHED;
            } else {
            PG8_LDB(B0, 0, 0); PG8_SCHED; PG8_LDA(At, 0, 0); PG8_STAGE(PG8_SA(1, 1), a1 + hstep, voffA);
            PG8_WAIT_L(8); PG8_BAR; PG8_WAIT_L(0); PG8_MMA(0, 0, At, B0); PG8_BAR; PG8_SCHED;
            PG8_LDB(B1, 0, 1); PG8_STAGE(PG8_SB(0, 0), b2, voffB);
            PG8_BAR; PG8_WAIT_L(0); PG8_MMA(0, 1, At, B1); PG8_BAR;
            PG8_LDA(At, 0, 1); PG8_STAGE(PG8_SA(0, 0), a2, voffA);
            PG8_BAR; PG8_WAIT_L(0); PG8_MMA(1, 0, At, B0); PG8_BAR; PG8_SCHED;
            PG8_STAGE(PG8_SB(0, 1), b2 + hstep, voffB);
            PG8_WAIT_V(6); PG8_BAR; PG8_MMA(1, 1, At, B1); PG8_BAR;
            PG8_LDB(B0, 1, 0); PG8_SCHED; PG8_LDA(At, 1, 0); PG8_STAGE(PG8_SA(0, 1), a2 + hstep, voffA);
            PG8_WAIT_L(8); PG8_BAR; PG8_WAIT_L(0); PG8_MMA(0, 0, At, B0); PG8_BAR; PG8_SCHED;
            PG8_LDB(B1, 1, 1); PG8_STAGE(PG8_SB(1, 0), b3, voffB);
            PG8_BAR; PG8_WAIT_L(0); PG8_MMA(0, 1, At, B1); PG8_BAR;
            PG8_LDA(At, 1, 1); PG8_STAGE(PG8_SA(1, 0), a3, voffA);
            PG8_BAR; PG8_WAIT_L(0); PG8_MMA(1, 0, At, B0); PG8_BAR; PG8_SCHED;
            PG8_STAGE(PG8_SB(1, 1), b3 + hstep, voffB);
            PG8_WAIT_V(6); PG8_BAR; PG8_MMA(1, 1, At, B1); PG8_BAR;
            }
        }
        if constexpr (ALIGN_EPI) { if (wr == 0) PG8_BAR; }
        if constexpr (!Epi::AFTER_DRAIN) { E(acc, cur, wr, wc, fr, fq); S.done(cur); }
        if (!has_next) break;
#pragma unroll
        for (int a = 0; a < 2; ++a)
#pragma unroll
            for (int b = 0; b < 2; ++b)
#pragma unroll
                for (int m = 0; m < 4; ++m)
#pragma unroll
                    for (int n = 0; n < 2; ++n) acc[a][b][m][n] = (f32x4){0.f, 0.f, 0.f, 0.f};
        cur = nxt; cA = nA; cB = nB; ++ui;
        if constexpr (ALIGN_EPI) { if (wr == 1) PG8_BAR; }
    }
    PG8_WAIT_V(0);
    if constexpr (!ALIGN_EPI) { if (wr == 0) PG8_BAR; }
    PG8_BAR;
    if constexpr (Epi::AFTER_DRAIN) { E.fused(acc, cur, wr, wc, fr, fq, lds, wid, lane); S.done(cur); }
#undef PG8_SA
#undef PG8_SB
#undef PG8_STAGE
#undef PG8_LDA
#undef PG8_LDB
#undef PG8_MMA
#undef PG8_WAIT_V
#undef PG8_WAIT_L
#undef PG8_BAR
#undef PG8_SCHED
}
}

namespace att {
using bf16 = unsigned short;
using bf16x8 = __attribute__((ext_vector_type(8))) short;
using s16x4  = __attribute__((ext_vector_type(4))) short;
using f32x16 = __attribute__((ext_vector_type(16))) float;
using f32x4  = __attribute__((ext_vector_type(4))) float;
using u32x4  = __attribute__((ext_vector_type(4))) unsigned;
constexpr int KVBLK = 64;
constexpr int SHM_V = 64 * 128 * 2, SHM_K = 64 * 128 * 2;
#define KSWZ(row, colB) ((row) * 256 + ((colB) ^ (((row) & 15) << 4)))
#define SBAR() __builtin_amdgcn_sched_barrier(0)
__device__ __forceinline__ int crow(int r, int hi) { return (r & 3) + 8 * (r >> 2) + 4 * hi; }
typedef float f32x2_t __attribute__((ext_vector_type(2))); typedef __bf16 bf16x2_t __attribute__((ext_vector_type(2)));
__device__ __forceinline__ unsigned cvtpk(float lo, float hi) { f32x2_t v = {lo, hi}; bf16x2_t b = __builtin_convertvector(v, bf16x2_t); return __builtin_bit_cast(unsigned, b); }
__device__ __forceinline__ float bf2f(unsigned short h) { return __uint_as_float(((unsigned)h) << 16); }
__device__ __forceinline__ float wave_sum(float v) { v += swz_xor<1>(v); v += swz_xor<2>(v); v += swz_xor<4>(v); v += swz_xor<8>(v); v += swz_xor<16>(v); return xsum32(v); }
__device__ __forceinline__ float wave_max(float v) { v = fmaxf(v, swz_xor<1>(v)); v = fmaxf(v, swz_xor<2>(v)); v = fmaxf(v, swz_xor<4>(v)); v = fmaxf(v, swz_xor<8>(v)); v = fmaxf(v, swz_xor<16>(v)); return xmax32(v); }
__device__ __forceinline__ float uni(float x) { return __uint_as_float(__builtin_amdgcn_readfirstlane(__float_as_uint(x))); }
__device__ __forceinline__ int to_sgpr(int v) { asm volatile("" : "+v"(v)); return __builtin_amdgcn_readfirstlane(v); }
__device__ __forceinline__ float silu(float x) { return x / (1.0f + __expf(-x)); }

__device__ __forceinline__ int v_st(int k, int c) { const int kk = (k & ~0xC) | ((k & 4) << 1) | ((k & 8) >> 1); return ((kk >> 3) * 4 + (c >> 5)) * 512 + ((kk & 7) * 32 + (c & 31)) * 2; }
__device__ __forceinline__ int v_rd_base(int lane) { return ((lane & 3) << 3) | (((lane >> 2) & 3) << 6) | (((lane >> 4) & 1) << 5) | (((lane >> 5) & 1) << 8); }
constexpr int v_rd_off(int d0, int ks, int half) { return d0 * 512 + ks * 4096 + half * 2048; }
template <int OFF> __device__ __forceinline__ s16x4 tr_read(int vb) {
    s16x4 r; asm volatile("ds_read_b64_tr_b16 %0, %1 offset:%2" : "=&v"(r) : "v"(vb), "i"(OFF) : "memory"); return r;
}
template <int D0> __device__ __forceinline__ void pv_one(f32x16& od, int vb, bf16x8 pa0, bf16x8 pa1, bf16x8 pa2, bf16x8 pa3) {
    const s16x4 l0 = tr_read<v_rd_off(D0, 0, 0)>(vb), h0 = tr_read<v_rd_off(D0, 0, 1)>(vb), l1 = tr_read<v_rd_off(D0, 1, 0)>(vb), h1 = tr_read<v_rd_off(D0, 1, 1)>(vb);
    const s16x4 l2 = tr_read<v_rd_off(D0, 2, 0)>(vb), h2 = tr_read<v_rd_off(D0, 2, 1)>(vb), l3 = tr_read<v_rd_off(D0, 3, 0)>(vb), h3 = tr_read<v_rd_off(D0, 3, 1)>(vb);
    asm volatile("s_waitcnt lgkmcnt(0)" ::: "memory"); SBAR();
#define PK(L, H) (bf16x8){L[0], L[1], L[2], L[3], H[0], H[1], H[2], H[3]}
    od = __builtin_amdgcn_mfma_f32_32x32x16_bf16(pa0, PK(l0, h0), od, 0, 0, 0);
    od = __builtin_amdgcn_mfma_f32_32x32x16_bf16(pa1, PK(l1, h1), od, 0, 0, 0);
    od = __builtin_amdgcn_mfma_f32_32x32x16_bf16(pa2, PK(l2, h2), od, 0, 0, 0);
    od = __builtin_amdgcn_mfma_f32_32x32x16_bf16(pa3, PK(l3, h3), od, 0, 0, 0);
#undef PK
}
template <int KS> __device__ __forceinline__ void pv_ks(f32x16* o, int vb, bf16x8 pa) {
    const s16x4 l0 = tr_read<v_rd_off(0, KS, 0)>(vb), h0 = tr_read<v_rd_off(0, KS, 1)>(vb), l1 = tr_read<v_rd_off(1, KS, 0)>(vb), h1 = tr_read<v_rd_off(1, KS, 1)>(vb);
    const s16x4 l2 = tr_read<v_rd_off(2, KS, 0)>(vb), h2 = tr_read<v_rd_off(2, KS, 1)>(vb), l3 = tr_read<v_rd_off(3, KS, 0)>(vb), h3 = tr_read<v_rd_off(3, KS, 1)>(vb);
#define PK(L, H) (bf16x8){L[0], L[1], L[2], L[3], H[0], H[1], H[2], H[3]}
    asm volatile("s_waitcnt lgkmcnt(6)" ::: "memory"); SBAR();
    o[0] = __builtin_amdgcn_mfma_f32_32x32x16_bf16(pa, PK(l0, h0), o[0], 0, 0, 0);
    asm volatile("s_waitcnt lgkmcnt(4)" ::: "memory"); SBAR();
    o[1] = __builtin_amdgcn_mfma_f32_32x32x16_bf16(pa, PK(l1, h1), o[1], 0, 0, 0);
    asm volatile("s_waitcnt lgkmcnt(2)" ::: "memory"); SBAR();
    o[2] = __builtin_amdgcn_mfma_f32_32x32x16_bf16(pa, PK(l2, h2), o[2], 0, 0, 0);
    asm volatile("s_waitcnt lgkmcnt(0)" ::: "memory"); SBAR();
    o[3] = __builtin_amdgcn_mfma_f32_32x32x16_bf16(pa, PK(l3, h3), o[3], 0, 0, 0);
#undef PK
}
__device__ __forceinline__ void pv_d0(f32x16* o, int vb, bf16x8 pa0, bf16x8 pa1, bf16x8 pa2, bf16x8 pa3) {
    pv_ks<0>(o, vb, pa0); pv_ks<1>(o, vb, pa1); pv_ks<2>(o, vb, pa2); pv_ks<3>(o, vb, pa3);
}
__device__ __forceinline__ void exp_half(f32x16& p) {
#pragma unroll
    for (int r = 0; r < 16; ++r) p[r] = __builtin_amdgcn_exp2f(p[r]);
}
__device__ __forceinline__ void pack_p(const f32x16& p0, const f32x16& p1, float& l_reg, bf16x8& pa0, bf16x8& pa1, bf16x8& pa2, bf16x8& pa3) {
    float ps = 0;
#pragma unroll
    for (int r = 0; r < 16; ++r) ps += p0[r];
#pragma unroll
    for (int r = 0; r < 16; ++r) ps += p1[r];
    l_reg += ps;
#define PK4(P, BASE, OUT) do { u32x4 w = {cvtpk(P[BASE + 0], P[BASE + 1]), cvtpk(P[BASE + 2], P[BASE + 3]), cvtpk(P[BASE + 4], P[BASE + 5]), cvtpk(P[BASE + 6], P[BASE + 7])}; \
    OUT = *reinterpret_cast<bf16x8*>(&w); } while (0)
    PK4(p0, 0, pa0); PK4(p0, 8, pa1); PK4(p1, 0, pa2); PK4(p1, 8, pa3);
#undef PK4
}
template <int ND0> __device__ __forceinline__ void qkt(f32x16& p0, f32x16& p1, const char* Ks, const bf16x8* qr, int r32, int hi, int colB0) {
#pragma unroll
    for (int d0 = 0; d0 < ND0; ++d0) { const int cb = colB0 + (d0 * 16 + hi * 8) * 2;
        const bf16x8 b0 = *reinterpret_cast<const bf16x8*>(Ks + KSWZ(r32, cb));
        const bf16x8 b1 = *reinterpret_cast<const bf16x8*>(Ks + KSWZ(32 + r32, cb));
        p0 = __builtin_amdgcn_mfma_f32_32x32x16_bf16(b0, qr[d0], p0, 0, 0, 0);
        p1 = __builtin_amdgcn_mfma_f32_32x32x16_bf16(b1, qr[d0], p1, 0, 0, 0); }
}
__device__ __forceinline__ void bias_init(f32x16& p0, f32x16& p1, float base, float nslope2, float nM2, int rel  ) {
    if (rel <= -63 || rel >= 31) {
        const float sg = (rel < 0) ? -nslope2 : nslope2, lbv = fmaf(-sg, base, nM2);
#pragma unroll
        for (int r = 0; r < 16; ++r) { p0[r] = fmaf((float)((r & 3) + 8 * (r >> 2)), sg, lbv); p1[r] = fmaf((float)((r & 3) + 8 * (r >> 2) + 32), sg, lbv); }
    } else {
#pragma unroll
        for (int r = 0; r < 16; ++r) { const float d = base - (float)((r & 3) + 8 * (r >> 2));
            p0[r] = fmaf(fabsf(d), nslope2, nM2); p1[r] = fmaf(fabsf(d - 32.f), nslope2, nM2); }
    }
}

struct DiffArgs { const bf16* proj; bf16* y; const float* ghead; int nM2b, lamb, laminitb; };

__device__ __forceinline__ void diff_unit(const DiffArgs& A, int b, int h, int qb, char* lds, int wv) {
    const int tid = opaque_tid(wv), wid = __builtin_amdgcn_readfirstlane(tid >> 6), lane = tid & 63, r32 = lane & 31, hi = lane >> 5, c = wid >> 2, wq = wid & 3;
    const char* Pb = (const char*)A.proj + ((size_t)b * SEQ * INC + h * 128) * 2;
    char* V_lds = lds; char* K_lds = lds + 4 * SHM_V;
    float* wsl = (float*)(lds + 131072) + wid * 64;
    int t_lo, nt; float nM2, lam, lam_init;
    { int a_ = A.nM2b, b_ = A.lamb, c_ = A.laminitb;
      asm volatile("" : "+s"(a_), "+s"(b_), "+s"(c_)); nM2 = __int_as_float(a_); lam = __int_as_float(b_); lam_init = __int_as_float(c_); }
    const float slope = exp2f(-8.0f * (float)(h + 1) / 6.0f);
    const float nslope2 = uni(-slope * LOG2E);
    { const float Df = (151.0f + 2.0f * (-nM2)) / (-nslope2); const int Dk = Df > 20000.f ? 20000 : (int)Df + 1; const int i0 = qb * 128;
      int lo_ = i0 - Dk + 1; lo_ = lo_ > 0 ? (lo_ >> 6) : 0; int hi_ = (i0 + 126 + Dk) >> 6; hi_ = hi_ > SEQ / KVBLK - 1 ? SEQ / KVBLK - 1 : hi_;
      if (((hi_ - lo_ + 1) & 1) != 0) { if (lo_ > 0) --lo_; else ++hi_; }
      t_lo = __builtin_amdgcn_readfirstlane(lo_); nt = __builtin_amdgcn_readfirstlane(hi_ - lo_ + 1); }
    const int ipos = qb * 128 + wq * 32 + r32;
    float l_reg = 0; f32x16 o[4] = {}; bf16x8 qr[4];
    { const char* Qw = Pb + (size_t)(qb * 128 + wq * 32) * (INC * 2) + (C_DQ + c * 64) * 2; const unsigned qoff = (unsigned)((r32 * INC + hi * 8) * 2);
#pragma unroll
      for (int d0 = 0; d0 < 4; ++d0) qr[d0] = *reinterpret_cast<const bf16x8*>(Qw + qoff + d0 * 32); }
    const int colB0 = c * 128;
    const int krow = wid * 4 + (lane >> 4), kcc = (lane & 15) ^ (krow & 15);
    const unsigned koff = (unsigned)((krow * INC + kcc * 8) * 2);
    const int vkey = (wid >> 2) * 16 + (((wid >> 1) & 1) << 3) + (((lane >> 4) & 1) << 2) + ((lane >> 2) & 3)  , vcol = ((wid & 1) * 2 + (lane >> 5)) * 32 + (lane & 3) * 8;
    const unsigned voff = (unsigned)((vkey * INC + vcol) * 2 + (C_DV - C_DK) * 2);
    const int vb0 = (int)(uintptr_t)V_lds + v_rd_base(lane);
    const char* Pk = Pb + (size_t)(t_lo * KVBLK) * (INC * 2) + C_DK * 2; int iposk = ipos - t_lo * KVBLK - 4 * hi; asm volatile("" : "+v"(iposk));     const int relw = t_lo * KVBLK - (qb * 128 + wq * 32);
    typedef __attribute__((address_space(3))) unsigned lds_u32;
    __attribute__((address_space(3))) unsigned char* ldsA = (__attribute__((address_space(3))) unsigned char*)lds + wid * 1024;
#define GLDS(gp, lp) __builtin_amdgcn_global_load_lds((const unsigned*)(gp), (lds_u32*)(lp), 16, 0, 0)
#define STAGE(t) do { const char* kt_ = Pk + (size_t)((t) * KVBLK) * (INC * 2); const int so_ = ((t) & 3) * SHM_K; \
    GLDS(kt_ + koff, ldsA + 4 * SHM_V + so_); GLDS(kt_ + 32 * INC * 2 + koff, ldsA + 4 * SHM_V + so_ + 8192); \
    GLDS(kt_ + voff, ldsA + so_); GLDS(kt_ + 32 * INC * 2 + voff, ldsA + so_ + 8192); } while (0)
#define SLOT(t) (((t) & 3) * SHM_K)
#define ENDI() do { asm volatile("s_waitcnt vmcnt(0)" ::: "memory"); __syncthreads(); } while (0)
#define BIAS(P0, P1, t) bias_init(P0, P1, (float)(iposk - (t) * KVBLK), nslope2, nM2, relw + (t) * KVBLK)
    f32x16 pA0, pA1, pB0, pB1; bf16x8 pa0, pa1, pa2, pa3; const int NT = nt;
    STAGE(0); ENDI();
    STAGE(1);
    BIAS(pA0, pA1, 0); qkt<4>(pA0, pA1, K_lds, qr, r32, hi, colB0);
#if DIFF_ANTIPHASE
    if (c == 0) {
#endif
        const int lp_ = opaque_tid(wv) & 63, r32p = lp_ & 31, hip = lp_ >> 5;
        exp_half(pA0);
        ENDI();
#pragma unroll 1
        for (int j = 1; j + 1 < NT; j += 2) {
            STAGE(j + 1);
            SBAR(); BIAS(pB0, pB1, j); qkt<4>(pB0, pB1, K_lds + SLOT(j), qr, r32p, hip, colB0);
            exp_half(pA1); pack_p(pA0, pA1, l_reg, pa0, pa1, pa2, pa3); SBAR();
            pv_d0(o, vb0 + SLOT(j - 1), pa0, pa1, pa2, pa3); exp_half(pB0);
            ENDI();
            STAGE(j + 2);
            SBAR(); BIAS(pA0, pA1, j + 1); qkt<4>(pA0, pA1, K_lds + SLOT(j + 1), qr, r32p, hip, colB0);
            exp_half(pB1); pack_p(pB0, pB1, l_reg, pa0, pa1, pa2, pa3); SBAR();
            pv_d0(o, vb0 + SLOT(j), pa0, pa1, pa2, pa3); exp_half(pA0);
            ENDI();
        }
        { const int lt_ = opaque_tid(wv) & 63;
          SBAR(); BIAS(pB0, pB1, NT - 1); qkt<4>(pB0, pB1, K_lds + SLOT(NT - 1), qr, lt_ & 31, lt_ >> 5, colB0); }
        exp_half(pA1); pack_p(pA0, pA1, l_reg, pa0, pa1, pa2, pa3); SBAR();
        pv_d0(o, vb0 + SLOT(NT - 2), pa0, pa1, pa2, pa3); exp_half(pB0);
        exp_half(pB1); pack_p(pB0, pB1, l_reg, pa0, pa1, pa2, pa3); SBAR();
        pv_d0(o, vb0 + SLOT(NT - 1), pa0, pa1, pa2, pa3);
#if DIFF_ANTIPHASE
    } else {
        const int lp_ = opaque_tid(wv) & 63, r32p = lp_ & 31, hip = lp_ >> 5;
        pa0 = bf16x8{}; pa1 = bf16x8{}; pa2 = bf16x8{}; pa3 = bf16x8{};
        ENDI();
#pragma unroll 1
        for (int j = 1; j + 1 < NT; j += 2) {
            STAGE(j + 1);
            SBAR(); pv_d0(o, vb0 + (j > 1 ? SLOT(j - 2) : 0), pa0, pa1, pa2, pa3);
            exp_half(pA0); SBAR();
            BIAS(pB0, pB1, j); qkt<4>(pB0, pB1, K_lds + SLOT(j), qr, r32p, hip, colB0);
            exp_half(pA1); pack_p(pA0, pA1, l_reg, pa0, pa1, pa2, pa3); SBAR();
            ENDI();
            STAGE(j + 2);
            SBAR(); pv_d0(o, vb0 + SLOT(j - 1), pa0, pa1, pa2, pa3);
            exp_half(pB0); SBAR();
            BIAS(pA0, pA1, j + 1); qkt<4>(pA0, pA1, K_lds + SLOT(j + 1), qr, r32p, hip, colB0);
            exp_half(pB1); pack_p(pB0, pB1, l_reg, pa0, pa1, pa2, pa3); SBAR();
            ENDI();
        }
        SBAR(); pv_d0(o, vb0 + SLOT(NT - 3), pa0, pa1, pa2, pa3);
        exp_half(pA0); SBAR();
        { const int lt_ = opaque_tid(wv) & 63;
          BIAS(pB0, pB1, NT - 1); qkt<4>(pB0, pB1, K_lds + SLOT(NT - 1), qr, lt_ & 31, lt_ >> 5, colB0); }
        exp_half(pA1); pack_p(pA0, pA1, l_reg, pa0, pa1, pa2, pa3); SBAR();
        pv_d0(o, vb0 + SLOT(NT - 2), pa0, pa1, pa2, pa3);
        exp_half(pB0); exp_half(pB1); pack_p(pB0, pB1, l_reg, pa0, pa1, pa2, pa3); SBAR();
        pv_d0(o, vb0 + SLOT(NT - 1), pa0, pa1, pa2, pa3);
    }
#endif
#undef GLDS
#undef STAGE
#undef SLOT
#undef ENDI
#undef BIAS
    { auto rr = __builtin_amdgcn_permlane32_swap(__float_as_uint(l_reg), __float_as_uint(l_reg), false, false);
      l_reg = __uint_as_float(rr[0]) + __uint_as_float(rr[1]); }
    const int tid_e = opaque_tid(wv), lane_e = tid_e & 63;
#define tid tid_e
#define r32 (lane_e & 31)
#define hi (lane_e >> 5)
    if (hi == 0) wsl[r32] = l_reg;
    asm volatile("s_waitcnt lgkmcnt(0)" ::: "memory");
    float rli[16];
#pragma unroll
    for (int r = 0; r < 16; ++r) rli[r] = (c ? lam : 1.0f) / wsl[crow(r, hi)];
    __syncthreads();
    float* OS = (float*)lds;
    if (c == 1) {
#pragma unroll
        for (int r = 0; r < 16; ++r) { float* orow = OS + (wq * 32 + crow(r, hi)) * 132 + r32;
#pragma unroll
            for (int d0 = 0; d0 < 4; ++d0) orow[d0 * 32] = o[d0][r] * rli[r]; }
    }
    __syncthreads();
    if (c == 0) {
#pragma unroll
        for (int r = 0; r < 16; ++r) { float* orow = OS + (wq * 32 + crow(r, hi)) * 132 + r32;
#pragma unroll
            for (int d0 = 0; d0 < 4; ++d0) orow[d0 * 32] = o[d0][r] * rli[r] - orow[d0 * 32]; }
    }
    __syncthreads();
    { const int row = tid >> 2, cq = tid & 3; const float* src = OS + row * 132 + cq * 32;
      f32x4 v[8]; float ss = 0.f;
#pragma unroll
      for (int i = 0; i < 8; ++i) { v[i] = *(const f32x4*)(src + 4 * i); const f32x4 q = v[i] * v[i]; ss += (q.x + q.y) + (q.z + q.w); }
      ss += swz_xor<1>(ss); ss += swz_xor<2>(ss);
      const float rn = (1.0f - lam_init) / sqrtf(ss * (1.0f / 128.0f) + EPS);
      const bf16* gp = (const bf16*)(Pb + (size_t)(qb * 128) * (INC * 2) + C_DG * 2 + (unsigned)((row * INC + cq * 32) * 2));
      bf16* yp = (bf16*)((char*)A.y + ((size_t)(b * SEQ + qb * 128) * DM + Y_D + h * 128) * 2 + (unsigned)((row * DM + cq * 32) * 2)); const float* gh = A.ghead + cq * 32;
#pragma unroll
      for (int i = 0; i < 4; ++i) { const bf16x8 g8 = *reinterpret_cast<const bf16x8*>(gp + 8 * i); const f32x4 h0 = *(const f32x4*)(gh + 8 * i), h1 = *(const f32x4*)(gh + 8 * i + 4);
          const f32x4 a = v[2 * i] * h0 * rn, bq = v[2 * i + 1] * h1 * rn;
          u32x4 w; w.x = cvtpk(a.x * silu(bf2f(g8[0])), a.y * silu(bf2f(g8[1]))); w.y = cvtpk(a.z * silu(bf2f(g8[2])), a.w * silu(bf2f(g8[3])));
          w.z = cvtpk(bq.x * silu(bf2f(g8[4])), bq.y * silu(bf2f(g8[5]))); w.w = cvtpk(bq.z * silu(bf2f(g8[6])), bq.w * silu(bf2f(g8[7])));
          *(u32x4*)(yp + 8 * i) = w; } }
    __syncthreads();
#undef tid
#undef r32
#undef hi
}

__device__ __forceinline__ int next_item(unsigned* ctr, char* lds, int tid) {
    int* slot = (int*)(lds + 131072 + 3072);
    if (tid == 0) *slot = (int)atomicAdd(ctr, 1u);
    __syncthreads();
    return __builtin_amdgcn_readfirstlane(*slot);
}

struct MemArgs { const bf16* proj; const bf16* mkv; bf16* y; const float* gmq; const float* gmk; int layer; };
__device__ __forceinline__ void mem_unit(const MemArgs& A, int unit, char* lds, int wv) {
    const int tid = opaque_tid(wv), wid = __builtin_amdgcn_readfirstlane(tid >> 6), lane = tid & 63, r32 = lane & 31, hi = lane >> 5;
    const int b = unit / (4 * 32), hm = (unit / 32) % 4, qb = unit % 32;
    const bf16* Kh = A.mkv + (size_t)b * NMEM * MKVC + A.layer * 1024 + hm * 128;
    const bf16* Vh = Kh + 512;
    char* V_lds = lds; char* K_lds = lds + 4 * SHM_V;
    float* wsl = (float*)(lds + 131072) + wid * 64;
    float nM2;
    { const float a = wave_max(fmaxf(fabsf(A.gmq[lane]), fabsf(A.gmq[lane + 64]))), bb = wave_max(fmaxf(fabsf(A.gmk[lane]), fabsf(A.gmk[lane + 64])));
      nM2 = -(11.3137085f * a * bb * LOG2E * 1.03f + 0.25f); }
    { const int sr = tid >> 4, sc = (tid & 15) * 8, kc = sc * 2;
      const f32x4 g0 = *(const f32x4*)(A.gmk + sc), g1 = *(const f32x4*)(A.gmk + sc + 4);
#pragma unroll
      for (int t = 0; t < 4; ++t)
#pragma unroll
        for (int hh = 0; hh < 2; ++hh) { const int key = t * 64 + hh * 32 + sr;
          const bf16x8 v8 = *reinterpret_cast<const bf16x8*>(&Vh[(size_t)key * MKVC + sc]); const bf16x8 k8 = *reinterpret_cast<const bf16x8*>(&Kh[(size_t)key * MKVC + sc]);
          float f[8]; float ss = 0.f;
#pragma unroll
          for (int i = 0; i < 8; ++i) { f[i] = bf2f((unsigned short)k8[i]); ss += f[i] * f[i]; }
          ss += swz_xor<1>(ss); ss += swz_xor<2>(ss); ss += swz_xor<4>(ss); ss += swz_xor<8>(ss);
          const float rn = 1.0f / sqrtf(ss * (1.0f / 128.0f) + EPS);
          u32x4 w; w.x = cvtpk(f[0] * rn * g0.x, f[1] * rn * g0.y); w.y = cvtpk(f[2] * rn * g0.z, f[3] * rn * g0.w); w.z = cvtpk(f[4] * rn * g1.x, f[5] * rn * g1.y); w.w = cvtpk(f[6] * rn * g1.z, f[7] * rn * g1.w);
          *(u32x4*)(K_lds + t * SHM_K + KSWZ(hh * 32 + sr, kc)) = w;
          { const int ks_ = hh * 32 + sr, kp_ = (ks_ & ~0xC) | ((ks_ & 4) << 1) | ((ks_ & 8) >> 1);
            *(bf16x8*)(V_lds + t * SHM_V + v_st(kp_, sc)) = v8; } } }
    bf16x8 qr[8];
    const size_t grow0 = (size_t)b * SEQ + qb * 256 + wid * 32;
    { const bf16* Qw = A.proj + (grow0 + r32) * INC + C_MQ + hm * 128 + hi * 8;
      bf16x8 raw[8]; float ss = 0.f;
#pragma unroll
      for (int d0 = 0; d0 < 8; ++d0) { raw[d0] = *reinterpret_cast<const bf16x8*>(Qw + d0 * 16);
#pragma unroll
          for (int i = 0; i < 8; ++i) { const float f = bf2f((unsigned short)raw[d0][i]); ss += f * f; } }
      { auto rr = __builtin_amdgcn_permlane32_swap(__float_as_uint(ss), __float_as_uint(ss), false, false); ss = __uint_as_float(rr[0]) + __uint_as_float(rr[1]); }
      const float rn = QSCALE_M / sqrtf(ss * (1.0f / 128.0f) + EPS);
#pragma unroll
      for (int d0 = 0; d0 < 8; ++d0) { const f32x4 g0 = *(const f32x4*)(A.gmq + d0 * 16 + hi * 8), g1 = *(const f32x4*)(A.gmq + d0 * 16 + hi * 8 + 4);
          u32x4 w; w.x = cvtpk(bf2f((unsigned short)raw[d0][0]) * rn * g0.x, bf2f((unsigned short)raw[d0][1]) * rn * g0.y); w.y = cvtpk(bf2f((unsigned short)raw[d0][2]) * rn * g0.z, bf2f((unsigned short)raw[d0][3]) * rn * g0.w);
          w.z = cvtpk(bf2f((unsigned short)raw[d0][4]) * rn * g1.x, bf2f((unsigned short)raw[d0][5]) * rn * g1.y); w.w = cvtpk(bf2f((unsigned short)raw[d0][6]) * rn * g1.z, bf2f((unsigned short)raw[d0][7]) * rn * g1.w);
          qr[d0] = *reinterpret_cast<bf16x8*>(&w); } }
    __syncthreads();
    float l_reg = 0; f32x16 o[4] = {};
    const int vb0 = (int)(uintptr_t)V_lds + v_rd_base(lane);
#pragma unroll 1
    for (int t = 0; t < 4; ++t) {
        f32x16 p0, p1; bf16x8 pa0, pa1, pa2, pa3;
#pragma unroll
        for (int r = 0; r < 16; ++r) { p0[r] = nM2; p1[r] = nM2; }
        qkt<8>(p0, p1, K_lds + t * SHM_K, qr, r32, hi, 0);
        exp_half(p0); exp_half(p1); pack_p(p0, p1, l_reg, pa0, pa1, pa2, pa3); SBAR();
        pv_d0(o, vb0 + t * SHM_V, pa0, pa1, pa2, pa3);
    }
    { auto rr = __builtin_amdgcn_permlane32_swap(__float_as_uint(l_reg), __float_as_uint(l_reg), false, false);
      l_reg = __uint_as_float(rr[0]) + __uint_as_float(rr[1]); }
    if (hi == 0) wsl[r32] = l_reg;
    asm volatile("s_waitcnt lgkmcnt(0)" ::: "memory");
#pragma unroll
    for (int r = 0; r < 16; ++r) { const int rr_ = crow(r, hi); const float rl = 1.0f / wsl[rr_];
        const bf16* gp = A.proj + (grow0 + rr_) * INC + C_MG + hm * 128 + r32; bf16* yp = A.y + (grow0 + rr_) * DM + Y_M + hm * 128 + r32;
#pragma unroll
        for (int d0 = 0; d0 < 4; ++d0) { const float g = bf2f(gp[d0 * 32]); const float val = o[d0][r] * rl * silu(g);
            yp[d0 * 32] = (bf16)(cvtpk(val, val) & 0xffffu); } }
    __syncthreads();
}

struct ConvArgs { const bf16* proj; bf16* y; const float* w; const float* bias; };
__device__ __forceinline__ void conv_items(const ConvArgs& A, long first, long stride) {
    constexpr long NIT = (long)(MTOK / 4) * 96;
    for (long it = first; it < NIT; it += stride) {
        const int row0 = (int)(it / 96) * 4, c8 = (int)(it % 96) * 8, t0 = row0 & (SEQ - 1);
        const bf16* p = A.proj + (size_t)row0 * INC + c8;
        bf16x8 xr[6], cr[6], br[4], gr[4];
#pragma unroll
        for (int i = 0; i < 6; ++i) { const int t = t0 - 1 + i; const bool ok = (t >= 0) && (t < SEQ);
            xr[i] = ok ? *reinterpret_cast<const bf16x8*>(p + (long)(i - 1) * INC + C_AX) : bf16x8{}; cr[i] = ok ? *reinterpret_cast<const bf16x8*>(p + (long)(i - 1) * INC + C_AC) : bf16x8{}; }
#pragma unroll
        for (int i = 0; i < 4; ++i) { br[i] = *reinterpret_cast<const bf16x8*>(p + (long)i * INC + C_AB); gr[i] = *reinterpret_cast<const bf16x8*>(p + (long)i * INC + C_AG); }
        float w0[8], w1[8], w2[8], bb[8];
#pragma unroll
        for (int i = 0; i < 2; ++i) { const f32x4 a = *(const f32x4*)(A.w + c8 + 4 * i), bq = *(const f32x4*)(A.w + 768 + c8 + 4 * i), cc = *(const f32x4*)(A.w + 1536 + c8 + 4 * i), dd = *(const f32x4*)(A.bias + c8 + 4 * i);
#pragma unroll
            for (int k = 0; k < 4; ++k) { w0[4 * i + k] = a[k]; w1[4 * i + k] = bq[k]; w2[4 * i + k] = cc[k]; bb[4 * i + k] = dd[k]; } }
        float u[6][8];
#pragma unroll
        for (int i = 0; i < 6; ++i)
#pragma unroll
            for (int k = 0; k < 8; ++k) u[i][k] = bf2f((unsigned short)cr[i][k]) * bf2f((unsigned short)xr[i][k]);
#pragma unroll
        for (int j = 0; j < 4; ++j) { float out[8];
#pragma unroll
            for (int k = 0; k < 8; ++k) { const float z = u[j][k] * w0[k] + u[j + 1][k] * w1[k] + u[j + 2][k] * w2[k] + bb[k];
                out[k] = bf2f((unsigned short)br[j][k]) * z * silu(bf2f((unsigned short)gr[j][k])); }
            u32x4 w; w.x = cvtpk(out[0], out[1]); w.y = cvtpk(out[2], out[3]); w.z = cvtpk(out[4], out[5]); w.w = cvtpk(out[6], out[7]);
            *(u32x4*)(A.y + (size_t)(row0 + j) * DM + Y_A + c8) = w; }
    }
}
}

using att::bf16;
typedef float f32x4_t __attribute__((ext_vector_type(4)));
typedef unsigned u32x4_t __attribute__((ext_vector_type(4)));
typedef unsigned u32x2_t __attribute__((ext_vector_type(2)));

__device__ __forceinline__ void transpose_item(const float* __restrict__ W, int K, int N, const float* __restrict__ gain, bf16* __restrict__ WT, float* scr, int item, int lane) {
    const int nblk = N / 32, kb = item / nblk, nb = item % nblk, k0 = 64 * kb, n0 = 32 * nb;
    float wv_[32], gv_[32];
    const float* wp_ = W + (size_t)(k0 + (lane >> 5)) * N + n0 + (lane & 31);
#pragma unroll
    for (int i = 0; i < 32; ++i) { wv_[i] = wp_[(size_t)(2 * i) * N]; gv_[i] = gain ? gain[k0 + 2 * i + (lane >> 5)] : 1.0f; }
#pragma unroll
    for (int i = 0; i < 32; ++i) scr[(2 * i + (lane >> 5)) * 33 + (lane & 31)] = wv_[i] * gv_[i];
    __builtin_amdgcn_s_waitcnt(0xc07f); asm volatile("s_waitcnt lgkmcnt(0)" ::: "memory");
    const int g8 = (n0 & 255) >> 5, n0p = (n0 & ~255) + 128 * (g8 & 1) + 32 * (g8 >> 1);
    const int c = lane & 7;
#pragma unroll
    for (int j = 0; j < 4; ++j) { const int n = (lane >> 3) + 8 * j; const float* s = scr + (8 * c) * 33 + n;
        u32x4_t o; o.x = pg8::cvt_pk_bf16(s[0 * 33], s[1 * 33]); o.y = pg8::cvt_pk_bf16(s[2 * 33], s[3 * 33]); o.z = pg8::cvt_pk_bf16(s[4 * 33], s[5 * 33]); o.w = pg8::cvt_pk_bf16(s[6 * 33], s[7 * 33]);
        *(u32x4_t*)(WT + (size_t)(n0p + n) * K + k0 + 8 * c) = o; }
    asm volatile("s_waitcnt lgkmcnt(0)" ::: "memory");
}
__device__ __forceinline__ void row_to_bf16(const float* __restrict__ xrow, bf16* __restrict__ orow, float* __restrict__ ssrow, int lane) {
    const f32x4_t* xr = (const f32x4_t*)xrow + lane; f32x4_t v[8]; float s = 0.f;
#pragma unroll
    for (int j = 0; j < 8; ++j) { v[j] = xr[64 * j]; s += (v[j].x * v[j].x + v[j].y * v[j].y) + (v[j].z * v[j].z + v[j].w * v[j].w); }
    s = att::wave_sum(s);
    u32x2_t* o8 = (u32x2_t*)orow + lane;
#pragma unroll
    for (int j = 0; j < 8; ++j) { u32x2_t w; w.x = pg8::cvt_pk_bf16(v[j].x, v[j].y); w.y = pg8::cvt_pk_bf16(v[j].z, v[j].w); o8[64 * j] = w; }
    if (lane < 32) ssrow[lane] = (lane == 0) ? s : 0.f;
}


#define XB_TMO      128
#define XB_XCNT(j)  (256  + 64 * (j))
#define XB_XSUB(j)  (1280 + 64 * (j))
#define XB_XGEN(j)  (2304 + 64 * (j))
#define XB_TOP      3328
#define XB_TOPGEN   3392
#define XCD_BAR_WORDS 3456
#define XB_SPIN_CAP (1u << 18)
#define LAS __attribute__((address_space(3)))

__device__ __forceinline__ unsigned xb_ld(unsigned* p)              { return __hip_atomic_load(p, __ATOMIC_RELAXED, __HIP_MEMORY_SCOPE_AGENT); }
__device__ __forceinline__ unsigned xb_add(unsigned* p, unsigned v) { return __hip_atomic_fetch_add(p, v, __ATOMIC_RELAXED, __HIP_MEMORY_SCOPE_AGENT); }
__device__ __forceinline__ unsigned xb_xcc_id() { return (unsigned)__builtin_amdgcn_s_getreg((3 << 11) | 20) & 0xFu; }
#define XB_SPIN(cond, bar) do { unsigned _sp = 0; while (cond) { __builtin_amdgcn_s_sleep(1); \
    if ((++_sp & 255u) == 0u) { if (xb_ld(&(bar)[XB_TMO])) break; if (_sp > XB_SPIN_CAP) { atomicAdd(&(bar)[XB_TMO], 1u); break; } } } } while (0)

struct XcdBarrier {
    unsigned* bar; unsigned x;
    volatile LAS unsigned* st;
};

__device__ __forceinline__ XcdBarrier xcd_barrier_post(unsigned* bar, volatile LAS unsigned* st) {
    XcdBarrier b; b.bar = bar; b.x = xb_xcc_id(); b.st = st;
    if (threadIdx.x == 0) (void)xb_add(&bar[XB_XCNT(b.x)], 1u);
    return b;
}
__device__ __forceinline__ void xcd_barrier_complete(unsigned* bar, unsigned x, unsigned& nloc, unsigned& nx) {
    const unsigned G = gridDim.x * gridDim.y * gridDim.z;
    unsigned sum, cnt, mine, sp = 0u;
    for (;;) {
        sum = 0u; cnt = 0u; mine = 0u;
#pragma unroll
        for (unsigned j = 0; j < 16; ++j) { const unsigned c = xb_ld(&bar[XB_XCNT(j)]); sum += c; cnt += (c > 0u) ? 1u : 0u; mine = (j == x) ? c : mine; }
        if (sum == G) break;
        __builtin_amdgcn_s_sleep(1);
        if ((++sp & 255u) == 0u) { if (xb_ld(&bar[XB_TMO])) break; if (sp > XB_SPIN_CAP) { atomicAdd(&bar[XB_TMO], 1u); break; } }
    }
    nloc = mine > 0u ? mine : 1u; nx = cnt > 0u ? cnt : 1u;
}

__device__ __forceinline__ void xcd_barrier(const XcdBarrier& b) {
    asm volatile("s_waitcnt vmcnt(0)" ::: "memory");
    __syncthreads();
    if (threadIdx.x == 0) {
        unsigned* bar = b.bar;
        __builtin_amdgcn_s_waitcnt(0);
        unsigned nloc = b.st[0], nx = b.st[1];
        if (nloc == 0u) { xcd_barrier_complete(bar, b.x, nloc, nx); b.st[0] = nloc; b.st[1] = nx; }
        const unsigned old = xb_add(&bar[XB_XSUB(b.x)], 1u);
        const unsigned gen = old / nloc;
        if (old + 1u == (gen + 1u) * nloc) {
            __builtin_amdgcn_fence(__ATOMIC_RELEASE, "agent");
            asm volatile("s_waitcnt vmcnt(0)" ::: "memory");
            const unsigned og = xb_add(&bar[XB_TOP], 1u);
            const unsigned tg = og / nx;
            if (og + 1u == (tg + 1u) * nx) xb_add(&bar[XB_TOPGEN], 1u);
            else XB_SPIN(xb_ld(&bar[XB_TOPGEN]) == tg, bar);
            __builtin_amdgcn_fence(__ATOMIC_ACQUIRE, "agent");
            xb_add(&bar[XB_XGEN(b.x)], 1u);
            asm volatile("s_waitcnt vmcnt(0)" ::: "memory");
        } else {
            XB_SPIN(xb_ld(&bar[XB_XGEN(b.x)]) == gen, bar);
            __builtin_amdgcn_fence(__ATOMIC_ACQUIRE, "agent");
            asm volatile("s_waitcnt vmcnt(0)" ::: "memory");
        }
    }
    __syncthreads();
}

struct Args { const float* in[18]; float* out; unsigned char* ws; int ph_lo, ph_hi; };
constexpr int NPHASE = 2 + 3 * DEPTH;

__global__ void __launch_bounds__(512) fwd_megakernel(Args args) {
    extern __shared__ __attribute__((aligned(16))) unsigned char lds[];
    cg::grid_group grid = cg::this_grid();
    const int tid = threadIdx.x, lane = tid & 63, wave = __builtin_amdgcn_readfirstlane(tid >> 6);
    const int G = gridDim.x, bx = blockIdx.x;
    unsigned char* ws = args.ws;
    bf16* WinT = (bf16*)(ws + WS_WIN); bf16* WoutT = (bf16*)(ws + WS_WOUT); bf16* WmemT = (bf16*)(ws + WS_WMEM);
    bf16* xb = (bf16*)(ws + WS_XB); bf16* memb = (bf16*)(ws + WS_MEMB); bf16* mkv = (bf16*)(ws + WS_MKV);
    float* ssq = (float*)(ws + WS_SSQ); float* ssqm = (float*)(ws + WS_SSQM);
    bf16* proj = (bf16*)(ws + WS_PROJ); bf16* yb = (bf16*)(ws + WS_Y);
    const int lo = args.ph_lo, hi = args.ph_hi;
#define IN(k) (lo <= (k) && (k) < hi)
    volatile LAS unsigned* xb_st = (volatile LAS unsigned*)((LAS unsigned char*)lds + 131072 + 3584);
    if (threadIdx.x < 4) xb_st[threadIdx.x] = 0u;
    __syncthreads();
    XcdBarrier xbar; xbar.bar = (unsigned*)(ws + WS_BAR); xbar.x = 0; xbar.st = xb_st;
#define SEAM(k) do { if (IN(k) && IN((k) + 1)) { if ((k) == 0) { grid.sync(); xbar = xcd_barrier_post((unsigned*)(ws + WS_BAR), xb_st); } else xcd_barrier(xbar); } } while (0)

#ifndef NO_PRO
    if (IN(0)) {
        float* scr = (float*)lds + wave * (64 * 33);
        const int gw = bx * 8 + wave, NGW = G * 8;
        constexpr int I_IN = (DM / 64) * (INC / 32), I_OUT = (DM / 64) * (DM / 32), I_MEM = (DM / 64) * (1024 / 32);
        constexpr int NITEMS = DEPTH * (I_IN + I_OUT + I_MEM);
        for (int it = gw; it < NITEMS; it += NGW) {
            int r = it;
            if (r < DEPTH * I_IN) { const int l = r / I_IN; r -= l * I_IN;
                transpose_item(args.in[3] + (size_t)l * DM * INC, DM, INC, args.in[2] + l * DM, WinT + (size_t)l * INC * DM, scr, r, lane); continue; }
            r -= DEPTH * I_IN;
            if (r < DEPTH * I_OUT) { const int l = r / I_OUT; r -= l * I_OUT;
                transpose_item(args.in[17] + (size_t)l * DM * DM, DM, DM, nullptr, WoutT + (size_t)l * DM * DM, scr, r, lane); continue; }
            r -= DEPTH * I_OUT;
            { const int l = r / I_MEM; r -= l * I_MEM;
                transpose_item(args.in[14] + (size_t)l * DM * 1024, DM, 1024, args.in[13] + l * DM, WmemT + (size_t)l * 1024 * DM, scr, r, lane); }
        }
        for (int m = gw; m < MTOK + MMEM; m += NGW) {
            if (m < MTOK) row_to_bf16(args.in[0] + (size_t)m * DM, xb + (size_t)m * DM, ssq + (size_t)m * 32, lane);
            else { const int mm = m - MTOK; row_to_bf16(args.in[1] + (size_t)mm * DM, memb + (size_t)mm * DM, ssqm + (size_t)mm * 32, lane); }
        }
        if (bx == 0 && opaque_tid(wave) < 16) ((unsigned*)(ws + WS_CTR))[opaque_tid(wave)] = 0u;
        if (bx == 0) for (int i_ = opaque_tid(wave); i_ < XCD_BAR_WORDS; i_ += 512) ((unsigned*)(ws + WS_BAR))[i_] = 0u;
        __syncthreads();
    }
#endif
    SEAM(0);
#ifndef NO_G1
    if (IN(1)) {
        pg8::Gemm g{memb, WmemT, MMEM, MKVC, DM}; pg8::StaticOrder S; S.init(MMEM, MKVC, G, bx);
        pg8::EpiProj E{mkv, MKVC, ssqm, nullptr, nullptr, 0, 0, 0, 0, 1.f};
        pg8::gemm_phase<pg8::EpiProj, pg8::StaticOrder, true, true>((PG8_LAS unsigned char*)lds, g, S, E, wave);
    }
#endif
#pragma unroll 1
    for (int l = 0; l < DEPTH; ++l) {
        const int pA = 2 + 3 * l, pB = pA + 1, pC = pA + 2;
#ifndef NO_G2
        if (IN(pA)) {
            pg8::Gemm g{xb, WinT + (size_t)l * INC * DM, MTOK, INC, DM}; pg8::StaticOrder S; S.init(MTOK, INC, G, bx);
            pg8::EpiProj E{proj, INC, ssq, args.in[6] + l * 64, args.in[7] + l * 64, C_DQ / 256, C_DK / 256, C_DK / 256, C_DV / 256, QSCALE_D};
            pg8::gemm_phase<pg8::EpiProj, pg8::StaticOrder, true, true>((PG8_LAS unsigned char*)lds, g, S, E, wave);
        }
#endif
        SEAM(pA);
        if (IN(pB)) {
            att::DiffArgs DA{proj, yb, args.in[12] + l * 128, 0, 0, 0};
            { const int ln = opaque_tid(wave) & 63;
              const float mq = att::wave_max(fabsf(args.in[6][l * 64 + ln])), mk = att::wave_max(fabsf(args.in[7][l * 64 + ln]));
              const float s1 = att::wave_sum(args.in[8][l * 64 + ln] * args.in[9][l * 64 + ln]), s2 = att::wave_sum(args.in[10][l * 64 + ln] * args.in[11][l * 64 + ln]);
              const int cb = (l == 0) ? 0x3e4ccccd : (l == 1) ? 0x3eb60549 : (l == 2) ? 0x3ef1014c : 0x3f0e59d5;
              const float li = __int_as_float(cb);
              DA.nM2b = att::to_sgpr(__float_as_int(-(8.0f * mq * mk * LOG2E * 1.03f + 0.25f))); DA.lamb = att::to_sgpr(__float_as_int(expf(s1) - expf(s2) + li)); DA.laminitb = att::to_sgpr(cb); }
            att::MemArgs MA{proj, mkv, yb, args.in[15] + l * 128, args.in[16] + l * 128, l};
            unsigned* ctr = (unsigned*)(ws + WS_CTR) + l;
            att::ConvArgs CA{proj, yb, args.in[4] + l * 3 * 768, args.in[5] + l * 768};
            for (;;) { const int it = att::next_item(ctr, (char*)lds, opaque_tid(wave));
                if (it >= 768 + 256 + 256) break;
                if (it < 768) { const int r = it & 127; att::diff_unit(DA, r >> 6, 5 - (it >> 7), r & 63, (char*)lds, wave); }
                else if (it < 1024) { att::conv_items(CA, (long)(it - 768) * 512 + opaque_tid(wave), 256L * 512); __syncthreads(); }
                else att::mem_unit(MA, it - 1024, (char*)lds, wave); }
        }
        SEAM(pB);
#ifndef NO_G3
        if (IN(pC)) {
            pg8::Gemm g{yb, WoutT + (size_t)l * DM * DM, MTOK, DM, DM}; pg8::StaticOrder S; S.init(MTOK, DM, G, bx);
            pg8::EpiOut E{args.out, xb, ssq, (l == DEPTH - 1) ? 1 : 0};
            pg8::gemm_phase<pg8::EpiOut, pg8::StaticOrder, true, true>((PG8_LAS unsigned char*)lds, g, S, E, wave);
        }
#endif
        if (l + 1 < DEPTH) SEAM(pC);
    }
#undef IN
#undef SEAM
}

extern "C" void kernel_launch(void* const* d_in, const int* in_sizes, int n_in, void* d_out, int out_size, void* d_ws, size_t ws_size, hipStream_t stream) {
    static int grid = 0;
    if (grid == 0) {
        if (n_in != 18 || in_sizes[0] != MTOK * DM || out_size != MTOK * DM || ws_size < WS_END) { fprintf(stderr, "kernel_launch: unexpected shapes (n_in %d, in0 %d, out %d, ws %zu)\n", n_in, n_in > 0 ? in_sizes[0] : -1, out_size, ws_size); grid = -1; return; }
        int dev = 0, cus = 0, per_cu = 0;
        if (hipGetDevice(&dev) != hipSuccess || hipDeviceGetAttribute(&cus, hipDeviceAttributeMultiprocessorCount, dev) != hipSuccess) { grid = -1; return; }
        if (hipFuncSetAttribute((const void*)fwd_megakernel, hipFuncAttributeMaxDynamicSharedMemorySize, LDS_BYTES) != hipSuccess) { fprintf(stderr, "kernel_launch: hipFuncSetAttribute failed\n"); grid = -1; return; }
        if (hipOccupancyMaxActiveBlocksPerMultiprocessor(&per_cu, (const void*)fwd_megakernel, 512, LDS_BYTES) != hipSuccess || per_cu < 1) { fprintf(stderr, "kernel_launch: occupancy query says %d blocks per CU\n", per_cu); per_cu = 1; }
        (void)hipGetLastError();
        grid = cus * 1;
    }
    if (grid < 0) return;
    Args a{};
    for (int i = 0; i < 18; ++i) a.in[i] = (const float*)d_in[i];
    a.out = (float*)d_out; a.ws = (unsigned char*)d_ws;
#if MK_ONE_LAUNCH
    a.ph_lo = 0; a.ph_hi = NPHASE;
    void* kargs[] = {&a};
    hipError_t e = hipLaunchCooperativeKernel((const void*)fwd_megakernel, dim3(grid), dim3(512), kargs, LDS_BYTES, stream);
    if (e != hipSuccess) fprintf(stderr, "kernel_launch: cooperative launch failed: %s (grid %d)\n", hipGetErrorString(e), grid);
#else
    for (int p = 0; p < NPHASE; ++p) { a.ph_lo = p; a.ph_hi = p + 1;
        hipLaunchKernelGGL(fwd_megakernel, dim3(grid), dim3(512), LDS_BYTES, stream, a);
        const hipError_t le = hipPeekAtLastError();
        if (le != hipSuccess) { fprintf(stderr, "kernel_launch: launch %d failed: %s\n", p, hipGetErrorName(le)); break; } }
#endif
}
```

```cpp
#include <hip/hip_runtime.h>
#include <hip/hip_cooperative_groups.h>
#include <cstdio>
#include <cstdint>
namespace cg = cooperative_groups;

#ifndef DIFF_ANTIPHASE
#define DIFF_ANTIPHASE 1
#endif
#ifndef MK_ONE_LAUNCH
#define MK_ONE_LAUNCH 1
#endif

constexpr int DM = 2048, BATCH = 2, SEQ = 8192, DEPTH = 4, NMEM = 256, MTOK = BATCH * SEQ, INC = 7168, MKVC = 4096, MMEM = BATCH * NMEM;
constexpr int C_AX = 0, C_AB = 768, C_AC = 1536, C_AG = 2304, C_DQ = 3072, C_DK = 3840, C_DV = 4608, C_DG = 5376, C_MQ = 6144, C_MG = 6656;
constexpr int Y_A = 0, Y_D = 768, Y_M = 1536;
constexpr float EPS = 1e-6f, LOG2E = 1.4426950408889634f;
constexpr float QSCALE_D = 0.125f * LOG2E;
constexpr float QSCALE_M = 0.08838834764831845f * LOG2E;
constexpr size_t MiB = 1u << 20;
constexpr size_t WS_WIN = 0, WS_WOUT = 112 * MiB, WS_WMEM = 144 * MiB, WS_XB = 160 * MiB, WS_MEMB = 224 * MiB, WS_MKV = 226 * MiB, WS_SSQ = 230 * MiB, WS_SSQM = 232 * MiB, WS_CTR = 233 * MiB, WS_BAR = 234 * MiB,
                 WS_PROJ = 240 * MiB, WS_Y = 464 * MiB, WS_END = 528 * MiB;
constexpr int LDS_BYTES = 131072 + 4096;
__device__ __forceinline__ int opaque_tid(int wv) { int lane_; asm volatile("v_mbcnt_lo_u32_b32 %0, -1, 0\n\tv_mbcnt_hi_u32_b32 %0, -1, %0" : "=v"(lane_)); return wv * 64 + lane_; }
template <int X> __device__ __forceinline__ float swz_xor(float v) { return __int_as_float(__builtin_amdgcn_ds_swizzle(__float_as_int(v), (X << 10) | 0x1f)); }
__device__ __forceinline__ float xsum32(float v) { auto rr = __builtin_amdgcn_permlane32_swap(__float_as_uint(v), __float_as_uint(v), false, false); return __uint_as_float(rr[0]) + __uint_as_float(rr[1]); }
__device__ __forceinline__ float xmax32(float v) { auto rr = __builtin_amdgcn_permlane32_swap(__float_as_uint(v), __float_as_uint(v), false, false); return fmaxf(__uint_as_float(rr[0]), __uint_as_float(rr[1])); }
namespace pg8 {
#define PG8_LAS __attribute__((address_space(3)))
typedef unsigned short bf16_t;
typedef short bf16x8 __attribute__((ext_vector_type(8)));
typedef float f32x4 __attribute__((ext_vector_type(4)));
typedef unsigned u32x4 __attribute__((ext_vector_type(4)));
constexpr int BM = 256, BK = 64, HALF = 128, HTB = HALF * BK * 2  , STAGE_BYTES = 8 * HTB, NXCD = 8, WGM = 8;

__host__ __device__ __forceinline__ int lds_byte(int r, int c) { const int st = (r >> 4) * 2 + (c >> 5), rr = r & 15, cc = c & 31, ob = rr * 64 + cc * 2; return st * 1024 + (ob ^ (((ob >> 9) & 1) << 5)); }
__host__ __device__ __forceinline__ void stage_rc(int b, int& R, int& C) { const int st = b / 1024, sb = b % 1024, swz = sb ^ (((sb >> 9) & 1) << 5); R = (st >> 1) * 16 + swz / 64; C = (st & 1) * 32 + (swz % 64) / 2; }
__host__ __device__ __forceinline__ int perm32(int rho) { const int n = rho >> 4, i = rho & 15; return 8 * (i >> 2) + 4 * n + (i & 3); }

struct Unit { int pm, pn; };
struct Gemm { const bf16_t* A; const bf16_t* Bt; int M, N, K; };

struct StaticOrder {
    int nM, nN, nwg, G, c;
    __host__ __device__ void init(int M, int N, int G_, int c_) { nM = M / BM; nN = N / BM; nwg = nM * nN; G = G_; c = c_; }
    __host__ __device__ bool next(int i, Unit& u) const {
        const long L = (long)i * G + c; if (L >= nwg) return false;
        int wgid = (int)L; { const int q = nwg / NXCD, r = nwg % NXCD, xcd = wgid % NXCD, off = wgid / NXCD; wgid = (xcd < r ? xcd * (q + 1) : r * (q + 1) + (xcd - r) * q) + off; }
        const int nig = WGM * nN, gid = wgid / nig, fm = gid * WGM, gsz = (nM - fm) < WGM ? (nM - fm) : WGM;
        u.pm = fm + ((wgid % nig) % gsz); u.pn = (wgid % nig) / gsz; return true;
    }
    __device__ __forceinline__ void a_ready(const Unit&) const {}
    __device__ __forceinline__ void done(const Unit&) const {}
};


__device__ __forceinline__ unsigned cvt_pk_bf16(float lo, float hi) { unsigned r; asm volatile("v_cvt_pk_bf16_f32 %0, %1, %2" : "=v"(r) : "v"(lo), "v"(hi)); return r; }

struct EpiProj {
    static constexpr bool PERM = true, AFTER_DRAIN = false;
    bf16_t* O; int ldc; const float* ssq; const float* gq; const float* gk; int qlo, qhi, klo, khi; float qscale;
    const PG8_LAS float* rs; int pm0;
    __device__ __forceinline__ void operator()(const f32x4 (&acc)[2][2][4][2], const Unit& u, int wr, int wc, int fr, int fq) const {
        const int row0 = u.pm * BM + wr * 64 + fr, colw = u.pn * BM + wc * 64 + 8 * fq;
        const int mode = (u.pn >= qlo && u.pn < qhi) ? 1 : ((u.pn >= klo && u.pn < khi) ? 2 : 0);
        float rv[2][4];
        if (u.pm == pm0) {
#pragma unroll
            for (int ai = 0; ai < 2; ++ai)
#pragma unroll
                for (int m = 0; m < 4; ++m) rv[ai][m] = rs[wr * 64 + fr + ai * HALF + m * 16];
        } else {
#pragma unroll
            for (int ai = 0; ai < 2; ++ai)
#pragma unroll
                for (int m = 0; m < 4; ++m) { const int row = row0 + ai * HALF + m * 16;
                    const f32x4* sp = (const f32x4*)(ssq + (size_t)row * 32 + 8 * fq); const f32x4 sa = sp[0], sb = sp[1];
                    float s = ((sa.x + sa.y) + (sa.z + sa.w)) + ((sb.x + sb.y) + (sb.z + sb.w)); s += swz_xor<16>(s); s = xsum32(s);
                    rv[ai][m] = __builtin_amdgcn_rsqf(s * (1.0f / 2048.0f) + 1e-6f); }
        }
        if (mode == 0) {
#pragma unroll
            for (int ai = 0; ai < 2; ++ai)
#pragma unroll
                for (int m = 0; m < 4; ++m) { const float r = rv[ai][m]; bf16_t* rowp = O + (size_t)(row0 + ai * HALF + m * 16) * ldc + colw;
#pragma unroll
                    for (int bj = 0; bj < 2; ++bj) { const f32x4 v0 = acc[ai][bj][m][0] * r, v1 = acc[ai][bj][m][1] * r;
                        u32x4 w; w.x = cvt_pk_bf16(v0[0], v0[1]); w.y = cvt_pk_bf16(v0[2], v0[3]); w.z = cvt_pk_bf16(v1[0], v1[1]); w.w = cvt_pk_bf16(v1[2], v1[3]);
                        *(u32x4*)(rowp + 32 * bj) = w; } }
            return; }
        f32x4 gv[2][2];
        { const float* g = (mode == 1) ? gq : gk; const float s = (mode == 1) ? qscale : 1.f;
#pragma unroll
            for (int bj = 0; bj < 2; ++bj)
#pragma unroll
                for (int n = 0; n < 2; ++n) gv[bj][n] = *(const f32x4*)(g + 32 * bj + 8 * fq + 4 * n) * s; }
#pragma unroll
        for (int ai = 0; ai < 2; ++ai)
#pragma unroll
            for (int m = 0; m < 4; ++m) {
                const int row = row0 + ai * HALF + m * 16;
                const float r = rv[ai][m];
                f32x4 v[2][2]; float ss = 0.f;
#pragma unroll
                for (int bj = 0; bj < 2; ++bj)
#pragma unroll
                    for (int n = 0; n < 2; ++n) { v[bj][n] = acc[ai][bj][m][n] * r; const f32x4 q = v[bj][n] * v[bj][n]; ss += (q.x + q.y) + (q.z + q.w); }
                ss += swz_xor<16>(ss); ss = xsum32(ss); const float rn = __builtin_amdgcn_rsqf(ss * (1.0f / 64.0f) + 1e-6f);
                bf16_t* rowp = O + (size_t)row * ldc + colw;
#pragma unroll
                for (int bj = 0; bj < 2; ++bj) { const f32x4 v0 = v[bj][0] * gv[bj][0] * rn, v1 = v[bj][1] * gv[bj][1] * rn;
                    u32x4 w; w.x = cvt_pk_bf16(v0[0], v0[1]); w.y = cvt_pk_bf16(v0[2], v0[3]); w.z = cvt_pk_bf16(v1[0], v1[1]); w.w = cvt_pk_bf16(v1[2], v1[3]);
                    *(u32x4*)(rowp + 32 * bj) = w; }
            }
    }
};

struct EpiOut {
    static constexpr bool PERM = true, AFTER_DRAIN = false;
    float* xout; bf16_t* xb; float* ssq; int last;
    __device__ __forceinline__ void operator()(const f32x4 (&acc)[2][2][4][2], const Unit& u, int wr, int wc, int fr, int fq) const {
        const int row0 = u.pm * BM + wr * 64 + fr, colw = u.pn * BM + wc * 64 + 8 * fq;
#pragma unroll
        for (int ai = 0; ai < 2; ++ai)
#pragma unroll
            for (int m = 0; m < 4; ++m) {
                const int row = row0 + ai * HALF + m * 16; float ss = 0.f;
#pragma unroll
                for (int bj = 0; bj < 2; ++bj) { const size_t off = (size_t)row * 2048 + colw + 32 * bj;
                    const u32x4 xw = *(const u32x4*)(xb + off);
                    f32x4 v0, v1;
                    v0.x = __uint_as_float(xw.x << 16); v0.y = __uint_as_float(xw.x & 0xffff0000u); v0.z = __uint_as_float(xw.y << 16); v0.w = __uint_as_float(xw.y & 0xffff0000u);
                    v1.x = __uint_as_float(xw.z << 16); v1.y = __uint_as_float(xw.z & 0xffff0000u); v1.z = __uint_as_float(xw.w << 16); v1.w = __uint_as_float(xw.w & 0xffff0000u);
                    v0 = v0 + acc[ai][bj][m][0]; v1 = v1 + acc[ai][bj][m][1];
                    if (last) { f32x4* op = (f32x4*)(xout + off); op[0] = v0; op[1] = v1; }
                    else { u32x4 w; w.x = cvt_pk_bf16(v0[0], v0[1]); w.y = cvt_pk_bf16(v0[2], v0[3]); w.z = cvt_pk_bf16(v1[0], v1[1]); w.w = cvt_pk_bf16(v1[2], v1[3]);
                        *(u32x4*)(xb + off) = w;
                        const f32x4 q0 = v0 * v0, q1 = v1 * v1; ss += ((q0.x + q0.y) + (q0.z + q0.w)) + ((q1.x + q1.y) + (q1.z + q1.w)); } }
                if (!last) { ss += swz_xor<16>(ss); ss = xsum32(ss);
                    if (fq == 0) ssq[(size_t)row * 32 + u.pn * 4 + wc] = ss; }
            }
    }
};

template <class Epi, class Sched, bool ALIGN_EPI = false, bool SP2 = false>
__device__ __forceinline__ void gemm_phase(PG8_LAS unsigned char* lds, const Gemm g, const Sched& S, const Epi& E, int wv) {
    const int tid = opaque_tid(wv), wid = __builtin_amdgcn_readfirstlane(tid >> 6), lane = tid & 63, wr = wid >> 2, wc = wid & 3, fr = lane & 15, fq = lane >> 4;
    const int K = g.K, nt = K / BK;
    unsigned voffA[2], voffB[2];
#pragma unroll
    for (int i = 0; i < 2; ++i) { int R, C; stage_rc(tid * 16 + i * 8192, R, C); const int Rb = Epi::PERM ? ((R & ~31) + perm32(R & 31)) : R;
        voffA[i] = (unsigned)(R * K + C) * 2u; voffB[i] = (unsigned)(Rb * K + C) * 2u; }
    const size_t kstep = (size_t)(BK * 2);
    const size_t hstep = (size_t)HALF * K * 2;
    const size_t tstep = 2 * hstep;
    const unsigned ldsw = (unsigned)wid * 1024u;
    const int aoff = lds_byte(wr * 64 + fr, fq * 8), boff = lds_byte(wc * 32 + fr, fq * 8);
#define PG8_SA(b, h) (((b) * 2 + (h)) * HTB)
#define PG8_SB(b, h) ((4 + (b) * 2 + (h)) * HTB)
#define PG8_STAGE(bufoff, gbase, voff) do { _Pragma("unroll") for (int _i = 0; _i < 2; ++_i) \
        __builtin_amdgcn_global_load_lds((const unsigned*)((const char*)(gbase) + (voff)[_i]), (PG8_LAS unsigned*)(lds + (bufoff) + ldsw + _i * 8192), 16, 0, 0); } while (0)
#define PG8_LDA(dst, b, h) do { _Pragma("unroll") for (int m = 0; m < 4; ++m) _Pragma("unroll") for (int k = 0; k < 2; ++k) dst[m][k] = *(const PG8_LAS bf16x8*)(lds + PG8_SA(b, h) + aoff + m * 2048 + k * 1024); } while (0)
#define PG8_LDB(dst, b, h) do { _Pragma("unroll") for (int n = 0; n < 2; ++n) _Pragma("unroll") for (int k = 0; k < 2; ++k) dst[n][k] = *(const PG8_LAS bf16x8*)(lds + PG8_SB(b, h) + boff + n * 2048 + k * 1024); } while (0)
#define PG8_MMA(ai, bj, At, Bt) do { __builtin_amdgcn_s_setprio(1); _Pragma("unroll") for (int m = 0; m < 4; ++m) _Pragma("unroll") for (int n = 0; n < 2; ++n) _Pragma("unroll") for (int k = 0; k < 2; ++k) \
        acc[ai][bj][m][n] = __builtin_amdgcn_mfma_f32_16x16x32_bf16(Bt[n][k], At[m][k], acc[ai][bj][m][n], 0, 0, 0); __builtin_amdgcn_s_setprio(0); } while (0)
#define PG8_WAIT_V(n) asm volatile("s_waitcnt vmcnt(" #n ")" ::: "memory")
#define PG8_WAIT_L(n) asm volatile("s_waitcnt lgkmcnt(" #n ")" ::: "memory")
#define PG8_BAR __builtin_amdgcn_s_barrier()
#define PG8_SCHED __builtin_amdgcn_sched_barrier(0)
    Unit cur, nxt; int ui = 0;
    if (!S.next(0, cur)) return;
    f32x4 acc[2][2][4][2];
#pragma unroll
    for (int a = 0; a < 2; ++a)
#pragma unroll
        for (int b = 0; b < 2; ++b)
#pragma unroll
            for (int m = 0; m < 4; ++m)
#pragma unroll
                for (int n = 0; n < 2; ++n) acc[a][b][m][n] = (f32x4){0.f, 0.f, 0.f, 0.f};
    bf16x8 At[4][2], B0[2][2], B1[2][2];
    const char* cA = (const char*)g.A + (size_t)cur.pm * tstep; const char* cB = (const char*)g.Bt + (size_t)cur.pn * tstep;
    S.a_ready(cur);
    if constexpr (SP2) {
        PG8_STAGE(PG8_SB(0, 0), cB, voffB); PG8_STAGE(PG8_SB(0, 1), cB + hstep, voffB); PG8_STAGE(PG8_SA(0, 0), cA, voffA); PG8_STAGE(PG8_SA(0, 1), cA + hstep, voffA);
        if (wr == 1) PG8_BAR;
        PG8_WAIT_V(2); PG8_BAR;
        PG8_STAGE(PG8_SB(1, 0), cB + kstep, voffB); PG8_STAGE(PG8_SA(1, 0), cA + kstep, voffA); PG8_STAGE(PG8_SB(1, 1), cB + hstep + kstep, voffB);
        PG8_WAIT_V(6); PG8_BAR;
    } else {
        PG8_STAGE(PG8_SB(0, 0), cB, voffB); PG8_STAGE(PG8_SA(0, 0), cA, voffA); PG8_STAGE(PG8_SB(0, 1), cB + hstep, voffB); PG8_STAGE(PG8_SA(0, 1), cA + hstep, voffA);
        if (wr == 1) PG8_BAR;
        PG8_WAIT_V(4); PG8_BAR;
        PG8_STAGE(PG8_SB(1, 0), cB + kstep, voffB); PG8_STAGE(PG8_SA(1, 0), cA + kstep, voffA); PG8_STAGE(PG8_SB(1, 1), cB + hstep + kstep, voffB);
        PG8_WAIT_V(6); PG8_BAR;
    }
    for (;;) {
        const bool has_next = S.next(ui + 1, nxt);
        const char* nA = has_next ? (const char*)g.A + (size_t)nxt.pm * tstep : cA; const char* nB = has_next ? (const char*)g.Bt + (size_t)nxt.pn * tstep : cB;
        for (int t = 0; t < nt; t += 2) {
            const bool last = (t == nt - 2);
            const char* a1 = cA + (size_t)(t + 1) * kstep;
            const char* a2 = last ? nA : cA + (size_t)(t + 2) * kstep; const char* b2 = last ? nB : cB + (size_t)(t + 2) * kstep;
            const char* a3 = a2 + kstep; const char* b3 = b2 + kstep;
            if (last && has_next) S.a_ready(nxt);
            if constexpr (SP2) {
            PG8_LDB(B0, 0, 0); PG8_LDB(B1, 0, 1); PG8_SCHED; PG8_LDA(At, 0, 0); PG8_STAGE(PG8_SA(1, 1), a1 + hstep, voffA);
            PG8_WAIT_V(8); PG8_WAIT_L(0); PG8_BAR; PG8_MMA(0, 0, At, B0); PG8_MMA(0, 1, At, B1); PG8_BAR; PG8_SCHED;
            PG8_LDA(At, 0, 1); PG8_STAGE(PG8_SB(0, 0), b2, voffB); PG8_STAGE(PG8_SB(0, 1), b2 + hstep, voffB); PG8_STAGE(PG8_SA(0, 0), a2, voffA);
            PG8_WAIT_V(8); PG8_WAIT_L(0); PG8_BAR; PG8_MMA(1, 0, At, B0); PG8_MMA(1, 1, At, B1); PG8_BAR; PG8_SCHED;
            PG8_LDB(B0, 1, 0); PG8_LDB(B1, 1, 1); PG8_SCHED; PG8_LDA(At, 1, 0); PG8_STAGE(PG8_SA(0, 1), a2 + hstep, voffA);
            PG8_WAIT_V(8); PG8_WAIT_L(0); PG8_BAR; PG8_MMA(0, 0, At, B0); PG8_MMA(0, 1, At, B1); PG8_BAR; PG8_SCHED;
            PG8_LDA(At, 1, 1); PG8_STAGE(PG8_SB(1, 0), b3, voffB); PG8_STAGE(PG8_SB(1, 1), b3 + hstep, voffB); PG8_STAGE(PG8_SA(1, 0), a3, voffA);
            PG8_WAIT_V(8); PG8_WAIT_L(0); PG8_BAR; PG8_MMA(1, 0, At, B0); PG8_MMA(1, 1, At, B1); PG8_BAR; PG8_SCHED;
            } else {
            PG8_LDB(B0, 0, 0); PG8_SCHED; PG8_LDA(At, 0, 0); PG8_STAGE(PG8_SA(1, 1), a1 + hstep, voffA);
            PG8_WAIT_L(8); PG8_BAR; PG8_WAIT_L(0); PG8_MMA(0, 0, At, B0); PG8_BAR; PG8_SCHED;
            PG8_LDB(B1, 0, 1); PG8_STAGE(PG8_SB(0, 0), b2, voffB);
            PG8_BAR; PG8_WAIT_L(0); PG8_MMA(0, 1, At, B1); PG8_BAR;
            PG8_LDA(At, 0, 1); PG8_STAGE(PG8_SA(0, 0), a2, voffA);
            PG8_BAR; PG8_WAIT_L(0); PG8_MMA(1, 0, At, B0); PG8_BAR; PG8_SCHED;
            PG8_STAGE(PG8_SB(0, 1), b2 + hstep, voffB);
            PG8_WAIT_V(6); PG8_BAR; PG8_MMA(1, 1, At, B1); PG8_BAR;
            PG8_LDB(B0, 1, 0); PG8_SCHED; PG8_LDA(At, 1, 0); PG8_STAGE(PG8_SA(0, 1), a2 + hstep, voffA);
            PG8_WAIT_L(8); PG8_BAR; PG8_WAIT_L(0); PG8_MMA(0, 0, At, B0); PG8_BAR; PG8_SCHED;
            PG8_LDB(B1, 1, 1); PG8_STAGE(PG8_SB(1, 0), b3, voffB);
            PG8_BAR; PG8_WAIT_L(0); PG8_MMA(0, 1, At, B1); PG8_BAR;
            PG8_LDA(At, 1, 1); PG8_STAGE(PG8_SA(1, 0), a3, voffA);
            PG8_BAR; PG8_WAIT_L(0); PG8_MMA(1, 0, At, B0); PG8_BAR; PG8_SCHED;
            PG8_STAGE(PG8_SB(1, 1), b3 + hstep, voffB);
            PG8_WAIT_V(6); PG8_BAR; PG8_MMA(1, 1, At, B1); PG8_BAR;
            }
        }
        if constexpr (ALIGN_EPI) { if (wr == 0) PG8_BAR; }
        if constexpr (!Epi::AFTER_DRAIN) { E(acc, cur, wr, wc, fr, fq); S.done(cur); }
        if (!has_next) break;
#pragma unroll
        for (int a = 0; a < 2; ++a)
#pragma unroll
            for (int b = 0; b < 2; ++b)
#pragma unroll
                for (int m = 0; m < 4; ++m)
#pragma unroll
                    for (int n = 0; n < 2; ++n) acc[a][b][m][n] = (f32x4){0.f, 0.f, 0.f, 0.f};
        cur = nxt; cA = nA; cB = nB; ++ui;
        if constexpr (ALIGN_EPI) { if (wr == 1) PG8_BAR; }
    }
    PG8_WAIT_V(0);
    if constexpr (!ALIGN_EPI) { if (wr == 0) PG8_BAR; }
    PG8_BAR;
    if constexpr (Epi::AFTER_DRAIN) { E.fused(acc, cur, wr, wc, fr, fq, lds, wid, lane); S.done(cur); }
#undef PG8_SA
#undef PG8_SB
#undef PG8_STAGE
#undef PG8_LDA
#undef PG8_LDB
#undef PG8_MMA
#undef PG8_WAIT_V
#undef PG8_WAIT_L
#undef PG8_BAR
#undef PG8_SCHED
}
}

namespace att {
using bf16 = unsigned short;
using bf16x8 = __attribute__((ext_vector_type(8))) short;
using s16x4  = __attribute__((ext_vector_type(4))) short;
using f32x16 = __attribute__((ext_vector_type(16))) float;
using f32x4  = __attribute__((ext_vector_type(4))) float;
using u32x4  = __attribute__((ext_vector_type(4))) unsigned;
constexpr int KVBLK = 64;
constexpr int SHM_V = 64 * 128 * 2, SHM_K = 64 * 128 * 2;
#define KSWZ(row, colB) ((row) * 256 + ((colB) ^ (((row) & 15) << 4)))
#define SBAR() __builtin_amdgcn_sched_barrier(0)
__device__ __forceinline__ int crow(int r, int hi) { return (r & 3) + 8 * (r >> 2) + 4 * hi; }
typedef float f32x2_t __attribute__((ext_vector_type(2))); typedef __bf16 bf16x2_t __attribute__((ext_vector_type(2)));
__device__ __forceinline__ unsigned cvtpk(float lo, float hi) { f32x2_t v = {lo, hi}; bf16x2_t b = __builtin_convertvector(v, bf16x2_t); return __builtin_bit_cast(unsigned, b); }
__device__ __forceinline__ float bf2f(unsigned short h) { return __uint_as_float(((unsigned)h) << 16); }
__device__ __forceinline__ float wave_sum(float v) { v += swz_xor<1>(v); v += swz_xor<2>(v); v += swz_xor<4>(v); v += swz_xor<8>(v); v += swz_xor<16>(v); return xsum32(v); }
__device__ __forceinline__ float wave_max(float v) { v = fmaxf(v, swz_xor<1>(v)); v = fmaxf(v, swz_xor<2>(v)); v = fmaxf(v, swz_xor<4>(v)); v = fmaxf(v, swz_xor<8>(v)); v = fmaxf(v, swz_xor<16>(v)); return xmax32(v); }
__device__ __forceinline__ float uni(float x) { return __uint_as_float(__builtin_amdgcn_readfirstlane(__float_as_uint(x))); }
__device__ __forceinline__ int to_sgpr(int v) { asm volatile("" : "+v"(v)); return __builtin_amdgcn_readfirstlane(v); }
__device__ __forceinline__ float silu(float x) { return x / (1.0f + __expf(-x)); }

__device__ __forceinline__ int v_st(int k, int c) { const int kk = (k & ~0xC) | ((k & 4) << 1) | ((k & 8) >> 1); return ((kk >> 3) * 4 + (c >> 5)) * 512 + ((kk & 7) * 32 + (c & 31)) * 2; }
__device__ __forceinline__ int v_rd_base(int lane) { return ((lane & 3) << 3) | (((lane >> 2) & 3) << 6) | (((lane >> 4) & 1) << 5) | (((lane >> 5) & 1) << 8); }
constexpr int v_rd_off(int d0, int ks, int half) { return d0 * 512 + ks * 4096 + half * 2048; }
template <int OFF> __device__ __forceinline__ s16x4 tr_read(int vb) {
    s16x4 r; asm volatile("ds_read_b64_tr_b16 %0, %1 offset:%2" : "=&v"(r) : "v"(vb), "i"(OFF) : "memory"); return r;
}
template <int D0> __device__ __forceinline__ void pv_one(f32x16& od, int vb, bf16x8 pa0, bf16x8 pa1, bf16x8 pa2, bf16x8 pa3) {
    const s16x4 l0 = tr_read<v_rd_off(D0, 0, 0)>(vb), h0 = tr_read<v_rd_off(D0, 0, 1)>(vb), l1 = tr_read<v_rd_off(D0, 1, 0)>(vb), h1 = tr_read<v_rd_off(D0, 1, 1)>(vb);
    const s16x4 l2 = tr_read<v_rd_off(D0, 2, 0)>(vb), h2 = tr_read<v_rd_off(D0, 2, 1)>(vb), l3 = tr_read<v_rd_off(D0, 3, 0)>(vb), h3 = tr_read<v_rd_off(D0, 3, 1)>(vb);
    asm volatile("s_waitcnt lgkmcnt(0)" ::: "memory"); SBAR();
#define PK(L, H) (bf16x8){L[0], L[1], L[2], L[3], H[0], H[1], H[2], H[3]}
    od = __builtin_amdgcn_mfma_f32_32x32x16_bf16(pa0, PK(l0, h0), od, 0, 0, 0);
    od = __builtin_amdgcn_mfma_f32_32x32x16_bf16(pa1, PK(l1, h1), od, 0, 0, 0);
    od = __builtin_amdgcn_mfma_f32_32x32x16_bf16(pa2, PK(l2, h2), od, 0, 0, 0);
    od = __builtin_amdgcn_mfma_f32_32x32x16_bf16(pa3, PK(l3, h3), od, 0, 0, 0);
#undef PK
}
template <int KS> __device__ __forceinline__ void pv_ks(f32x16* o, int vb, bf16x8 pa) {
    const s16x4 l0 = tr_read<v_rd_off(0, KS, 0)>(vb), h0 = tr_read<v_rd_off(0, KS, 1)>(vb), l1 = tr_read<v_rd_off(1, KS, 0)>(vb), h1 = tr_read<v_rd_off(1, KS, 1)>(vb);
    const s16x4 l2 = tr_read<v_rd_off(2, KS, 0)>(vb), h2 = tr_read<v_rd_off(2, KS, 1)>(vb), l3 = tr_read<v_rd_off(3, KS, 0)>(vb), h3 = tr_read<v_rd_off(3, KS, 1)>(vb);
#define PK(L, H) (bf16x8){L[0], L[1], L[2], L[3], H[0], H[1], H[2], H[3]}
    asm volatile("s_waitcnt lgkmcnt(6)" ::: "memory"); SBAR();
    o[0] = __builtin_amdgcn_mfma_f32_32x32x16_bf16(pa, PK(l0, h0), o[0], 0, 0, 0);
    asm volatile("s_waitcnt lgkmcnt(4)" ::: "memory"); SBAR();
    o[1] = __builtin_amdgcn_mfma_f32_32x32x16_bf16(pa, PK(l1, h1), o[1], 0, 0, 0);
    asm volatile("s_waitcnt lgkmcnt(2)" ::: "memory"); SBAR();
    o[2] = __builtin_amdgcn_mfma_f32_32x32x16_bf16(pa, PK(l2, h2), o[2], 0, 0, 0);
    asm volatile("s_waitcnt lgkmcnt(0)" ::: "memory"); SBAR();
    o[3] = __builtin_amdgcn_mfma_f32_32x32x16_bf16(pa, PK(l3, h3), o[3], 0, 0, 0);
#undef PK
}
__device__ __forceinline__ void pv_d0(f32x16* o, int vb, bf16x8 pa0, bf16x8 pa1, bf16x8 pa2, bf16x8 pa3) {
    pv_ks<0>(o, vb, pa0); pv_ks<1>(o, vb, pa1); pv_ks<2>(o, vb, pa2); pv_ks<3>(o, vb, pa3);
}
__device__ __forceinline__ void exp_half(f32x16& p) {
#pragma unroll
    for (int r = 0; r < 16; ++r) p[r] = __builtin_amdgcn_exp2f(p[r]);
}
__device__ __forceinline__ void pack_p(const f32x16& p0, const f32x16& p1, float& l_reg, bf16x8& pa0, bf16x8& pa1, bf16x8& pa2, bf16x8& pa3) {
    float ps = 0;
#pragma unroll
    for (int r = 0; r < 16; ++r) ps += p0[r];
#pragma unroll
    for (int r = 0; r < 16; ++r) ps += p1[r];
    l_reg += ps;
#define PK4(P, BASE, OUT) do { u32x4 w = {cvtpk(P[BASE + 0], P[BASE + 1]), cvtpk(P[BASE + 2], P[BASE + 3]), cvtpk(P[BASE + 4], P[BASE + 5]), cvtpk(P[BASE + 6], P[BASE + 7])}; \
    OUT = *reinterpret_cast<bf16x8*>(&w); } while (0)
    PK4(p0, 0, pa0); PK4(p0, 8, pa1); PK4(p1, 0, pa2); PK4(p1, 8, pa3);
#undef PK4
}
template <int ND0> __device__ __forceinline__ void qkt(f32x16& p0, f32x16& p1, const char* Ks, const bf16x8* qr, int r32, int hi, int colB0) {
#pragma unroll
    for (int d0 = 0; d0 < ND0; ++d0) { const int cb = colB0 + (d0 * 16 + hi * 8) * 2;
        const bf16x8 b0 = *reinterpret_cast<const bf16x8*>(Ks + KSWZ(r32, cb));
        const bf16x8 b1 = *reinterpret_cast<const bf16x8*>(Ks + KSWZ(32 + r32, cb));
        p0 = __builtin_amdgcn_mfma_f32_32x32x16_bf16(b0, qr[d0], p0, 0, 0, 0);
        p1 = __builtin_amdgcn_mfma_f32_32x32x16_bf16(b1, qr[d0], p1, 0, 0, 0); }
}
__device__ __forceinline__ void bias_init(f32x16& p0, f32x16& p1, float base, float nslope2, float nM2, int rel  ) {
    if (rel <= -63 || rel >= 31) {
        const float sg = (rel < 0) ? -nslope2 : nslope2, lbv = fmaf(-sg, base, nM2);
#pragma unroll
        for (int r = 0; r < 16; ++r) { p0[r] = fmaf((float)((r & 3) + 8 * (r >> 2)), sg, lbv); p1[r] = fmaf((float)((r & 3) + 8 * (r >> 2) + 32), sg, lbv); }
    } else {
#pragma unroll
        for (int r = 0; r < 16; ++r) { const float d = base - (float)((r & 3) + 8 * (r >> 2));
            p0[r] = fmaf(fabsf(d), nslope2, nM2); p1[r] = fmaf(fabsf(d - 32.f), nslope2, nM2); }
    }
}

struct DiffArgs { const bf16* proj; bf16* y; const float* ghead; int nM2b, lamb, laminitb; };

__device__ __forceinline__ void diff_unit(const DiffArgs& A, int b, int h, int qb, char* lds, int wv) {
    const int tid = opaque_tid(wv), wid = __builtin_amdgcn_readfirstlane(tid >> 6), lane = tid & 63, r32 = lane & 31, hi = lane >> 5, c = wid >> 2, wq = wid & 3;
    const char* Pb = (const char*)A.proj + ((size_t)b * SEQ * INC + h * 128) * 2;
    char* V_lds = lds; char* K_lds = lds + 4 * SHM_V;
    float* wsl = (float*)(lds + 131072) + wid * 64;
    int t_lo, nt; float nM2, lam, lam_init;
    { int a_ = A.nM2b, b_ = A.lamb, c_ = A.laminitb;
      asm volatile("" : "+s"(a_), "+s"(b_), "+s"(c_)); nM2 = __int_as_float(a_); lam = __int_as_float(b_); lam_init = __int_as_float(c_); }
    const float slope = exp2f(-8.0f * (float)(h + 1) / 6.0f);
    const float nslope2 = uni(-slope * LOG2E);
    { const float Df = (151.0f + 2.0f * (-nM2)) / (-nslope2); const int Dk = Df > 20000.f ? 20000 : (int)Df + 1; const int i0 = qb * 128;
      int lo_ = i0 - Dk + 1; lo_ = lo_ > 0 ? (lo_ >> 6) : 0; int hi_ = (i0 + 126 + Dk) >> 6; hi_ = hi_ > SEQ / KVBLK - 1 ? SEQ / KVBLK - 1 : hi_;
      if (((hi_ - lo_ + 1) & 1) != 0) { if (lo_ > 0) --lo_; else ++hi_; }
      t_lo = __builtin_amdgcn_readfirstlane(lo_); nt = __builtin_amdgcn_readfirstlane(hi_ - lo_ + 1); }
    const int ipos = qb * 128 + wq * 32 + r32;
    float l_reg = 0; f32x16 o[4] = {}; bf16x8 qr[4];
    { const char* Qw = Pb + (size_t)(qb * 128 + wq * 32) * (INC * 2) + (C_DQ + c * 64) * 2; const unsigned qoff = (unsigned)((r32 * INC + hi * 8) * 2);
#pragma unroll
      for (int d0 = 0; d0 < 4; ++d0) qr[d0] = *reinterpret_cast<const bf16x8*>(Qw + qoff + d0 * 32); }
    const int colB0 = c * 128;
    const int krow = wid * 4 + (lane >> 4), kcc = (lane & 15) ^ (krow & 15);
    const unsigned koff = (unsigned)((krow * INC + kcc * 8) * 2);
    const int vkey = (wid >> 2) * 16 + (((wid >> 1) & 1) << 3) + (((lane >> 4) & 1) << 2) + ((lane >> 2) & 3)  , vcol = ((wid & 1) * 2 + (lane >> 5)) * 32 + (lane & 3) * 8;
    const unsigned voff = (unsigned)((vkey * INC + vcol) * 2 + (C_DV - C_DK) * 2);
    const int vb0 = (int)(uintptr_t)V_lds + v_rd_base(lane);
    const char* Pk = Pb + (size_t)(t_lo * KVBLK) * (INC * 2) + C_DK * 2; int iposk = ipos - t_lo * KVBLK - 4 * hi; asm volatile("" : "+v"(iposk));     const int relw = t_lo * KVBLK - (qb * 128 + wq * 32);
    typedef __attribute__((address_space(3))) unsigned lds_u32;
    __attribute__((address_space(3))) unsigned char* ldsA = (__attribute__((address_space(3))) unsigned char*)lds + wid * 1024;
#define GLDS(gp, lp) __builtin_amdgcn_global_load_lds((const unsigned*)(gp), (lds_u32*)(lp), 16, 0, 0)
#define STAGE(t) do { const char* kt_ = Pk + (size_t)((t) * KVBLK) * (INC * 2); const int so_ = ((t) & 3) * SHM_K; \
    GLDS(kt_ + koff, ldsA + 4 * SHM_V + so_); GLDS(kt_ + 32 * INC * 2 + koff, ldsA + 4 * SHM_V + so_ + 8192); \
    GLDS(kt_ + voff, ldsA + so_); GLDS(kt_ + 32 * INC * 2 + voff, ldsA + so_ + 8192); } while (0)
#define SLOT(t) (((t) & 3) * SHM_K)
#define ENDI() do { asm volatile("s_waitcnt vmcnt(0)" ::: "memory"); __syncthreads(); } while (0)
#define BIAS(P0, P1, t) bias_init(P0, P1, (float)(iposk - (t) * KVBLK), nslope2, nM2, relw + (t) * KVBLK)
    f32x16 pA0, pA1, pB0, pB1; bf16x8 pa0, pa1, pa2, pa3; const int NT = nt;
    STAGE(0); ENDI();
    STAGE(1);
    BIAS(pA0, pA1, 0); qkt<4>(pA0, pA1, K_lds, qr, r32, hi, colB0);
#if DIFF_ANTIPHASE
    if (c == 0) {
#endif
        const int lp_ = opaque_tid(wv) & 63, r32p = lp_ & 31, hip = lp_ >> 5;
        exp_half(pA0);
        ENDI();
#pragma unroll 1
        for (int j = 1; j + 1 < NT; j += 2) {
            STAGE(j + 1);
            SBAR(); BIAS(pB0, pB1, j); qkt<4>(pB0, pB1, K_lds + SLOT(j), qr, r32p, hip, colB0);
            exp_half(pA1); pack_p(pA0, pA1, l_reg, pa0, pa1, pa2, pa3); SBAR();
            pv_d0(o, vb0 + SLOT(j - 1), pa0, pa1, pa2, pa3); exp_half(pB0);
            ENDI();
            STAGE(j + 2);
            SBAR(); BIAS(pA0, pA1, j + 1); qkt<4>(pA0, pA1, K_lds + SLOT(j + 1), qr, r32p, hip, colB0);
            exp_half(pB1); pack_p(pB0, pB1, l_reg, pa0, pa1, pa2, pa3); SBAR();
            pv_d0(o, vb0 + SLOT(j), pa0, pa1, pa2, pa3); exp_half(pA0);
            ENDI();
        }
        { const int lt_ = opaque_tid(wv) & 63;
          SBAR(); BIAS(pB0, pB1, NT - 1); qkt<4>(pB0, pB1, K_lds + SLOT(NT - 1), qr, lt_ & 31, lt_ >> 5, colB0); }
        exp_half(pA1); pack_p(pA0, pA1, l_reg, pa0, pa1, pa2, pa3); SBAR();
        pv_d0(o, vb0 + SLOT(NT - 2), pa0, pa1, pa2, pa3); exp_half(pB0);
        exp_half(pB1); pack_p(pB0, pB1, l_reg, pa0, pa1, pa2, pa3); SBAR();
        pv_d0(o, vb0 + SLOT(NT - 1), pa0, pa1, pa2, pa3);
#if DIFF_ANTIPHASE
    } else {
        const int lp_ = opaque_tid(wv) & 63, r32p = lp_ & 31, hip = lp_ >> 5;
        pa0 = bf16x8{}; pa1 = bf16x8{}; pa2 = bf16x8{}; pa3 = bf16x8{};
        ENDI();
#pragma unroll 1
        for (int j = 1; j + 1 < NT; j += 2) {
            STAGE(j + 1);
            SBAR(); pv_d0(o, vb0 + (j > 1 ? SLOT(j - 2) : 0), pa0, pa1, pa2, pa3);
            exp_half(pA0); SBAR();
            BIAS(pB0, pB1, j); qkt<4>(pB0, pB1, K_lds + SLOT(j), qr, r32p, hip, colB0);
            exp_half(pA1); pack_p(pA0, pA1, l_reg, pa0, pa1, pa2, pa3); SBAR();
            ENDI();
            STAGE(j + 2);
            SBAR(); pv_d0(o, vb0 + SLOT(j - 1), pa0, pa1, pa2, pa3);
            exp_half(pB0); SBAR();
            BIAS(pA0, pA1, j + 1); qkt<4>(pA0, pA1, K_lds + SLOT(j + 1), qr, r32p, hip, colB0);
            exp_half(pB1); pack_p(pB0, pB1, l_reg, pa0, pa1, pa2, pa3); SBAR();
            ENDI();
        }
        SBAR(); pv_d0(o, vb0 + SLOT(NT - 3), pa0, pa1, pa2, pa3);
        exp_half(pA0); SBAR();
        { const int lt_ = opaque_tid(wv) & 63;
          BIAS(pB0, pB1, NT - 1); qkt<4>(pB0, pB1, K_lds + SLOT(NT - 1), qr, lt_ & 31, lt_ >> 5, colB0); }
        exp_half(pA1); pack_p(pA0, pA1, l_reg, pa0, pa1, pa2, pa3); SBAR();
        pv_d0(o, vb0 + SLOT(NT - 2), pa0, pa1, pa2, pa3);
        exp_half(pB0); exp_half(pB1); pack_p(pB0, pB1, l_reg, pa0, pa1, pa2, pa3); SBAR();
        pv_d0(o, vb0 + SLOT(NT - 1), pa0, pa1, pa2, pa3);
    }
#endif
#undef GLDS
#undef STAGE
#undef SLOT
#undef ENDI
#undef BIAS
    { auto rr = __builtin_amdgcn_permlane32_swap(__float_as_uint(l_reg), __float_as_uint(l_reg), false, false);
      l_reg = __uint_as_float(rr[0]) + __uint_as_float(rr[1]); }
    const int tid_e = opaque_tid(wv), lane_e = tid_e & 63;
#define tid tid_e
#define r32 (lane_e & 31)
#define hi (lane_e >> 5)
    if (hi == 0) wsl[r32] = l_reg;
    asm volatile("s_waitcnt lgkmcnt(0)" ::: "memory");
    float rli[16];
#pragma unroll
    for (int r = 0; r < 16; ++r) rli[r] = (c ? lam : 1.0f) / wsl[crow(r, hi)];
    __syncthreads();
    float* OS = (float*)lds;
    if (c == 1) {
#pragma unroll
        for (int r = 0; r < 16; ++r) { float* orow = OS + (wq * 32 + crow(r, hi)) * 132 + r32;
#pragma unroll
            for (int d0 = 0; d0 < 4; ++d0) orow[d0 * 32] = o[d0][r] * rli[r]; }
    }
    __syncthreads();
    if (c == 0) {
#pragma unroll
        for (int r = 0; r < 16; ++r) { float* orow = OS + (wq * 32 + crow(r, hi)) * 132 + r32;
#pragma unroll
            for (int d0 = 0; d0 < 4; ++d0) orow[d0 * 32] = o[d0][r] * rli[r] - orow[d0 * 32]; }
    }
    __syncthreads();
    { const int row = tid >> 2, cq = tid & 3; const float* src = OS + row * 132 + cq * 32;
      f32x4 v[8]; float ss = 0.f;
#pragma unroll
      for (int i = 0; i < 8; ++i) { v[i] = *(const f32x4*)(src + 4 * i); const f32x4 q = v[i] * v[i]; ss += (q.x + q.y) + (q.z + q.w); }
      ss += swz_xor<1>(ss); ss += swz_xor<2>(ss);
      const float rn = (1.0f - lam_init) / sqrtf(ss * (1.0f / 128.0f) + EPS);
      const bf16* gp = (const bf16*)(Pb + (size_t)(qb * 128) * (INC * 2) + C_DG * 2 + (unsigned)((row * INC + cq * 32) * 2));
      bf16* yp = (bf16*)((char*)A.y + ((size_t)(b * SEQ + qb * 128) * DM + Y_D + h * 128) * 2 + (unsigned)((row * DM + cq * 32) * 2)); const float* gh = A.ghead + cq * 32;
#pragma unroll
      for (int i = 0; i < 4; ++i) { const bf16x8 g8 = *reinterpret_cast<const bf16x8*>(gp + 8 * i); const f32x4 h0 = *(const f32x4*)(gh + 8 * i), h1 = *(const f32x4*)(gh + 8 * i + 4);
          const f32x4 a = v[2 * i] * h0 * rn, bq = v[2 * i + 1] * h1 * rn;
          u32x4 w; w.x = cvtpk(a.x * silu(bf2f(g8[0])), a.y * silu(bf2f(g8[1]))); w.y = cvtpk(a.z * silu(bf2f(g8[2])), a.w * silu(bf2f(g8[3])));
          w.z = cvtpk(bq.x * silu(bf2f(g8[4])), bq.y * silu(bf2f(g8[5]))); w.w = cvtpk(bq.z * silu(bf2f(g8[6])), bq.w * silu(bf2f(g8[7])));
          *(u32x4*)(yp + 8 * i) = w; } }
    __syncthreads();
#undef tid
#undef r32
#undef hi
}

__device__ __forceinline__ int next_item(unsigned* ctr, char* lds, int tid) {
    int* slot = (int*)(lds + 131072 + 3072);
    if (tid == 0) *slot = (int)atomicAdd(ctr, 1u);
    __syncthreads();
    return __builtin_amdgcn_readfirstlane(*slot);
}

struct MemArgs { const bf16* proj; const bf16* mkv; bf16* y; const float* gmq; const float* gmk; int layer; };
__device__ __forceinline__ void mem_unit(const MemArgs& A, int unit, char* lds, int wv) {
    const int tid = opaque_tid(wv), wid = __builtin_amdgcn_readfirstlane(tid >> 6), lane = tid & 63, r32 = lane & 31, hi = lane >> 5;
    const int b = unit / (4 * 32), hm = (unit / 32) % 4, qb = unit % 32;
    const bf16* Kh = A.mkv + (size_t)b * NMEM * MKVC + A.layer * 1024 + hm * 128;
    const bf16* Vh = Kh + 512;
    char* V_lds = lds; char* K_lds = lds + 4 * SHM_V;
    float* wsl = (float*)(lds + 131072) + wid * 64;
    float nM2;
    { const float a = wave_max(fmaxf(fabsf(A.gmq[lane]), fabsf(A.gmq[lane + 64]))), bb = wave_max(fmaxf(fabsf(A.gmk[lane]), fabsf(A.gmk[lane + 64])));
      nM2 = -(11.3137085f * a * bb * LOG2E * 1.03f + 0.25f); }
    { const int sr = tid >> 4, sc = (tid & 15) * 8, kc = sc * 2;
      const f32x4 g0 = *(const f32x4*)(A.gmk + sc), g1 = *(const f32x4*)(A.gmk + sc + 4);
#pragma unroll
      for (int t = 0; t < 4; ++t)
#pragma unroll
        for (int hh = 0; hh < 2; ++hh) { const int key = t * 64 + hh * 32 + sr;
          const bf16x8 v8 = *reinterpret_cast<const bf16x8*>(&Vh[(size_t)key * MKVC + sc]); const bf16x8 k8 = *reinterpret_cast<const bf16x8*>(&Kh[(size_t)key * MKVC + sc]);
          float f[8]; float ss = 0.f;
#pragma unroll
          for (int i = 0; i < 8; ++i) { f[i] = bf2f((unsigned short)k8[i]); ss += f[i] * f[i]; }
          ss += swz_xor<1>(ss); ss += swz_xor<2>(ss); ss += swz_xor<4>(ss); ss += swz_xor<8>(ss);
          const float rn = 1.0f / sqrtf(ss * (1.0f / 128.0f) + EPS);
          u32x4 w; w.x = cvtpk(f[0] * rn * g0.x, f[1] * rn * g0.y); w.y = cvtpk(f[2] * rn * g0.z, f[3] * rn * g0.w); w.z = cvtpk(f[4] * rn * g1.x, f[5] * rn * g1.y); w.w = cvtpk(f[6] * rn * g1.z, f[7] * rn * g1.w);
          *(u32x4*)(K_lds + t * SHM_K + KSWZ(hh * 32 + sr, kc)) = w;
          { const int ks_ = hh * 32 + sr, kp_ = (ks_ & ~0xC) | ((ks_ & 4) << 1) | ((ks_ & 8) >> 1);
            *(bf16x8*)(V_lds + t * SHM_V + v_st(kp_, sc)) = v8; } } }
    bf16x8 qr[8];
    const size_t grow0 = (size_t)b * SEQ + qb * 256 + wid * 32;
    { const bf16* Qw = A.proj + (grow0 + r32) * INC + C_MQ + hm * 128 + hi * 8;
      bf16x8 raw[8]; float ss = 0.f;
#pragma unroll
      for (int d0 = 0; d0 < 8; ++d0) { raw[d0] = *reinterpret_cast<const bf16x8*>(Qw + d0 * 16);
#pragma unroll
          for (int i = 0; i < 8; ++i) { const float f = bf2f((unsigned short)raw[d0][i]); ss += f * f; } }
      { auto rr = __builtin_amdgcn_permlane32_swap(__float_as_uint(ss), __float_as_uint(ss), false, false); ss = __uint_as_float(rr[0]) + __uint_as_float(rr[1]); }
      const float rn = QSCALE_M / sqrtf(ss * (1.0f / 128.0f) + EPS);
#pragma unroll
      for (int d0 = 0; d0 < 8; ++d0) { const f32x4 g0 = *(const f32x4*)(A.gmq + d0 * 16 + hi * 8), g1 = *(const f32x4*)(A.gmq + d0 * 16 + hi * 8 + 4);
          u32x4 w; w.x = cvtpk(bf2f((unsigned short)raw[d0][0]) * rn * g0.x, bf2f((unsigned short)raw[d0][1]) * rn * g0.y); w.y = cvtpk(bf2f((unsigned short)raw[d0][2]) * rn * g0.z, bf2f((unsigned short)raw[d0][3]) * rn * g0.w);
          w.z = cvtpk(bf2f((unsigned short)raw[d0][4]) * rn * g1.x, bf2f((unsigned short)raw[d0][5]) * rn * g1.y); w.w = cvtpk(bf2f((unsigned short)raw[d0][6]) * rn * g1.z, bf2f((unsigned short)raw[d0][7]) * rn * g1.w);
          qr[d0] = *reinterpret_cast<bf16x8*>(&w); } }
    __syncthreads();
    float l_reg = 0; f32x16 o[4] = {};
    const int vb0 = (int)(uintptr_t)V_lds + v_rd_base(lane);
#pragma unroll 1
    for (int t = 0; t < 4; ++t) {
        f32x16 p0, p1; bf16x8 pa0, pa1, pa2, pa3;
#pragma unroll
        for (int r = 0; r < 16; ++r) { p0[r] = nM2; p1[r] = nM2; }
        qkt<8>(p0, p1, K_lds + t * SHM_K, qr, r32, hi, 0);
        exp_half(p0); exp_half(p1); pack_p(p0, p1, l_reg, pa0, pa1, pa2, pa3); SBAR();
        pv_d0(o, vb0 + t * SHM_V, pa0, pa1, pa2, pa3);
    }
    { auto rr = __builtin_amdgcn_permlane32_swap(__float_as_uint(l_reg), __float_as_uint(l_reg), false, false);
      l_reg = __uint_as_float(rr[0]) + __uint_as_float(rr[1]); }
    if (hi == 0) wsl[r32] = l_reg;
    asm volatile("s_waitcnt lgkmcnt(0)" ::: "memory");
#pragma unroll
    for (int r = 0; r < 16; ++r) { const int rr_ = crow(r, hi); const float rl = 1.0f / wsl[rr_];
        const bf16* gp = A.proj + (grow0 + rr_) * INC + C_MG + hm * 128 + r32; bf16* yp = A.y + (grow0 + rr_) * DM + Y_M + hm * 128 + r32;
#pragma unroll
        for (int d0 = 0; d0 < 4; ++d0) { const float g = bf2f(gp[d0 * 32]); const float val = o[d0][r] * rl * silu(g);
            yp[d0 * 32] = (bf16)(cvtpk(val, val) & 0xffffu); } }
    __syncthreads();
}

struct ConvArgs { const bf16* proj; bf16* y; const float* w; const float* bias; };
__device__ __forceinline__ void conv_items(const ConvArgs& A, long first, long stride) {
    constexpr long NIT = (long)(MTOK / 4) * 96;
    for (long it = first; it < NIT; it += stride) {
        const int row0 = (int)(it / 96) * 4, c8 = (int)(it % 96) * 8, t0 = row0 & (SEQ - 1);
        const bf16* p = A.proj + (size_t)row0 * INC + c8;
        bf16x8 xr[6], cr[6], br[4], gr[4];
#pragma unroll
        for (int i = 0; i < 6; ++i) { const int t = t0 - 1 + i; const bool ok = (t >= 0) && (t < SEQ);
            xr[i] = ok ? *reinterpret_cast<const bf16x8*>(p + (long)(i - 1) * INC + C_AX) : bf16x8{}; cr[i] = ok ? *reinterpret_cast<const bf16x8*>(p + (long)(i - 1) * INC + C_AC) : bf16x8{}; }
#pragma unroll
        for (int i = 0; i < 4; ++i) { br[i] = *reinterpret_cast<const bf16x8*>(p + (long)i * INC + C_AB); gr[i] = *reinterpret_cast<const bf16x8*>(p + (long)i * INC + C_AG); }
        float w0[8], w1[8], w2[8], bb[8];
#pragma unroll
        for (int i = 0; i < 2; ++i) { const f32x4 a = *(const f32x4*)(A.w + c8 + 4 * i), bq = *(const f32x4*)(A.w + 768 + c8 + 4 * i), cc = *(const f32x4*)(A.w + 1536 + c8 + 4 * i), dd = *(const f32x4*)(A.bias + c8 + 4 * i);
#pragma unroll
            for (int k = 0; k < 4; ++k) { w0[4 * i + k] = a[k]; w1[4 * i + k] = bq[k]; w2[4 * i + k] = cc[k]; bb[4 * i + k] = dd[k]; } }
        float u[6][8];
#pragma unroll
        for (int i = 0; i < 6; ++i)
#pragma unroll
            for (int k = 0; k < 8; ++k) u[i][k] = bf2f((unsigned short)cr[i][k]) * bf2f((unsigned short)xr[i][k]);
#pragma unroll
        for (int j = 0; j < 4; ++j) { float out[8];
#pragma unroll
            for (int k = 0; k < 8; ++k) { const float z = u[j][k] * w0[k] + u[j + 1][k] * w1[k] + u[j + 2][k] * w2[k] + bb[k];
                out[k] = bf2f((unsigned short)br[j][k]) * z * silu(bf2f((unsigned short)gr[j][k])); }
            u32x4 w; w.x = cvtpk(out[0], out[1]); w.y = cvtpk(out[2], out[3]); w.z = cvtpk(out[4], out[5]); w.w = cvtpk(out[6], out[7]);
            *(u32x4*)(A.y + (size_t)(row0 + j) * DM + Y_A + c8) = w; }
    }
}
}

using att::bf16;
typedef float f32x4_t __attribute__((ext_vector_type(4)));
typedef unsigned u32x4_t __attribute__((ext_vector_type(4)));
typedef unsigned u32x2_t __attribute__((ext_vector_type(2)));

__device__ __forceinline__ void transpose_item(const float* __restrict__ W, int K, int N, const float* __restrict__ gain, bf16* __restrict__ WT, float* scr, int item, int lane) {
    const int nblk = N / 32, kb = item / nblk, nb = item % nblk, k0 = 64 * kb, n0 = 32 * nb;
    float wv_[32], gv_[32];
    const float* wp_ = W + (size_t)(k0 + (lane >> 5)) * N + n0 + (lane & 31);
#pragma unroll
    for (int i = 0; i < 32; ++i) { wv_[i] = wp_[(size_t)(2 * i) * N]; gv_[i] = gain ? gain[k0 + 2 * i + (lane >> 5)] : 1.0f; }
#pragma unroll
    for (int i = 0; i < 32; ++i) scr[(2 * i + (lane >> 5)) * 33 + (lane & 31)] = wv_[i] * gv_[i];
    __builtin_amdgcn_s_waitcnt(0xc07f); asm volatile("s_waitcnt lgkmcnt(0)" ::: "memory");
    const int g8 = (n0 & 255) >> 5, n0p = (n0 & ~255) + 128 * (g8 & 1) + 32 * (g8 >> 1);
    const int c = lane & 7;
#pragma unroll
    for (int j = 0; j < 4; ++j) { const int n = (lane >> 3) + 8 * j; const float* s = scr + (8 * c) * 33 + n;
        u32x4_t o; o.x = pg8::cvt_pk_bf16(s[0 * 33], s[1 * 33]); o.y = pg8::cvt_pk_bf16(s[2 * 33], s[3 * 33]); o.z = pg8::cvt_pk_bf16(s[4 * 33], s[5 * 33]); o.w = pg8::cvt_pk_bf16(s[6 * 33], s[7 * 33]);
        *(u32x4_t*)(WT + (size_t)(n0p + n) * K + k0 + 8 * c) = o; }
    asm volatile("s_waitcnt lgkmcnt(0)" ::: "memory");
}
__device__ __forceinline__ void row_to_bf16(const float* __restrict__ xrow, bf16* __restrict__ orow, float* __restrict__ ssrow, int lane) {
    const f32x4_t* xr = (const f32x4_t*)xrow + lane; f32x4_t v[8]; float s = 0.f;
#pragma unroll
    for (int j = 0; j < 8; ++j) { v[j] = xr[64 * j]; s += (v[j].x * v[j].x + v[j].y * v[j].y) + (v[j].z * v[j].z + v[j].w * v[j].w); }
    s = att::wave_sum(s);
    u32x2_t* o8 = (u32x2_t*)orow + lane;
#pragma unroll
    for (int j = 0; j < 8; ++j) { u32x2_t w; w.x = pg8::cvt_pk_bf16(v[j].x, v[j].y); w.y = pg8::cvt_pk_bf16(v[j].z, v[j].w); o8[64 * j] = w; }
    if (lane < 32) ssrow[lane] = (lane == 0) ? s : 0.f;
}


#define XB_TMO      128
#define XB_XCNT(j)  (256  + 64 * (j))
#define XB_XSUB(j)  (1280 + 64 * (j))
#define XB_XGEN(j)  (2304 + 64 * (j))
#define XB_TOP      3328
#define XB_TOPGEN   3392
#define XCD_BAR_WORDS 3456
#define XB_SPIN_CAP (1u << 18)
#define LAS __attribute__((address_space(3)))

__device__ __forceinline__ unsigned xb_ld(unsigned* p)              { return __hip_atomic_load(p, __ATOMIC_RELAXED, __HIP_MEMORY_SCOPE_AGENT); }
__device__ __forceinline__ unsigned xb_add(unsigned* p, unsigned v) { return __hip_atomic_fetch_add(p, v, __ATOMIC_RELAXED, __HIP_MEMORY_SCOPE_AGENT); }
__device__ __forceinline__ unsigned xb_xcc_id() { return (unsigned)__builtin_amdgcn_s_getreg((3 << 11) | 20) & 0xFu; }
#define XB_SPIN(cond, bar) do { unsigned _sp = 0; while (cond) { __builtin_amdgcn_s_sleep(1); \
    if ((++_sp & 255u) == 0u) { if (xb_ld(&(bar)[XB_TMO])) break; if (_sp > XB_SPIN_CAP) { atomicAdd(&(bar)[XB_TMO], 1u); break; } } } } while (0)

struct XcdBarrier {
    unsigned* bar; unsigned x;
    volatile LAS unsigned* st;
};

__device__ __forceinline__ XcdBarrier xcd_barrier_post(unsigned* bar, volatile LAS unsigned* st) {
    XcdBarrier b; b.bar = bar; b.x = xb_xcc_id(); b.st = st;
    if (threadIdx.x == 0) (void)xb_add(&bar[XB_XCNT(b.x)], 1u);
    return b;
}
__device__ __forceinline__ void xcd_barrier_complete(unsigned* bar, unsigned x, unsigned& nloc, unsigned& nx) {
    const unsigned G = gridDim.x * gridDim.y * gridDim.z;
    unsigned sum, cnt, mine, sp = 0u;
    for (;;) {
        sum = 0u; cnt = 0u; mine = 0u;
#pragma unroll
        for (unsigned j = 0; j < 16; ++j) { const unsigned c = xb_ld(&bar[XB_XCNT(j)]); sum += c; cnt += (c > 0u) ? 1u : 0u; mine = (j == x) ? c : mine; }
        if (sum == G) break;
        __builtin_amdgcn_s_sleep(1);
        if ((++sp & 255u) == 0u) { if (xb_ld(&bar[XB_TMO])) break; if (sp > XB_SPIN_CAP) { atomicAdd(&bar[XB_TMO], 1u); break; } }
    }
    nloc = mine > 0u ? mine : 1u; nx = cnt > 0u ? cnt : 1u;
}

__device__ __forceinline__ void xcd_barrier(const XcdBarrier& b) {
    asm volatile("s_waitcnt vmcnt(0)" ::: "memory");
    __syncthreads();
    if (threadIdx.x == 0) {
        unsigned* bar = b.bar;
        __builtin_amdgcn_s_waitcnt(0);
        unsigned nloc = b.st[0], nx = b.st[1];
        if (nloc == 0u) { xcd_barrier_complete(bar, b.x, nloc, nx); b.st[0] = nloc; b.st[1] = nx; }
        const unsigned old = xb_add(&bar[XB_XSUB(b.x)], 1u);
        const unsigned gen = old / nloc;
        if (old + 1u == (gen + 1u) * nloc) {
            __builtin_amdgcn_fence(__ATOMIC_RELEASE, "agent");
            asm volatile("s_waitcnt vmcnt(0)" ::: "memory");
            const unsigned og = xb_add(&bar[XB_TOP], 1u);
            const unsigned tg = og / nx;
            if (og + 1u == (tg + 1u) * nx) xb_add(&bar[XB_TOPGEN], 1u);
            else XB_SPIN(xb_ld(&bar[XB_TOPGEN]) == tg, bar);
            __builtin_amdgcn_fence(__ATOMIC_ACQUIRE, "agent");
            xb_add(&bar[XB_XGEN(b.x)], 1u);
            asm volatile("s_waitcnt vmcnt(0)" ::: "memory");
        } else {
            XB_SPIN(xb_ld(&bar[XB_XGEN(b.x)]) == gen, bar);
            __builtin_amdgcn_fence(__ATOMIC_ACQUIRE, "agent");
            asm volatile("s_waitcnt vmcnt(0)" ::: "memory");
        }
    }
    __syncthreads();
}

__device__ __forceinline__ void fill_rowscale(const float* __restrict__ ssq, int pm0, unsigned char* lds, int tid) {
    const int row = tid >> 1, h = tid & 1;
    const f32x4_t* sp = (const f32x4_t*)(ssq + ((size_t)pm0 * 256 + row) * 32 + h * 16);
    const f32x4_t a = sp[0], b = sp[1], c = sp[2], d = sp[3];
    float s = (((a.x + a.y) + (a.z + a.w)) + ((b.x + b.y) + (b.z + b.w))) + (((c.x + c.y) + (c.z + c.w)) + ((d.x + d.y) + (d.z + d.w)));
    s += swz_xor<1>(s);
    if (h == 0) ((float*)(lds + 131072 + 2048))[row] = __builtin_amdgcn_rsqf(s * (1.0f / 2048.0f) + 1e-6f);
    __syncthreads();
}

struct Args { const float* in[18]; float* out; unsigned char* ws; int ph_lo, ph_hi; };
constexpr int NPHASE = 2 + 3 * DEPTH;

__global__ void __launch_bounds__(512) fwd_megakernel(Args args) {
    extern __shared__ __attribute__((aligned(16))) unsigned char lds[];
    cg::grid_group grid = cg::this_grid();
    const int tid = threadIdx.x, lane = tid & 63, wave = __builtin_amdgcn_readfirstlane(tid >> 6);
    const int G = gridDim.x, bx = blockIdx.x;
    unsigned char* ws = args.ws;
    bf16* WinT = (bf16*)(ws + WS_WIN); bf16* WoutT = (bf16*)(ws + WS_WOUT); bf16* WmemT = (bf16*)(ws + WS_WMEM);
    bf16* xb = (bf16*)(ws + WS_XB); bf16* memb = (bf16*)(ws + WS_MEMB); bf16* mkv = (bf16*)(ws + WS_MKV);
    float* ssq = (float*)(ws + WS_SSQ); float* ssqm = (float*)(ws + WS_SSQM);
    bf16* proj = (bf16*)(ws + WS_PROJ); bf16* yb = (bf16*)(ws + WS_Y);
    const int lo = args.ph_lo, hi = args.ph_hi;
#define IN(k) (lo <= (k) && (k) < hi)
    volatile LAS unsigned* xb_st = (volatile LAS unsigned*)((LAS unsigned char*)lds + 131072 + 3584);
    if (threadIdx.x < 4) xb_st[threadIdx.x] = 0u;
    __syncthreads();
    XcdBarrier xbar; xbar.bar = (unsigned*)(ws + WS_BAR); xbar.x = 0; xbar.st = xb_st;
#define SEAM(k) do { if (IN(k) && IN((k) + 1)) { if ((k) == 0) { grid.sync(); xbar = xcd_barrier_post((unsigned*)(ws + WS_BAR), xb_st); } else xcd_barrier(xbar); } } while (0)

#ifndef NO_PRO
    if (IN(0)) {
        float* scr = (float*)lds + wave * (64 * 33);
        const int gw = bx * 8 + wave, NGW = G * 8;
        constexpr int I_IN = (DM / 64) * (INC / 32), I_OUT = (DM / 64) * (DM / 32), I_MEM = (DM / 64) * (1024 / 32);
        constexpr int NITEMS = DEPTH * (I_IN + I_OUT + I_MEM);
        for (int it = gw; it < NITEMS; it += NGW) {
            int r = it;
            if (r < DEPTH * I_IN) { const int l = r / I_IN; r -= l * I_IN;
                transpose_item(args.in[3] + (size_t)l * DM * INC, DM, INC, args.in[2] + l * DM, WinT + (size_t)l * INC * DM, scr, r, lane); continue; }
            r -= DEPTH * I_IN;
            if (r < DEPTH * I_OUT) { const int l = r / I_OUT; r -= l * I_OUT;
                transpose_item(args.in[17] + (size_t)l * DM * DM, DM, DM, nullptr, WoutT + (size_t)l * DM * DM, scr, r, lane); continue; }
            r -= DEPTH * I_OUT;
            { const int l = r / I_MEM; r -= l * I_MEM;
                transpose_item(args.in[14] + (size_t)l * DM * 1024, DM, 1024, args.in[13] + l * DM, WmemT + (size_t)l * 1024 * DM, scr, r, lane); }
        }
        for (int m = gw; m < MTOK + MMEM; m += NGW) {
            if (m < MTOK) row_to_bf16(args.in[0] + (size_t)m * DM, xb + (size_t)m * DM, ssq + (size_t)m * 32, lane);
            else { const int mm = m - MTOK; row_to_bf16(args.in[1] + (size_t)mm * DM, memb + (size_t)mm * DM, ssqm + (size_t)mm * 32, lane); }
        }
        if (bx == 0 && opaque_tid(wave) < 16) ((unsigned*)(ws + WS_CTR))[opaque_tid(wave)] = 0u;
        if (bx == 0) for (int i_ = opaque_tid(wave); i_ < XCD_BAR_WORDS; i_ += 512) ((unsigned*)(ws + WS_BAR))[i_] = 0u;
        __syncthreads();
    }
#endif
    SEAM(0);
#ifndef NO_G1
    if (IN(1)) {
        pg8::Gemm g{memb, WmemT, MMEM, MKVC, DM}; pg8::StaticOrder S; S.init(MMEM, MKVC, G, bx);
        pg8::Unit u0_; int pm0_ = -1; if (S.next(0, u0_)) { pm0_ = u0_.pm; fill_rowscale(ssqm, pm0_, lds, opaque_tid(wave)); }
        pg8::EpiProj E{mkv, MKVC, ssqm, nullptr, nullptr, 0, 0, 0, 0, 1.f, (const PG8_LAS float*)((PG8_LAS unsigned char*)lds + 131072 + 2048), pm0_};
        pg8::gemm_phase<pg8::EpiProj, pg8::StaticOrder, true, true>((PG8_LAS unsigned char*)lds, g, S, E, wave);
    }
#endif
#pragma unroll 1
    for (int l = 0; l < DEPTH; ++l) {
        const int pA = 2 + 3 * l, pB = pA + 1, pC = pA + 2;
        int bxl = bx; asm volatile("" : "+s"(bxl));
#ifndef NO_G2
        if (IN(pA)) {
            pg8::Gemm g{xb, WinT + (size_t)l * INC * DM, MTOK, INC, DM}; pg8::StaticOrder S; S.init(MTOK, INC, G, bxl);
            pg8::Unit u0_{0, 0}; (void)S.next(0, u0_); const int pm0_ = u0_.pm;
            fill_rowscale(ssq, pm0_, lds, opaque_tid(wave));
            pg8::EpiProj E{proj, INC, ssq, args.in[6] + l * 64, args.in[7] + l * 64, C_DQ / 256, C_DK / 256, C_DK / 256, C_DV / 256, QSCALE_D, (const PG8_LAS float*)((PG8_LAS unsigned char*)lds + 131072 + 2048), pm0_};
            pg8::gemm_phase<pg8::EpiProj, pg8::StaticOrder, true, true>((PG8_LAS unsigned char*)lds, g, S, E, wave);
        }
#endif
        SEAM(pA);
        if (IN(pB)) {
            att::DiffArgs DA{proj, yb, args.in[12] + l * 128, 0, 0, 0};
            { const int ln = opaque_tid(wave) & 63;
              const float mq = att::wave_max(fabsf(args.in[6][l * 64 + ln])), mk = att::wave_max(fabsf(args.in[7][l * 64 + ln]));
              const float s1 = att::wave_sum(args.in[8][l * 64 + ln] * args.in[9][l * 64 + ln]), s2 = att::wave_sum(args.in[10][l * 64 + ln] * args.in[11][l * 64 + ln]);
              const int cb = (l == 0) ? 0x3e4ccccd : (l == 1) ? 0x3eb60549 : (l == 2) ? 0x3ef1014c : 0x3f0e59d5;
              const float li = __int_as_float(cb);
              DA.nM2b = att::to_sgpr(__float_as_int(-(8.0f * mq * mk * LOG2E * 1.03f + 0.25f))); DA.lamb = att::to_sgpr(__float_as_int(expf(s1) - expf(s2) + li)); DA.laminitb = att::to_sgpr(cb); }
            att::MemArgs MA{proj, mkv, yb, args.in[15] + l * 128, args.in[16] + l * 128, l};
            unsigned* ctr = (unsigned*)(ws + WS_CTR) + l;
            att::ConvArgs CA{proj, yb, args.in[4] + l * 3 * 768, args.in[5] + l * 768};
            for (;;) { const int it = att::next_item(ctr, (char*)lds, opaque_tid(wave));
                if (it >= 768 + 256 + 256) break;
                if (it < 768) { const int r = it & 127; att::diff_unit(DA, r >> 6, 5 - (it >> 7), r & 63, (char*)lds, wave); }
                else if (it < 1024) { att::conv_items(CA, (long)(it - 768) * 512 + opaque_tid(wave), 256L * 512); __syncthreads(); }
                else att::mem_unit(MA, it - 1024, (char*)lds, wave); }
        }
        SEAM(pB);
#ifndef NO_G3
        if (IN(pC)) {
            pg8::Gemm g{yb, WoutT + (size_t)l * DM * DM, MTOK, DM, DM}; pg8::StaticOrder S; S.init(MTOK, DM, G, bxl);
            pg8::EpiOut E{args.out, xb, ssq, (l == DEPTH - 1) ? 1 : 0};
            pg8::gemm_phase<pg8::EpiOut, pg8::StaticOrder, true, true>((PG8_LAS unsigned char*)lds, g, S, E, wave);
        }
#endif
        if (l + 1 < DEPTH) SEAM(pC);
    }
#undef IN
#undef SEAM
}

extern "C" void kernel_launch(void* const* d_in, const int* in_sizes, int n_in, void* d_out, int out_size, void* d_ws, size_t ws_size, hipStream_t stream) {
    static int grid = 0;
    if (grid == 0) {
        if (n_in != 18 || in_sizes[0] != MTOK * DM || out_size != MTOK * DM || ws_size < WS_END) { fprintf(stderr, "kernel_launch: unexpected shapes (n_in %d, in0 %d, out %d, ws %zu)\n", n_in, n_in > 0 ? in_sizes[0] : -1, out_size, ws_size); grid = -1; return; }
        int dev = 0, cus = 0, per_cu = 0;
        if (hipGetDevice(&dev) != hipSuccess || hipDeviceGetAttribute(&cus, hipDeviceAttributeMultiprocessorCount, dev) != hipSuccess) { grid = -1; return; }
        if (hipFuncSetAttribute((const void*)fwd_megakernel, hipFuncAttributeMaxDynamicSharedMemorySize, LDS_BYTES) != hipSuccess) { fprintf(stderr, "kernel_launch: hipFuncSetAttribute failed\n"); grid = -1; return; }
        if (hipOccupancyMaxActiveBlocksPerMultiprocessor(&per_cu, (const void*)fwd_megakernel, 512, LDS_BYTES) != hipSuccess || per_cu < 1) { fprintf(stderr, "kernel_launch: occupancy query says %d blocks per CU\n", per_cu); per_cu = 1; }
        (void)hipGetLastError();
        grid = cus * 1;
    }
    if (grid < 0) return;
    Args a{};
    for (int i = 0; i < 18; ++i) a.in[i] = (const float*)d_in[i];
    a.out = (float*)d_out; a.ws = (unsigned char*)d_ws;
#if MK_ONE_LAUNCH
    a.ph_lo = 0; a.ph_hi = NPHASE;
    void* kargs[] = {&a};
    hipError_t e = hipLaunchCooperativeKernel((const void*)fwd_megakernel, dim3(grid), dim3(512), kargs, LDS_BYTES, stream);
    if (e != hipSuccess) fprintf(stderr, "kernel_launch: cooperative launch failed: %s (grid %d)\n", hipGetErrorString(e), grid);
#else
    for (int p = 0; p < NPHASE; ++p) { a.ph_lo = p; a.ph_hi = p + 1;
        hipLaunchKernelGGL(fwd_megakernel, dim3(grid), dim3(512), LDS_BYTES, stream, a);
        const hipError_t le = hipPeekAtLastError();
        if (le != hipSuccess) { fprintf(stderr, "kernel_launch: launch %d failed: %s\n", p, hipGetErrorName(le)); break; } }
#endif
}
```

```cpp
#include <hip/hip_runtime.h>
#include <hip/hip_cooperative_groups.h>
#include <cstdio>
#include <cstdint>
namespace cg = cooperative_groups;

#ifndef DIFF_ANTIPHASE
#define DIFF_ANTIPHASE 1
#endif
#ifndef MK_ONE_LAUNCH
#define MK_ONE_LAUNCH 1
#endif

constexpr int DM = 2048, BATCH = 2, SEQ = 8192, DEPTH = 4, NMEM = 256, MTOK = BATCH * SEQ, INC = 7168, MKVC = 4096, MMEM = BATCH * NMEM;
constexpr int C_AX = 0, C_AB = 768, C_AC = 1536, C_AG = 2304, C_DQ = 3072, C_DK = 3840, C_DV = 4608, C_DG = 5376, C_MQ = 6144, C_MG = 6656;
constexpr int Y_A = 0, Y_D = 768, Y_M = 1536;
constexpr float EPS = 1e-6f, LOG2E = 1.4426950408889634f;
constexpr float QSCALE_D = 0.125f * LOG2E;
constexpr float QSCALE_M = 0.08838834764831845f * LOG2E;
constexpr size_t MiB = 1u << 20;
constexpr size_t WS_WIN = 0, WS_WOUT = 112 * MiB, WS_WMEM = 144 * MiB, WS_XB = 160 * MiB, WS_MEMB = 224 * MiB, WS_MKV = 226 * MiB, WS_SSQ = 230 * MiB, WS_SSQM = 232 * MiB, WS_CTR = 233 * MiB, WS_BAR = 234 * MiB,
                 WS_PROJ = 240 * MiB, WS_Y = 464 * MiB, WS_END = 528 * MiB;
constexpr int LDS_BYTES = 131072 + 4096;
__device__ __forceinline__ int opaque_tid(int wv) { int lane_; asm volatile("v_mbcnt_lo_u32_b32 %0, -1, 0\n\tv_mbcnt_hi_u32_b32 %0, -1, %0" : "=v"(lane_)); return wv * 64 + lane_; }
template <int X> __device__ __forceinline__ float swz_xor(float v) { return __int_as_float(__builtin_amdgcn_ds_swizzle(__float_as_int(v), (X << 10) | 0x1f)); }
__device__ __forceinline__ float xsum32(float v) { auto rr = __builtin_amdgcn_permlane32_swap(__float_as_uint(v), __float_as_uint(v), false, false); return __uint_as_float(rr[0]) + __uint_as_float(rr[1]); }
__device__ __forceinline__ float xmax32(float v) { auto rr = __builtin_amdgcn_permlane32_swap(__float_as_uint(v), __float_as_uint(v), false, false); return fmaxf(__uint_as_float(rr[0]), __uint_as_float(rr[1])); }
namespace pg8 {
#define PG8_LAS __attribute__((address_space(3)))
typedef unsigned short bf16_t;
typedef short bf16x8 __attribute__((ext_vector_type(8)));
typedef float f32x4 __attribute__((ext_vector_type(4)));
typedef unsigned u32x4 __attribute__((ext_vector_type(4)));
constexpr int BM = 256, BK = 64, HALF = 128, HTB = HALF * BK * 2  , STAGE_BYTES = 8 * HTB, NXCD = 8, WGM = 8;

__host__ __device__ __forceinline__ int lds_byte(int r, int c) { const int st = (r >> 4) * 2 + (c >> 5), rr = r & 15, cc = c & 31, ob = rr * 64 + cc * 2; return st * 1024 + (ob ^ (((ob >> 9) & 1) << 5)); }
__host__ __device__ __forceinline__ void stage_rc(int b, int& R, int& C) { const int st = b / 1024, sb = b % 1024, swz = sb ^ (((sb >> 9) & 1) << 5); R = (st >> 1) * 16 + swz / 64; C = (st & 1) * 32 + (swz % 64) / 2; }
__host__ __device__ __forceinline__ int perm32(int rho) { const int n = rho >> 4, i = rho & 15; return 8 * (i >> 2) + 4 * n + (i & 3); }

struct Unit { int pm, pn; };
struct Gemm { const bf16_t* A; const bf16_t* Bt; int M, N, K; };

struct StaticOrder {
    int nM, nN, nwg, G, c;
    __host__ __device__ void init(int M, int N, int G_, int c_) { nM = M / BM; nN = N / BM; nwg = nM * nN; G = G_; c = c_; }
    __host__ __device__ bool next(int i, Unit& u) const {
        const long L = (long)i * G + c; if (L >= nwg) return false;
        int wgid = (int)L; { const int q = nwg / NXCD, r = nwg % NXCD, xcd = wgid % NXCD, off = wgid / NXCD; wgid = (xcd < r ? xcd * (q + 1) : r * (q + 1) + (xcd - r) * q) + off; }
        const int nig = WGM * nN, gid = wgid / nig, fm = gid * WGM, gsz = (nM - fm) < WGM ? (nM - fm) : WGM;
        u.pm = fm + ((wgid % nig) % gsz); u.pn = (wgid % nig) / gsz; return true;
    }
    __device__ __forceinline__ void a_ready(const Unit&) const {}
    __device__ __forceinline__ void done(const Unit&) const {}
};


__device__ __forceinline__ unsigned cvt_pk_bf16(float lo, float hi) { unsigned r; asm volatile("v_cvt_pk_bf16_f32 %0, %1, %2" : "=v"(r) : "v"(lo), "v"(hi)); return r; }

struct EpiProj {
    static constexpr bool PERM = true, AFTER_DRAIN = false;
    bf16_t* O; int ldc; const float* ssq; const float* gq; const float* gk; int qlo, qhi, klo, khi; float qscale;
    const PG8_LAS float* rs; int pm0;
    __device__ __forceinline__ void operator()(const f32x4 (&acc)[2][2][4][2], const Unit& u, int wr, int wc, int fr, int fq) const {
        const int row0 = u.pm * BM + wr * 64 + fr, colw = u.pn * BM + wc * 64 + 8 * fq;
        const int mode = (u.pn >= qlo && u.pn < qhi) ? 1 : ((u.pn >= klo && u.pn < khi) ? 2 : 0);
        float rv[2][4];
        if (u.pm == pm0) {
#pragma unroll
            for (int ai = 0; ai < 2; ++ai)
#pragma unroll
                for (int m = 0; m < 4; ++m) rv[ai][m] = rs[wr * 64 + fr + ai * HALF + m * 16];
        } else {
#pragma unroll
            for (int ai = 0; ai < 2; ++ai)
#pragma unroll
                for (int m = 0; m < 4; ++m) { const int row = row0 + ai * HALF + m * 16;
                    const f32x4* sp = (const f32x4*)(ssq + (size_t)row * 32 + 8 * fq); const f32x4 sa = sp[0], sb = sp[1];
                    float s = ((sa.x + sa.y) + (sa.z + sa.w)) + ((sb.x + sb.y) + (sb.z + sb.w)); s += swz_xor<16>(s); s = xsum32(s);
                    rv[ai][m] = __builtin_amdgcn_rsqf(s * (1.0f / 2048.0f) + 1e-6f); }
        }
        if (mode == 0) {
#pragma unroll
            for (int ai = 0; ai < 2; ++ai)
#pragma unroll
                for (int m = 0; m < 4; ++m) { const float r = rv[ai][m]; bf16_t* rowp = O + (size_t)(row0 + ai * HALF + m * 16) * ldc + colw;
#pragma unroll
                    for (int bj = 0; bj < 2; ++bj) { const f32x4 v0 = acc[ai][bj][m][0] * r, v1 = acc[ai][bj][m][1] * r;
                        u32x4 w; w.x = cvt_pk_bf16(v0[0], v0[1]); w.y = cvt_pk_bf16(v0[2], v0[3]); w.z = cvt_pk_bf16(v1[0], v1[1]); w.w = cvt_pk_bf16(v1[2], v1[3]);
                        *(u32x4*)(rowp + 32 * bj) = w; } }
            return; }
        f32x4 gv[2][2];
        { const float* g = (mode == 1) ? gq : gk; const float s = (mode == 1) ? qscale : 1.f;
#pragma unroll
            for (int bj = 0; bj < 2; ++bj)
#pragma unroll
                for (int n = 0; n < 2; ++n) gv[bj][n] = *(const f32x4*)(g + 32 * bj + 8 * fq + 4 * n) * s; }
#pragma unroll
        for (int ai = 0; ai < 2; ++ai)
#pragma unroll
            for (int m = 0; m < 4; ++m) {
                const int row = row0 + ai * HALF + m * 16;
                const float r = rv[ai][m];
                f32x4 v[2][2]; float ss = 0.f;
#pragma unroll
                for (int bj = 0; bj < 2; ++bj)
#pragma unroll
                    for (int n = 0; n < 2; ++n) { v[bj][n] = acc[ai][bj][m][n] * r; const f32x4 q = v[bj][n] * v[bj][n]; ss += (q.x + q.y) + (q.z + q.w); }
                ss += swz_xor<16>(ss); ss = xsum32(ss); const float rn = __builtin_amdgcn_rsqf(ss * (1.0f / 64.0f) + 1e-6f);
                bf16_t* rowp = O + (size_t)row * ldc + colw;
#pragma unroll
                for (int bj = 0; bj < 2; ++bj) { const f32x4 v0 = v[bj][0] * gv[bj][0] * rn, v1 = v[bj][1] * gv[bj][1] * rn;
                    u32x4 w; w.x = cvt_pk_bf16(v0[0], v0[1]); w.y = cvt_pk_bf16(v0[2], v0[3]); w.z = cvt_pk_bf16(v1[0], v1[1]); w.w = cvt_pk_bf16(v1[2], v1[3]);
                    *(u32x4*)(rowp + 32 * bj) = w; }
            }
    }
};

struct EpiOut {
    static constexpr bool PERM = true, AFTER_DRAIN = false;
    float* xout; bf16_t* xb; float* ssq; int last;
    __device__ __forceinline__ void operator()(const f32x4 (&acc)[2][2][4][2], const Unit& u, int wr, int wc, int fr, int fq) const {
        const int row0 = u.pm * BM + wr * 64 + fr, colw = u.pn * BM + wc * 64 + 8 * fq;
#pragma unroll
        for (int ai = 0; ai < 2; ++ai)
#pragma unroll
            for (int m = 0; m < 4; ++m) {
                const int row = row0 + ai * HALF + m * 16; float ss = 0.f;
#pragma unroll
                for (int bj = 0; bj < 2; ++bj) { const size_t off = (size_t)row * 2048 + colw + 32 * bj;
                    const u32x4 xw = *(const u32x4*)(xb + off);
                    f32x4 v0, v1;
                    v0.x = __uint_as_float(xw.x << 16); v0.y = __uint_as_float(xw.x & 0xffff0000u); v0.z = __uint_as_float(xw.y << 16); v0.w = __uint_as_float(xw.y & 0xffff0000u);
                    v1.x = __uint_as_float(xw.z << 16); v1.y = __uint_as_float(xw.z & 0xffff0000u); v1.z = __uint_as_float(xw.w << 16); v1.w = __uint_as_float(xw.w & 0xffff0000u);
                    v0 = v0 + acc[ai][bj][m][0]; v1 = v1 + acc[ai][bj][m][1];
                    if (last) { f32x4* op = (f32x4*)(xout + off); op[0] = v0; op[1] = v1; }
                    else { u32x4 w; w.x = cvt_pk_bf16(v0[0], v0[1]); w.y = cvt_pk_bf16(v0[2], v0[3]); w.z = cvt_pk_bf16(v1[0], v1[1]); w.w = cvt_pk_bf16(v1[2], v1[3]);
                        *(u32x4*)(xb + off) = w;
                        const f32x4 q0 = v0 * v0, q1 = v1 * v1; ss += ((q0.x + q0.y) + (q0.z + q0.w)) + ((q1.x + q1.y) + (q1.z + q1.w)); } }
                if (!last) { ss += swz_xor<16>(ss); ss = xsum32(ss);
                    if (fq == 0) ssq[(size_t)row * 32 + u.pn * 4 + wc] = ss; }
            }
    }
};

template <class Epi, class Sched, bool ALIGN_EPI = false, bool SP2 = false>
__device__ __forceinline__ void gemm_phase(PG8_LAS unsigned char* lds, const Gemm g, const Sched& S, const Epi& E, int wv) {
    const int tid = opaque_tid(wv), wid = __builtin_amdgcn_readfirstlane(tid >> 6), lane = tid & 63, wr = wid >> 2, wc = wid & 3, fr = lane & 15, fq = lane >> 4;
    const int K = g.K, nt = K / BK;
    unsigned voffA[2], voffB[2];
#pragma unroll
    for (int i = 0; i < 2; ++i) { int R, C; stage_rc(tid * 16 + i * 8192, R, C); const int Rb = Epi::PERM ? ((R & ~31) + perm32(R & 31)) : R;
        voffA[i] = (unsigned)(R * K + C) * 2u; voffB[i] = (unsigned)(Rb * K + C) * 2u; }
    const size_t kstep = (size_t)(BK * 2);
    const size_t hstep = (size_t)HALF * K * 2;
    const size_t tstep = 2 * hstep;
    const unsigned ldsw = (unsigned)wid * 1024u;
    const int aoff = lds_byte(wr * 64 + fr, fq * 8), boff = lds_byte(wc * 32 + fr, fq * 8);
#define PG8_SA(b, h) (((b) * 2 + (h)) * HTB)
#define PG8_SB(b, h) ((4 + (b) * 2 + (h)) * HTB)
#define PG8_STAGE(bufoff, gbase, voff) do { _Pragma("unroll") for (int _i = 0; _i < 2; ++_i) \
        __builtin_amdgcn_global_load_lds((const unsigned*)((const char*)(gbase) + (voff)[_i]), (PG8_LAS unsigned*)(lds + (bufoff) + ldsw + _i * 8192), 16, 0, 0); } while (0)
#define PG8_LDA(dst, b, h) do { _Pragma("unroll") for (int m = 0; m < 4; ++m) _Pragma("unroll") for (int k = 0; k < 2; ++k) dst[m][k] = *(const PG8_LAS bf16x8*)(lds + PG8_SA(b, h) + aoff + m * 2048 + k * 1024); } while (0)
#define PG8_LDB(dst, b, h) do { _Pragma("unroll") for (int n = 0; n < 2; ++n) _Pragma("unroll") for (int k = 0; k < 2; ++k) dst[n][k] = *(const PG8_LAS bf16x8*)(lds + PG8_SB(b, h) + boff + n * 2048 + k * 1024); } while (0)
#define PG8_MMA(ai, bj, At, Bt) do { __builtin_amdgcn_s_setprio(1); _Pragma("unroll") for (int m = 0; m < 4; ++m) _Pragma("unroll") for (int n = 0; n < 2; ++n) _Pragma("unroll") for (int k = 0; k < 2; ++k) \
        acc[ai][bj][m][n] = __builtin_amdgcn_mfma_f32_16x16x32_bf16(Bt[n][k], At[m][k], acc[ai][bj][m][n], 0, 0, 0); __builtin_amdgcn_s_setprio(0); } while (0)
#define PG8_WAIT_V(n) asm volatile("s_waitcnt vmcnt(" #n ")" ::: "memory")
#define PG8_WAIT_L(n) asm volatile("s_waitcnt lgkmcnt(" #n ")" ::: "memory")
#define PG8_BAR __builtin_amdgcn_s_barrier()
#define PG8_SCHED __builtin_amdgcn_sched_barrier(0)
    Unit cur, nxt; int ui = 0;
    if (!S.next(0, cur)) return;
    f32x4 acc[2][2][4][2];
#pragma unroll
    for (int a = 0; a < 2; ++a)
#pragma unroll
        for (int b = 0; b < 2; ++b)
#pragma unroll
            for (int m = 0; m < 4; ++m)
#pragma unroll
                for (int n = 0; n < 2; ++n) acc[a][b][m][n] = (f32x4){0.f, 0.f, 0.f, 0.f};
    bf16x8 At[4][2], B0[2][2], B1[2][2];
    const char* cA = (const char*)g.A + (size_t)cur.pm * tstep; const char* cB = (const char*)g.Bt + (size_t)cur.pn * tstep;
    S.a_ready(cur);
    if constexpr (SP2) {
        PG8_STAGE(PG8_SB(0, 0), cB, voffB); PG8_STAGE(PG8_SB(0, 1), cB + hstep, voffB); PG8_STAGE(PG8_SA(0, 0), cA, voffA); PG8_STAGE(PG8_SA(0, 1), cA + hstep, voffA);
        if (wr == 1) PG8_BAR;
        PG8_WAIT_V(2); PG8_BAR;
        PG8_STAGE(PG8_SB(1, 0), cB + kstep, voffB); PG8_STAGE(PG8_SA(1, 0), cA + kstep, voffA); PG8_STAGE(PG8_SB(1, 1), cB + hstep + kstep, voffB);
        PG8_WAIT_V(6); PG8_BAR;
    } else {
        PG8_STAGE(PG8_SB(0, 0), cB, voffB); PG8_STAGE(PG8_SA(0, 0), cA, voffA); PG8_STAGE(PG8_SB(0, 1), cB + hstep, voffB); PG8_STAGE(PG8_SA(0, 1), cA + hstep, voffA);
        if (wr == 1) PG8_BAR;
        PG8_WAIT_V(4); PG8_BAR;
        PG8_STAGE(PG8_SB(1, 0), cB + kstep, voffB); PG8_STAGE(PG8_SA(1, 0), cA + kstep, voffA); PG8_STAGE(PG8_SB(1, 1), cB + hstep + kstep, voffB);
        PG8_WAIT_V(6); PG8_BAR;
    }
    for (;;) {
        const bool has_next = S.next(ui + 1, nxt);
        const char* nA = has_next ? (const char*)g.A + (size_t)nxt.pm * tstep : cA; const char* nB = has_next ? (const char*)g.Bt + (size_t)nxt.pn * tstep : cB;
        for (int t = 0; t < nt; t += 2) {
            const bool last = (t == nt - 2);
            const char* a1 = cA + (size_t)(t + 1) * kstep;
            const char* a2 = last ? nA : cA + (size_t)(t + 2) * kstep; const char* b2 = last ? nB : cB + (size_t)(t + 2) * kstep;
            const char* a3 = a2 + kstep; const char* b3 = b2 + kstep;
            if (last && has_next) S.a_ready(nxt);
            if constexpr (SP2) {
            PG8_LDB(B0, 0, 0); PG8_LDB(B1, 0, 1); PG8_SCHED; PG8_LDA(At, 0, 0); PG8_STAGE(PG8_SA(1, 1), a1 + hstep, voffA);
            PG8_WAIT_V(8); PG8_WAIT_L(0); PG8_BAR; PG8_MMA(0, 0, At, B0); PG8_MMA(0, 1, At, B1); PG8_BAR; PG8_SCHED;
            PG8_LDA(At, 0, 1); PG8_STAGE(PG8_SB(0, 0), b2, voffB); PG8_STAGE(PG8_SB(0, 1), b2 + hstep, voffB); PG8_STAGE(PG8_SA(0, 0), a2, voffA);
            PG8_WAIT_V(8); PG8_WAIT_L(0); PG8_BAR; PG8_MMA(1, 0, At, B0); PG8_MMA(1, 1, At, B1); PG8_BAR; PG8_SCHED;
            PG8_LDB(B0, 1, 0); PG8_LDB(B1, 1, 1); PG8_SCHED; PG8_LDA(At, 1, 0); PG8_STAGE(PG8_SA(0, 1), a2 + hstep, voffA);
            PG8_WAIT_V(8); PG8_WAIT_L(0); PG8_BAR; PG8_MMA(0, 0, At, B0); PG8_MMA(0, 1, At, B1); PG8_BAR; PG8_SCHED;
            PG8_LDA(At, 1, 1); PG8_STAGE(PG8_SB(1, 0), b3, voffB); PG8_STAGE(PG8_SB(1, 1), b3 + hstep, voffB); PG8_STAGE(PG8_SA(1, 0), a3, voffA);
            PG8_WAIT_V(8); PG8_WAIT_L(0); PG8_BAR; PG8_MMA(1, 0, At, B0); PG8_MMA(1, 1, At, B1); PG8_BAR; PG8_SCHED;
            } else {
            PG8_LDB(B0, 0, 0); PG8_SCHED; PG8_LDA(At, 0, 0); PG8_STAGE(PG8_SA(1, 1), a1 + hstep, voffA);
            PG8_WAIT_L(8); PG8_BAR; PG8_WAIT_L(0); PG8_MMA(0, 0, At, B0); PG8_BAR; PG8_SCHED;
            PG8_LDB(B1, 0, 1); PG8_STAGE(PG8_SB(0, 0), b2, voffB);
            PG8_BAR; PG8_WAIT_L(0); PG8_MMA(0, 1, At, B1); PG8_BAR;
            PG8_LDA(At, 0, 1); PG8_STAGE(PG8_SA(0, 0), a2, voffA);
            PG8_BAR; PG8_WAIT_L(0); PG8_MMA(1, 0, At, B0); PG8_BAR; PG8_SCHED;
            PG8_STAGE(PG8_SB(0, 1), b2 + hstep, voffB);
            PG8_WAIT_V(6); PG8_BAR; PG8_MMA(1, 1, At, B1); PG8_BAR;
            PG8_LDB(B0, 1, 0); PG8_SCHED; PG8_LDA(At, 1, 0); PG8_STAGE(PG8_SA(0, 1), a2 + hstep, voffA);
            PG8_WAIT_L(8); PG8_BAR; PG8_WAIT_L(0); PG8_MMA(0, 0, At, B0); PG8_BAR; PG8_SCHED;
            PG8_LDB(B1, 1, 1); PG8_STAGE(PG8_SB(1, 0), b3, voffB);
            PG8_BAR; PG8_WAIT_L(0); PG8_MMA(0, 1, At, B1); PG8_BAR;
            PG8_LDA(At, 1, 1); PG8_STAGE(PG8_SA(1, 0), a3, voffA);
            PG8_BAR; PG8_WAIT_L(0); PG8_MMA(1, 0, At, B0); PG8_BAR; PG8_SCHED;
            PG8_STAGE(PG8_SB(1, 1), b3 + hstep, voffB);
            PG8_WAIT_V(6); PG8_BAR; PG8_MMA(1, 1, At, B1); PG8_BAR;
            }
        }
        if constexpr (ALIGN_EPI) { if (wr == 0) PG8_BAR; }
        if constexpr (!Epi::AFTER_DRAIN) { E(acc, cur, wr, wc, fr, fq); S.done(cur); }
        if (!has_next) break;
#pragma unroll
        for (int a = 0; a < 2; ++a)
#pragma unroll
            for (int b = 0; b < 2; ++b)
#pragma unroll
                for (int m = 0; m < 4; ++m)
#pragma unroll
                    for (int n = 0; n < 2; ++n) acc[a][b][m][n] = (f32x4){0.f, 0.f, 0.f, 0.f};
        cur = nxt; cA = nA; cB = nB; ++ui;
        if constexpr (ALIGN_EPI) { if (wr == 1) PG8_BAR; }
    }
    PG8_WAIT_V(0);
    if constexpr (!ALIGN_EPI) { if (wr == 0) PG8_BAR; }
    PG8_BAR;
    if constexpr (Epi::AFTER_DRAIN) { E.fused(acc, cur, wr, wc, fr, fq, lds, wid, lane); S.done(cur); }
#undef PG8_SA
#undef PG8_SB
#undef PG8_STAGE
#undef PG8_LDA
#undef PG8_LDB
#undef PG8_MMA
#undef PG8_WAIT_V
#undef PG8_WAIT_L
#undef PG8_BAR
#undef PG8_SCHED
}
}

namespace att {
using bf16 = unsigned short;
using bf16x8 = __attribute__((ext_vector_type(8))) short;
using s16x4  = __attribute__((ext_vector_type(4))) short;
using f32x16 = __attribute__((ext_vector_type(16))) float;
using f32x4  = __attribute__((ext_vector_type(4))) float;
using u32x4  = __attribute__((ext_vector_type(4))) unsigned;
constexpr int KVBLK = 64;
constexpr int SHM_V = 64 * 128 * 2, SHM_K = 64 * 128 * 2;
#define KSWZ(row, colB) ((row) * 256 + ((colB) ^ (((row) & 15) << 4)))
#define SBAR() __builtin_amdgcn_sched_barrier(0)
__device__ __forceinline__ int crow(int r, int hi) { return (r & 3) + 8 * (r >> 2) + 4 * hi; }
typedef float f32x2_t __attribute__((ext_vector_type(2))); typedef __bf16 bf16x2_t __attribute__((ext_vector_type(2)));
__device__ __forceinline__ unsigned cvtpk(float lo, float hi) { f32x2_t v = {lo, hi}; bf16x2_t b = __builtin_convertvector(v, bf16x2_t); return __builtin_bit_cast(unsigned, b); }
__device__ __forceinline__ float bf2f(unsigned short h) { return __uint_as_float(((unsigned)h) << 16); }
__device__ __forceinline__ float wave_sum(float v) { v += swz_xor<1>(v); v += swz_xor<2>(v); v += swz_xor<4>(v); v += swz_xor<8>(v); v += swz_xor<16>(v); return xsum32(v); }
__device__ __forceinline__ float wave_max(float v) { v = fmaxf(v, swz_xor<1>(v)); v = fmaxf(v, swz_xor<2>(v)); v = fmaxf(v, swz_xor<4>(v)); v = fmaxf(v, swz_xor<8>(v)); v = fmaxf(v, swz_xor<16>(v)); return xmax32(v); }
__device__ __forceinline__ float uni(float x) { return __uint_as_float(__builtin_amdgcn_readfirstlane(__float_as_uint(x))); }
__device__ __forceinline__ int to_sgpr(int v) { asm volatile("" : "+v"(v)); return __builtin_amdgcn_readfirstlane(v); }
__device__ __forceinline__ float silu(float x) { return x / (1.0f + __expf(-x)); }

__device__ __forceinline__ int v_st(int k, int c) { const int kk = (k & ~0xC) | ((k & 4) << 1) | ((k & 8) >> 1); return ((kk >> 3) * 4 + (c >> 5)) * 512 + ((kk & 7) * 32 + (c & 31)) * 2; }
__device__ __forceinline__ int v_rd_base(int lane) { return ((lane & 3) << 3) | (((lane >> 2) & 3) << 6) | (((lane >> 4) & 1) << 5) | (((lane >> 5) & 1) << 8); }
constexpr int v_rd_off(int d0, int ks, int half) { return d0 * 512 + ks * 4096 + half * 2048; }
template <int OFF> __device__ __forceinline__ s16x4 tr_read(int vb) {
    s16x4 r; asm volatile("ds_read_b64_tr_b16 %0, %1 offset:%2" : "=&v"(r) : "v"(vb), "i"(OFF) : "memory"); return r;
}
template <int D0> __device__ __forceinline__ void pv_one(f32x16& od, int vb, bf16x8 pa0, bf16x8 pa1, bf16x8 pa2, bf16x8 pa3) {
    const s16x4 l0 = tr_read<v_rd_off(D0, 0, 0)>(vb), h0 = tr_read<v_rd_off(D0, 0, 1)>(vb), l1 = tr_read<v_rd_off(D0, 1, 0)>(vb), h1 = tr_read<v_rd_off(D0, 1, 1)>(vb);
    const s16x4 l2 = tr_read<v_rd_off(D0, 2, 0)>(vb), h2 = tr_read<v_rd_off(D0, 2, 1)>(vb), l3 = tr_read<v_rd_off(D0, 3, 0)>(vb), h3 = tr_read<v_rd_off(D0, 3, 1)>(vb);
    asm volatile("s_waitcnt lgkmcnt(0)" ::: "memory"); SBAR();
#define PK(L, H) (bf16x8){L[0], L[1], L[2], L[3], H[0], H[1], H[2], H[3]}
    od = __builtin_amdgcn_mfma_f32_32x32x16_bf16(pa0, PK(l0, h0), od, 0, 0, 0);
    od = __builtin_amdgcn_mfma_f32_32x32x16_bf16(pa1, PK(l1, h1), od, 0, 0, 0);
    od = __builtin_amdgcn_mfma_f32_32x32x16_bf16(pa2, PK(l2, h2), od, 0, 0, 0);
    od = __builtin_amdgcn_mfma_f32_32x32x16_bf16(pa3, PK(l3, h3), od, 0, 0, 0);
#undef PK
}
template <int KS> __device__ __forceinline__ void pv_ks(f32x16* o, int vb, bf16x8 pa) {
    const s16x4 l0 = tr_read<v_rd_off(0, KS, 0)>(vb), h0 = tr_read<v_rd_off(0, KS, 1)>(vb), l1 = tr_read<v_rd_off(1, KS, 0)>(vb), h1 = tr_read<v_rd_off(1, KS, 1)>(vb);
    const s16x4 l2 = tr_read<v_rd_off(2, KS, 0)>(vb), h2 = tr_read<v_rd_off(2, KS, 1)>(vb), l3 = tr_read<v_rd_off(3, KS, 0)>(vb), h3 = tr_read<v_rd_off(3, KS, 1)>(vb);
#define PK(L, H) (bf16x8){L[0], L[1], L[2], L[3], H[0], H[1], H[2], H[3]}
    asm volatile("s_waitcnt lgkmcnt(6)" ::: "memory"); SBAR();
    o[0] = __builtin_amdgcn_mfma_f32_32x32x16_bf16(pa, PK(l0, h0), o[0], 0, 0, 0);
    asm volatile("s_waitcnt lgkmcnt(4)" ::: "memory"); SBAR();
    o[1] = __builtin_amdgcn_mfma_f32_32x32x16_bf16(pa, PK(l1, h1), o[1], 0, 0, 0);
    asm volatile("s_waitcnt lgkmcnt(2)" ::: "memory"); SBAR();
    o[2] = __builtin_amdgcn_mfma_f32_32x32x16_bf16(pa, PK(l2, h2), o[2], 0, 0, 0);
    asm volatile("s_waitcnt lgkmcnt(0)" ::: "memory"); SBAR();
    o[3] = __builtin_amdgcn_mfma_f32_32x32x16_bf16(pa, PK(l3, h3), o[3], 0, 0, 0);
#undef PK
}
__device__ __forceinline__ void pv_d0(f32x16* o, int vb, bf16x8 pa0, bf16x8 pa1, bf16x8 pa2, bf16x8 pa3) {
    __builtin_amdgcn_s_setprio(1);
    pv_ks<0>(o, vb, pa0); pv_ks<1>(o, vb, pa1); pv_ks<2>(o, vb, pa2); pv_ks<3>(o, vb, pa3);
    __builtin_amdgcn_s_setprio(0);
}
__device__ __forceinline__ void exp_half(f32x16& p) {
#pragma unroll
    for (int r = 0; r < 16; ++r) p[r] = __builtin_amdgcn_exp2f(p[r]);
}
__device__ __forceinline__ void pack_p(const f32x16& p0, const f32x16& p1, float& l_reg, bf16x8& pa0, bf16x8& pa1, bf16x8& pa2, bf16x8& pa3) {
    float ps = 0;
#pragma unroll
    for (int r = 0; r < 16; ++r) ps += p0[r];
#pragma unroll
    for (int r = 0; r < 16; ++r) ps += p1[r];
    l_reg += ps;
#define PK4(P, BASE, OUT) do { u32x4 w = {cvtpk(P[BASE + 0], P[BASE + 1]), cvtpk(P[BASE + 2], P[BASE + 3]), cvtpk(P[BASE + 4], P[BASE + 5]), cvtpk(P[BASE + 6], P[BASE + 7])}; \
    OUT = *reinterpret_cast<bf16x8*>(&w); } while (0)
    PK4(p0, 0, pa0); PK4(p0, 8, pa1); PK4(p1, 0, pa2); PK4(p1, 8, pa3);
#undef PK4
}
template <int ND0> __device__ __forceinline__ void qkt(f32x16& p0, f32x16& p1, const char* Ks, const bf16x8* qr, int r32, int hi, int colB0) {
#pragma unroll
    for (int d0 = 0; d0 < ND0; ++d0) { const int cb = colB0 + (d0 * 16 + hi * 8) * 2;
        const bf16x8 b0 = *reinterpret_cast<const bf16x8*>(Ks + KSWZ(r32, cb));
        const bf16x8 b1 = *reinterpret_cast<const bf16x8*>(Ks + KSWZ(32 + r32, cb));
        p0 = __builtin_amdgcn_mfma_f32_32x32x16_bf16(b0, qr[d0], p0, 0, 0, 0);
        p1 = __builtin_amdgcn_mfma_f32_32x32x16_bf16(b1, qr[d0], p1, 0, 0, 0); }
}
__device__ __forceinline__ void bias_init(f32x16& p0, f32x16& p1, float base, float nslope2, float nM2, int rel  ) {
    if (rel <= -63 || rel >= 31) {
        const float sg = (rel < 0) ? -nslope2 : nslope2, lbv = fmaf(-sg, base, nM2);
#pragma unroll
        for (int r = 0; r < 16; ++r) { p0[r] = fmaf((float)((r & 3) + 8 * (r >> 2)), sg, lbv); p1[r] = fmaf((float)((r & 3) + 8 * (r >> 2) + 32), sg, lbv); }
    } else {
#pragma unroll
        for (int r = 0; r < 16; ++r) { const float d = base - (float)((r & 3) + 8 * (r >> 2));
            p0[r] = fmaf(fabsf(d), nslope2, nM2); p1[r] = fmaf(fabsf(d - 32.f), nslope2, nM2); }
    }
}

struct DiffArgs { const bf16* proj; bf16* y; const float* ghead; int nM2b, lamb, laminitb; };

__device__ __forceinline__ void diff_unit(const DiffArgs& A, int b, int h, int qb, char* lds, int wv) {
    const int tid = opaque_tid(wv), wid = __builtin_amdgcn_readfirstlane(tid >> 6), lane = tid & 63, r32 = lane & 31, hi = lane >> 5, c = wid >> 2, wq = wid & 3;
    const char* Pb = (const char*)A.proj + ((size_t)b * SEQ * INC + h * 128) * 2;
    char* V_lds = lds; char* K_lds = lds + 4 * SHM_V;
    float* wsl = (float*)(lds + 131072) + wid * 64;
    int t_lo, nt; float nM2, lam, lam_init;
    { int a_ = A.nM2b, b_ = A.lamb, c_ = A.laminitb;
      asm volatile("" : "+s"(a_), "+s"(b_), "+s"(c_)); nM2 = __int_as_float(a_); lam = __int_as_float(b_); lam_init = __int_as_float(c_); }
    const float slope = exp2f(-8.0f * (float)(h + 1) / 6.0f);
    const float nslope2 = uni(-slope * LOG2E);
    { const float Df = (151.0f + 2.0f * (-nM2)) / (-nslope2); const int Dk = Df > 20000.f ? 20000 : (int)Df + 1; const int i0 = qb * 128;
      int lo_ = i0 - Dk + 1; lo_ = lo_ > 0 ? (lo_ >> 6) : 0; int hi_ = (i0 + 126 + Dk) >> 6; hi_ = hi_ > SEQ / KVBLK - 1 ? SEQ / KVBLK - 1 : hi_;
      if (((hi_ - lo_ + 1) & 1) != 0) { if (lo_ > 0) --lo_; else ++hi_; }
      t_lo = __builtin_amdgcn_readfirstlane(lo_); nt = __builtin_amdgcn_readfirstlane(hi_ - lo_ + 1); }
    const int ipos = qb * 128 + wq * 32 + r32;
    float l_reg = 0; f32x16 o[4] = {}; bf16x8 qr[4];
    { const char* Qw = Pb + (size_t)(qb * 128 + wq * 32) * (INC * 2) + (C_DQ + c * 64) * 2; const unsigned qoff = (unsigned)((r32 * INC + hi * 8) * 2);
#pragma unroll
      for (int d0 = 0; d0 < 4; ++d0) qr[d0] = *reinterpret_cast<const bf16x8*>(Qw + qoff + d0 * 32); }
    const int colB0 = c * 128;
    const int krow = wid * 4 + (lane >> 4), kcc = (lane & 15) ^ (krow & 15);
    const unsigned koff = (unsigned)((krow * INC + kcc * 8) * 2);
    const int vkey = (wid >> 2) * 16 + (((wid >> 1) & 1) << 3) + (((lane >> 4) & 1) << 2) + ((lane >> 2) & 3)  , vcol = ((wid & 1) * 2 + (lane >> 5)) * 32 + (lane & 3) * 8;
    const unsigned voff = (unsigned)((vkey * INC + vcol) * 2 + (C_DV - C_DK) * 2);
    const int vb0 = (int)(uintptr_t)V_lds + v_rd_base(lane);
    const char* Pk = Pb + (size_t)(t_lo * KVBLK) * (INC * 2) + C_DK * 2; int iposk = ipos - t_lo * KVBLK - 4 * hi; asm volatile("" : "+v"(iposk));     const int relw = t_lo * KVBLK - (qb * 128 + wq * 32);
    typedef __attribute__((address_space(3))) unsigned lds_u32;
    __attribute__((address_space(3))) unsigned char* ldsA = (__attribute__((address_space(3))) unsigned char*)lds + wid * 1024;
#define GLDS(gp, lp) __builtin_amdgcn_global_load_lds((const unsigned*)(gp), (lds_u32*)(lp), 16, 0, 0)
#define STAGE(t) do { const char* kt_ = Pk + (size_t)((t) * KVBLK) * (INC * 2); const int so_ = ((t) & 3) * SHM_K; \
    GLDS(kt_ + koff, ldsA + 4 * SHM_V + so_); GLDS(kt_ + 32 * INC * 2 + koff, ldsA + 4 * SHM_V + so_ + 8192); \
    GLDS(kt_ + voff, ldsA + so_); GLDS(kt_ + 32 * INC * 2 + voff, ldsA + so_ + 8192); } while (0)
#define SLOT(t) (((t) & 3) * SHM_K)
#define ENDI() do { asm volatile("s_waitcnt vmcnt(0)" ::: "memory"); __syncthreads(); } while (0)
#define BIAS(P0, P1, t) bias_init(P0, P1, (float)(iposk - (t) * KVBLK), nslope2, nM2, relw + (t) * KVBLK)
    f32x16 pA0, pA1, pB0, pB1; bf16x8 pa0, pa1, pa2, pa3; const int NT = nt;
    STAGE(0); ENDI();
    STAGE(1);
    BIAS(pA0, pA1, 0); qkt<4>(pA0, pA1, K_lds, qr, r32, hi, colB0);
#if DIFF_ANTIPHASE
    if (c == 0) {
#endif
        const int lp_ = opaque_tid(wv) & 63, r32p = lp_ & 31, hip = lp_ >> 5;
        exp_half(pA0);
        ENDI();
#pragma unroll 1
        for (int j = 1; j + 1 < NT; j += 2) {
            STAGE(j + 1);
            SBAR(); BIAS(pB0, pB1, j); qkt<4>(pB0, pB1, K_lds + SLOT(j), qr, r32p, hip, colB0);
            exp_half(pA1); pack_p(pA0, pA1, l_reg, pa0, pa1, pa2, pa3); SBAR();
            pv_d0(o, vb0 + SLOT(j - 1), pa0, pa1, pa2, pa3); exp_half(pB0);
            ENDI();
            STAGE(j + 2);
            SBAR(); BIAS(pA0, pA1, j + 1); qkt<4>(pA0, pA1, K_lds + SLOT(j + 1), qr, r32p, hip, colB0);
            exp_half(pB1); pack_p(pB0, pB1, l_reg, pa0, pa1, pa2, pa3); SBAR();
            pv_d0(o, vb0 + SLOT(j), pa0, pa1, pa2, pa3); exp_half(pA0);
            ENDI();
        }
        { const int lt_ = opaque_tid(wv) & 63;
          SBAR(); BIAS(pB0, pB1, NT - 1); qkt<4>(pB0, pB1, K_lds + SLOT(NT - 1), qr, lt_ & 31, lt_ >> 5, colB0); }
        exp_half(pA1); pack_p(pA0, pA1, l_reg, pa0, pa1, pa2, pa3); SBAR();
        pv_d0(o, vb0 + SLOT(NT - 2), pa0, pa1, pa2, pa3); exp_half(pB0);
        exp_half(pB1); pack_p(pB0, pB1, l_reg, pa0, pa1, pa2, pa3); SBAR();
        pv_d0(o, vb0 + SLOT(NT - 1), pa0, pa1, pa2, pa3);
#if DIFF_ANTIPHASE
    } else {
        const int lp_ = opaque_tid(wv) & 63, r32p = lp_ & 31, hip = lp_ >> 5;
        pa0 = bf16x8{}; pa1 = bf16x8{}; pa2 = bf16x8{}; pa3 = bf16x8{};
        ENDI();
#pragma unroll 1
        for (int j = 1; j + 1 < NT; j += 2) {
            STAGE(j + 1);
            SBAR(); pv_d0(o, vb0 + (j > 1 ? SLOT(j - 2) : 0), pa0, pa1, pa2, pa3);
            exp_half(pA0); SBAR();
            BIAS(pB0, pB1, j); qkt<4>(pB0, pB1, K_lds + SLOT(j), qr, r32p, hip, colB0);
            exp_half(pA1); pack_p(pA0, pA1, l_reg, pa0, pa1, pa2, pa3); SBAR();
            ENDI();
            STAGE(j + 2);
            SBAR(); pv_d0(o, vb0 + SLOT(j - 1), pa0, pa1, pa2, pa3);
            exp_half(pB0); SBAR();
            BIAS(pA0, pA1, j + 1); qkt<4>(pA0, pA1, K_lds + SLOT(j + 1), qr, r32p, hip, colB0);
            exp_half(pB1); pack_p(pB0, pB1, l_reg, pa0, pa1, pa2, pa3); SBAR();
            ENDI();
        }
        SBAR(); pv_d0(o, vb0 + SLOT(NT - 3), pa0, pa1, pa2, pa3);
        exp_half(pA0); SBAR();
        { const int lt_ = opaque_tid(wv) & 63;
          BIAS(pB0, pB1, NT - 1); qkt<4>(pB0, pB1, K_lds + SLOT(NT - 1), qr, lt_ & 31, lt_ >> 5, colB0); }
        exp_half(pA1); pack_p(pA0, pA1, l_reg, pa0, pa1, pa2, pa3); SBAR();
        pv_d0(o, vb0 + SLOT(NT - 2), pa0, pa1, pa2, pa3);
        exp_half(pB0); exp_half(pB1); pack_p(pB0, pB1, l_reg, pa0, pa1, pa2, pa3); SBAR();
        pv_d0(o, vb0 + SLOT(NT - 1), pa0, pa1, pa2, pa3);
    }
#endif
#undef GLDS
#undef STAGE
#undef SLOT
#undef ENDI
#undef BIAS
    { auto rr = __builtin_amdgcn_permlane32_swap(__float_as_uint(l_reg), __float_as_uint(l_reg), false, false);
      l_reg = __uint_as_float(rr[0]) + __uint_as_float(rr[1]); }
    const int tid_e = opaque_tid(wv), lane_e = tid_e & 63;
#define tid tid_e
#define r32 (lane_e & 31)
#define hi (lane_e >> 5)
    if (hi == 0) wsl[r32] = l_reg;
    asm volatile("s_waitcnt lgkmcnt(0)" ::: "memory");
    float rli[16];
#pragma unroll
    for (int r = 0; r < 16; ++r) rli[r] = (c ? lam : 1.0f) / wsl[crow(r, hi)];
    __syncthreads();
    float* OS = (float*)lds;
    if (c == 1) {
#pragma unroll
        for (int r = 0; r < 16; ++r) { float* orow = OS + (wq * 32 + crow(r, hi)) * 132 + r32;
#pragma unroll
            for (int d0 = 0; d0 < 4; ++d0) orow[d0 * 32] = o[d0][r] * rli[r]; }
    }
    __syncthreads();
    if (c == 0) {
#pragma unroll
        for (int r = 0; r < 16; ++r) { float* orow = OS + (wq * 32 + crow(r, hi)) * 132 + r32;
#pragma unroll
            for (int d0 = 0; d0 < 4; ++d0) orow[d0 * 32] = o[d0][r] * rli[r] - orow[d0 * 32]; }
    }
    __syncthreads();
    { const int row = tid >> 2, cq = tid & 3; const float* src = OS + row * 132 + cq * 32;
      f32x4 v[8]; float ss = 0.f;
#pragma unroll
      for (int i = 0; i < 8; ++i) { v[i] = *(const f32x4*)(src + 4 * i); const f32x4 q = v[i] * v[i]; ss += (q.x + q.y) + (q.z + q.w); }
      ss += swz_xor<1>(ss); ss += swz_xor<2>(ss);
      const float rn = (1.0f - lam_init) / sqrtf(ss * (1.0f / 128.0f) + EPS);
      const bf16* gp = (const bf16*)(Pb + (size_t)(qb * 128) * (INC * 2) + C_DG * 2 + (unsigned)((row * INC + cq * 32) * 2));
      bf16* yp = (bf16*)((char*)A.y + ((size_t)(b * SEQ + qb * 128) * DM + Y_D + h * 128) * 2 + (unsigned)((row * DM + cq * 32) * 2)); const float* gh = A.ghead + cq * 32;
#pragma unroll
      for (int i = 0; i < 4; ++i) { const bf16x8 g8 = *reinterpret_cast<const bf16x8*>(gp + 8 * i); const f32x4 h0 = *(const f32x4*)(gh + 8 * i), h1 = *(const f32x4*)(gh + 8 * i + 4);
          const f32x4 a = v[2 * i] * h0 * rn, bq = v[2 * i + 1] * h1 * rn;
          u32x4 w; w.x = cvtpk(a.x * silu(bf2f(g8[0])), a.y * silu(bf2f(g8[1]))); w.y = cvtpk(a.z * silu(bf2f(g8[2])), a.w * silu(bf2f(g8[3])));
          w.z = cvtpk(bq.x * silu(bf2f(g8[4])), bq.y * silu(bf2f(g8[5]))); w.w = cvtpk(bq.z * silu(bf2f(g8[6])), bq.w * silu(bf2f(g8[7])));
          *(u32x4*)(yp + 8 * i) = w; } }
    __syncthreads();
#undef tid
#undef r32
#undef hi
}

__device__ __forceinline__ int next_item(unsigned* ctr, char* lds, int tid) {
    int* slot = (int*)(lds + 131072 + 3072);
    if (tid == 0) *slot = (int)atomicAdd(ctr, 1u);
    __syncthreads();
    return __builtin_amdgcn_readfirstlane(*slot);
}

struct MemArgs { const bf16* proj; const bf16* mkv; bf16* y; const float* gmq; const float* gmk; int layer; };
__device__ __forceinline__ void mem_unit(const MemArgs& A, int unit, char* lds, int wv) {
    const int tid = opaque_tid(wv), wid = __builtin_amdgcn_readfirstlane(tid >> 6), lane = tid & 63, r32 = lane & 31, hi = lane >> 5;
    const int b = unit / (4 * 32), hm = (unit / 32) % 4, qb = unit % 32;
    const bf16* Kh = A.mkv + (size_t)b * NMEM * MKVC + A.layer * 1024 + hm * 128;
    const bf16* Vh = Kh + 512;
    char* V_lds = lds; char* K_lds = lds + 4 * SHM_V;
    float* wsl = (float*)(lds + 131072) + wid * 64;
    float nM2;
    { const float a = wave_max(fmaxf(fabsf(A.gmq[lane]), fabsf(A.gmq[lane + 64]))), bb = wave_max(fmaxf(fabsf(A.gmk[lane]), fabsf(A.gmk[lane + 64])));
      nM2 = -(11.3137085f * a * bb * LOG2E * 1.03f + 0.25f); }
    { const int sr = tid >> 4, sc = (tid & 15) * 8, kc = sc * 2;
      const f32x4 g0 = *(const f32x4*)(A.gmk + sc), g1 = *(const f32x4*)(A.gmk + sc + 4);
#pragma unroll
      for (int t = 0; t < 4; ++t)
#pragma unroll
        for (int hh = 0; hh < 2; ++hh) { const int key = t * 64 + hh * 32 + sr;
          const bf16x8 v8 = *reinterpret_cast<const bf16x8*>(&Vh[(size_t)key * MKVC + sc]); const bf16x8 k8 = *reinterpret_cast<const bf16x8*>(&Kh[(size_t)key * MKVC + sc]);
          float f[8]; float ss = 0.f;
#pragma unroll
          for (int i = 0; i < 8; ++i) { f[i] = bf2f((unsigned short)k8[i]); ss += f[i] * f[i]; }
          ss += swz_xor<1>(ss); ss += swz_xor<2>(ss); ss += swz_xor<4>(ss); ss += swz_xor<8>(ss);
          const float rn = 1.0f / sqrtf(ss * (1.0f / 128.0f) + EPS);
          u32x4 w; w.x = cvtpk(f[0] * rn * g0.x, f[1] * rn * g0.y); w.y = cvtpk(f[2] * rn * g0.z, f[3] * rn * g0.w); w.z = cvtpk(f[4] * rn * g1.x, f[5] * rn * g1.y); w.w = cvtpk(f[6] * rn * g1.z, f[7] * rn * g1.w);
          *(u32x4*)(K_lds + t * SHM_K + KSWZ(hh * 32 + sr, kc)) = w;
          { const int ks_ = hh * 32 + sr, kp_ = (ks_ & ~0xC) | ((ks_ & 4) << 1) | ((ks_ & 8) >> 1);
            *(bf16x8*)(V_lds + t * SHM_V + v_st(kp_, sc)) = v8; } } }
    bf16x8 qr[8];
    const size_t grow0 = (size_t)b * SEQ + qb * 256 + wid * 32;
    { const bf16* Qw = A.proj + (grow0 + r32) * INC + C_MQ + hm * 128 + hi * 8;
      bf16x8 raw[8]; float ss = 0.f;
#pragma unroll
      for (int d0 = 0; d0 < 8; ++d0) { raw[d0] = *reinterpret_cast<const bf16x8*>(Qw + d0 * 16);
#pragma unroll
          for (int i = 0; i < 8; ++i) { const float f = bf2f((unsigned short)raw[d0][i]); ss += f * f; } }
      { auto rr = __builtin_amdgcn_permlane32_swap(__float_as_uint(ss), __float_as_uint(ss), false, false); ss = __uint_as_float(rr[0]) + __uint_as_float(rr[1]); }
      const float rn = QSCALE_M / sqrtf(ss * (1.0f / 128.0f) + EPS);
#pragma unroll
      for (int d0 = 0; d0 < 8; ++d0) { const f32x4 g0 = *(const f32x4*)(A.gmq + d0 * 16 + hi * 8), g1 = *(const f32x4*)(A.gmq + d0 * 16 + hi * 8 + 4);
          u32x4 w; w.x = cvtpk(bf2f((unsigned short)raw[d0][0]) * rn * g0.x, bf2f((unsigned short)raw[d0][1]) * rn * g0.y); w.y = cvtpk(bf2f((unsigned short)raw[d0][2]) * rn * g0.z, bf2f((unsigned short)raw[d0][3]) * rn * g0.w);
          w.z = cvtpk(bf2f((unsigned short)raw[d0][4]) * rn * g1.x, bf2f((unsigned short)raw[d0][5]) * rn * g1.y); w.w = cvtpk(bf2f((unsigned short)raw[d0][6]) * rn * g1.z, bf2f((unsigned short)raw[d0][7]) * rn * g1.w);
          qr[d0] = *reinterpret_cast<bf16x8*>(&w); } }
    __syncthreads();
    float l_reg = 0; f32x16 o[4] = {};
    const int vb0 = (int)(uintptr_t)V_lds + v_rd_base(lane);
#pragma unroll 1
    for (int t = 0; t < 4; ++t) {
        f32x16 p0, p1; bf16x8 pa0, pa1, pa2, pa3;
#pragma unroll
        for (int r = 0; r < 16; ++r) { p0[r] = nM2; p1[r] = nM2; }
        qkt<8>(p0, p1, K_lds + t * SHM_K, qr, r32, hi, 0);
        exp_half(p0); exp_half(p1); pack_p(p0, p1, l_reg, pa0, pa1, pa2, pa3); SBAR();
        pv_d0(o, vb0 + t * SHM_V, pa0, pa1, pa2, pa3);
    }
    { auto rr = __builtin_amdgcn_permlane32_swap(__float_as_uint(l_reg), __float_as_uint(l_reg), false, false);
      l_reg = __uint_as_float(rr[0]) + __uint_as_float(rr[1]); }
    if (hi == 0) wsl[r32] = l_reg;
    asm volatile("s_waitcnt lgkmcnt(0)" ::: "memory");
#pragma unroll
    for (int r = 0; r < 16; ++r) { const int rr_ = crow(r, hi); const float rl = 1.0f / wsl[rr_];
        const bf16* gp = A.proj + (grow0 + rr_) * INC + C_MG + hm * 128 + r32; bf16* yp = A.y + (grow0 + rr_) * DM + Y_M + hm * 128 + r32;
#pragma unroll
        for (int d0 = 0; d0 < 4; ++d0) { const float g = bf2f(gp[d0 * 32]); const float val = o[d0][r] * rl * silu(g);
            yp[d0 * 32] = (bf16)(cvtpk(val, val) & 0xffffu); } }
    __syncthreads();
}

struct ConvArgs { const bf16* proj; bf16* y; const float* w; const float* bias; };
__device__ __forceinline__ void conv_items(const ConvArgs& A, long first, long stride) {
    constexpr long NIT = (long)(MTOK / 4) * 96;
    for (long it = first; it < NIT; it += stride) {
        const int row0 = (int)(it / 96) * 4, c8 = (int)(it % 96) * 8, t0 = row0 & (SEQ - 1);
        const bf16* p = A.proj + (size_t)row0 * INC + c8;
        bf16x8 xr[6], cr[6], br[4], gr[4];
#pragma unroll
        for (int i = 0; i < 6; ++i) { const int t = t0 - 1 + i; const bool ok = (t >= 0) && (t < SEQ);
            xr[i] = ok ? *reinterpret_cast<const bf16x8*>(p + (long)(i - 1) * INC + C_AX) : bf16x8{}; cr[i] = ok ? *reinterpret_cast<const bf16x8*>(p + (long)(i - 1) * INC + C_AC) : bf16x8{}; }
#pragma unroll
        for (int i = 0; i < 4; ++i) { br[i] = *reinterpret_cast<const bf16x8*>(p + (long)i * INC + C_AB); gr[i] = *reinterpret_cast<const bf16x8*>(p + (long)i * INC + C_AG); }
        float w0[8], w1[8], w2[8], bb[8];
#pragma unroll
        for (int i = 0; i < 2; ++i) { const f32x4 a = *(const f32x4*)(A.w + c8 + 4 * i), bq = *(const f32x4*)(A.w + 768 + c8 + 4 * i), cc = *(const f32x4*)(A.w + 1536 + c8 + 4 * i), dd = *(const f32x4*)(A.bias + c8 + 4 * i);
#pragma unroll
            for (int k = 0; k < 4; ++k) { w0[4 * i + k] = a[k]; w1[4 * i + k] = bq[k]; w2[4 * i + k] = cc[k]; bb[4 * i + k] = dd[k]; } }
        float u[6][8];
#pragma unroll
        for (int i = 0; i < 6; ++i)
#pragma unroll
            for (int k = 0; k < 8; ++k) u[i][k] = bf2f((unsigned short)cr[i][k]) * bf2f((unsigned short)xr[i][k]);
#pragma unroll
        for (int j = 0; j < 4; ++j) { float out[8];
#pragma unroll
            for (int k = 0; k < 8; ++k) { const float z = u[j][k] * w0[k] + u[j + 1][k] * w1[k] + u[j + 2][k] * w2[k] + bb[k];
                out[k] = bf2f((unsigned short)br[j][k]) * z * silu(bf2f((unsigned short)gr[j][k])); }
            u32x4 w; w.x = cvtpk(out[0], out[1]); w.y = cvtpk(out[2], out[3]); w.z = cvtpk(out[4], out[5]); w.w = cvtpk(out[6], out[7]);
            *(u32x4*)(A.y + (size_t)(row0 + j) * DM + Y_A + c8) = w; }
    }
}
}

using att::bf16;
typedef float f32x4_t __attribute__((ext_vector_type(4)));
typedef unsigned u32x4_t __attribute__((ext_vector_type(4)));
typedef unsigned u32x2_t __attribute__((ext_vector_type(2)));

__device__ __forceinline__ void transpose_item(const float* __restrict__ W, int K, int N, const float* __restrict__ gain, bf16* __restrict__ WT, float* scr, int item, int lane) {
    const int nblk = N / 32, kb = item / nblk, nb = item % nblk, k0 = 64 * kb, n0 = 32 * nb;
    float wv_[32], gv_[32];
    const float* wp_ = W + (size_t)(k0 + (lane >> 5)) * N + n0 + (lane & 31);
#pragma unroll
    for (int i = 0; i < 32; ++i) { wv_[i] = wp_[(size_t)(2 * i) * N]; gv_[i] = gain ? gain[k0 + 2 * i + (lane >> 5)] : 1.0f; }
#pragma unroll
    for (int i = 0; i < 32; ++i) scr[(2 * i + (lane >> 5)) * 33 + (lane & 31)] = wv_[i] * gv_[i];
    __builtin_amdgcn_s_waitcnt(0xc07f); asm volatile("s_waitcnt lgkmcnt(0)" ::: "memory");
    const int g8 = (n0 & 255) >> 5, n0p = (n0 & ~255) + 128 * (g8 & 1) + 32 * (g8 >> 1);
    const int c = lane & 7;
#pragma unroll
    for (int j = 0; j < 4; ++j) { const int n = (lane >> 3) + 8 * j; const float* s = scr + (8 * c) * 33 + n;
        u32x4_t o; o.x = pg8::cvt_pk_bf16(s[0 * 33], s[1 * 33]); o.y = pg8::cvt_pk_bf16(s[2 * 33], s[3 * 33]); o.z = pg8::cvt_pk_bf16(s[4 * 33], s[5 * 33]); o.w = pg8::cvt_pk_bf16(s[6 * 33], s[7 * 33]);
        *(u32x4_t*)(WT + (size_t)(n0p + n) * K + k0 + 8 * c) = o; }
    asm volatile("s_waitcnt lgkmcnt(0)" ::: "memory");
}
__device__ __forceinline__ void row_to_bf16(const float* __restrict__ xrow, bf16* __restrict__ orow, float* __restrict__ ssrow, int lane) {
    const f32x4_t* xr = (const f32x4_t*)xrow + lane; f32x4_t v[8]; float s = 0.f;
#pragma unroll
    for (int j = 0; j < 8; ++j) { v[j] = xr[64 * j]; s += (v[j].x * v[j].x + v[j].y * v[j].y) + (v[j].z * v[j].z + v[j].w * v[j].w); }
    s = att::wave_sum(s);
    u32x2_t* o8 = (u32x2_t*)orow + lane;
#pragma unroll
    for (int j = 0; j < 8; ++j) { u32x2_t w; w.x = pg8::cvt_pk_bf16(v[j].x, v[j].y); w.y = pg8::cvt_pk_bf16(v[j].z, v[j].w); o8[64 * j] = w; }
    if (lane < 32) ssrow[lane] = (lane == 0) ? s : 0.f;
}


#define XB_TMO      128
#define XB_XCNT(j)  (256  + 64 * (j))
#define XB_XSUB(j)  (1280 + 64 * (j))
#define XB_XGEN(j)  (2304 + 64 * (j))
#define XB_TOP      3328
#define XB_TOPGEN   3392
#define XCD_BAR_WORDS 3456
#define XB_SPIN_CAP (1u << 18)
#define LAS __attribute__((address_space(3)))

__device__ __forceinline__ unsigned xb_ld(unsigned* p)              { return __hip_atomic_load(p, __ATOMIC_RELAXED, __HIP_MEMORY_SCOPE_AGENT); }
__device__ __forceinline__ unsigned xb_add(unsigned* p, unsigned v) { return __hip_atomic_fetch_add(p, v, __ATOMIC_RELAXED, __HIP_MEMORY_SCOPE_AGENT); }
__device__ __forceinline__ unsigned xb_xcc_id() { return (unsigned)__builtin_amdgcn_s_getreg((3 << 11) | 20) & 0xFu; }
#define XB_SPIN(cond, bar) do { unsigned _sp = 0; while (cond) { __builtin_amdgcn_s_sleep(1); \
    if ((++_sp & 255u) == 0u) { if (xb_ld(&(bar)[XB_TMO])) break; if (_sp > XB_SPIN_CAP) { atomicAdd(&(bar)[XB_TMO], 1u); break; } } } } while (0)

struct XcdBarrier {
    unsigned* bar; unsigned x;
    volatile LAS unsigned* st;
};

__device__ __forceinline__ XcdBarrier xcd_barrier_post(unsigned* bar, volatile LAS unsigned* st) {
    XcdBarrier b; b.bar = bar; b.x = xb_xcc_id(); b.st = st;
    if (threadIdx.x == 0) (void)xb_add(&bar[XB_XCNT(b.x)], 1u);
    return b;
}
__device__ __forceinline__ void xcd_barrier_complete(unsigned* bar, unsigned x, unsigned& nloc, unsigned& nx) {
    const unsigned G = gridDim.x * gridDim.y * gridDim.z;
    unsigned sum, cnt, mine, sp = 0u;
    for (;;) {
        sum = 0u; cnt = 0u; mine = 0u;
#pragma unroll
        for (unsigned j = 0; j < 16; ++j) { const unsigned c = xb_ld(&bar[XB_XCNT(j)]); sum += c; cnt += (c > 0u) ? 1u : 0u; mine = (j == x) ? c : mine; }
        if (sum == G) break;
        __builtin_amdgcn_s_sleep(1);
        if ((++sp & 255u) == 0u) { if (xb_ld(&bar[XB_TMO])) break; if (sp > XB_SPIN_CAP) { atomicAdd(&bar[XB_TMO], 1u); break; } }
    }
    nloc = mine > 0u ? mine : 1u; nx = cnt > 0u ? cnt : 1u;
}

__device__ __forceinline__ void xcd_barrier(const XcdBarrier& b) {
    asm volatile("s_waitcnt vmcnt(0)" ::: "memory");
    __syncthreads();
    if (threadIdx.x == 0) {
        unsigned* bar = b.bar;
        __builtin_amdgcn_s_waitcnt(0);
        unsigned nloc = b.st[0], nx = b.st[1];
        if (nloc == 0u) { xcd_barrier_complete(bar, b.x, nloc, nx); b.st[0] = nloc; b.st[1] = nx; }
        const unsigned old = xb_add(&bar[XB_XSUB(b.x)], 1u);
        const unsigned gen = old / nloc;
        if (old + 1u == (gen + 1u) * nloc) {
            __builtin_amdgcn_fence(__ATOMIC_RELEASE, "agent");
            asm volatile("s_waitcnt vmcnt(0)" ::: "memory");
            const unsigned og = xb_add(&bar[XB_TOP], 1u);
            const unsigned tg = og / nx;
            if (og + 1u == (tg + 1u) * nx) xb_add(&bar[XB_TOPGEN], 1u);
            else XB_SPIN(xb_ld(&bar[XB_TOPGEN]) == tg, bar);
            __builtin_amdgcn_fence(__ATOMIC_ACQUIRE, "agent");
            xb_add(&bar[XB_XGEN(b.x)], 1u);
            asm volatile("s_waitcnt vmcnt(0)" ::: "memory");
        } else {
            XB_SPIN(xb_ld(&bar[XB_XGEN(b.x)]) == gen, bar);
            __builtin_amdgcn_fence(__ATOMIC_ACQUIRE, "agent");
            asm volatile("s_waitcnt vmcnt(0)" ::: "memory");
        }
    }
    __syncthreads();
}

__device__ __forceinline__ void fill_rowscale(const float* __restrict__ ssq, int pm0, unsigned char* lds, int tid) {
    const int row = tid >> 1, h = tid & 1;
    const f32x4_t* sp = (const f32x4_t*)(ssq + ((size_t)pm0 * 256 + row) * 32 + h * 16);
    const f32x4_t a = sp[0], b = sp[1], c = sp[2], d = sp[3];
    float s = (((a.x + a.y) + (a.z + a.w)) + ((b.x + b.y) + (b.z + b.w))) + (((c.x + c.y) + (c.z + c.w)) + ((d.x + d.y) + (d.z + d.w)));
    s += swz_xor<1>(s);
    if (h == 0) ((float*)(lds + 131072 + 2048))[row] = __builtin_amdgcn_rsqf(s * (1.0f / 2048.0f) + 1e-6f);
    __syncthreads();
}

struct Args { const float* in[18]; float* out; unsigned char* ws; int ph_lo, ph_hi; };
constexpr int NPHASE = 2 + 3 * DEPTH;

__global__ void __launch_bounds__(512) fwd_megakernel(Args args) {
    extern __shared__ __attribute__((aligned(16))) unsigned char lds[];
    cg::grid_group grid = cg::this_grid();
    const int tid = threadIdx.x, lane = tid & 63, wave = __builtin_amdgcn_readfirstlane(tid >> 6);
    const int G = gridDim.x, bx = blockIdx.x;
    unsigned char* ws = args.ws;
    bf16* WinT = (bf16*)(ws + WS_WIN); bf16* WoutT = (bf16*)(ws + WS_WOUT); bf16* WmemT = (bf16*)(ws + WS_WMEM);
    bf16* xb = (bf16*)(ws + WS_XB); bf16* memb = (bf16*)(ws + WS_MEMB); bf16* mkv = (bf16*)(ws + WS_MKV);
    float* ssq = (float*)(ws + WS_SSQ); float* ssqm = (float*)(ws + WS_SSQM);
    bf16* proj = (bf16*)(ws + WS_PROJ); bf16* yb = (bf16*)(ws + WS_Y);
    const int lo = args.ph_lo, hi = args.ph_hi;
#define IN(k) (lo <= (k) && (k) < hi)
    volatile LAS unsigned* xb_st = (volatile LAS unsigned*)((LAS unsigned char*)lds + 131072 + 3584);
    if (threadIdx.x < 4) xb_st[threadIdx.x] = 0u;
    __syncthreads();
    XcdBarrier xbar; xbar.bar = (unsigned*)(ws + WS_BAR); xbar.x = 0; xbar.st = xb_st;
#define SEAM(k) do { if (IN(k) && IN((k) + 1)) { if ((k) == 0) { grid.sync(); xbar = xcd_barrier_post((unsigned*)(ws + WS_BAR), xb_st); } else xcd_barrier(xbar); } } while (0)

#ifndef NO_PRO
    if (IN(0)) {
        float* scr = (float*)lds + wave * (64 * 33);
        const int gw = bx * 8 + wave, NGW = G * 8;
        constexpr int I_IN = (DM / 64) * (INC / 32), I_OUT = (DM / 64) * (DM / 32), I_MEM = (DM / 64) * (1024 / 32);
        constexpr int NITEMS = DEPTH * (I_IN + I_OUT + I_MEM);
        for (int it = gw; it < NITEMS; it += NGW) {
            int r = it;
            if (r < DEPTH * I_IN) { const int l = r / I_IN; r -= l * I_IN;
                transpose_item(args.in[3] + (size_t)l * DM * INC, DM, INC, args.in[2] + l * DM, WinT + (size_t)l * INC * DM, scr, r, lane); continue; }
            r -= DEPTH * I_IN;
            if (r < DEPTH * I_OUT) { const int l = r / I_OUT; r -= l * I_OUT;
                transpose_item(args.in[17] + (size_t)l * DM * DM, DM, DM, nullptr, WoutT + (size_t)l * DM * DM, scr, r, lane); continue; }
            r -= DEPTH * I_OUT;
            { const int l = r / I_MEM; r -= l * I_MEM;
                transpose_item(args.in[14] + (size_t)l * DM * 1024, DM, 1024, args.in[13] + l * DM, WmemT + (size_t)l * 1024 * DM, scr, r, lane); }
        }
        for (int m = gw; m < MTOK + MMEM; m += NGW) {
            if (m < MTOK) row_to_bf16(args.in[0] + (size_t)m * DM, xb + (size_t)m * DM, ssq + (size_t)m * 32, lane);
            else { const int mm = m - MTOK; row_to_bf16(args.in[1] + (size_t)mm * DM, memb + (size_t)mm * DM, ssqm + (size_t)mm * 32, lane); }
        }
        if (bx == 0 && opaque_tid(wave) < 16) ((unsigned*)(ws + WS_CTR))[opaque_tid(wave)] = 0u;
        if (bx == 0) for (int i_ = opaque_tid(wave); i_ < XCD_BAR_WORDS; i_ += 512) ((unsigned*)(ws + WS_BAR))[i_] = 0u;
        __syncthreads();
    }
#endif
    SEAM(0);
#ifndef NO_G1
    if (IN(1)) {
        pg8::Gemm g{memb, WmemT, MMEM, MKVC, DM}; pg8::StaticOrder S; S.init(MMEM, MKVC, G, bx);
        pg8::Unit u0_; int pm0_ = -1; if (S.next(0, u0_)) { pm0_ = u0_.pm; fill_rowscale(ssqm, pm0_, lds, opaque_tid(wave)); }
        pg8::EpiProj E{mkv, MKVC, ssqm, nullptr, nullptr, 0, 0, 0, 0, 1.f, (const PG8_LAS float*)((PG8_LAS unsigned char*)lds + 131072 + 2048), pm0_};
        pg8::gemm_phase<pg8::EpiProj, pg8::StaticOrder, true, true>((PG8_LAS unsigned char*)lds, g, S, E, wave);
    }
#endif
#pragma unroll 1
    for (int l = 0; l < DEPTH; ++l) {
        const int pA = 2 + 3 * l, pB = pA + 1, pC = pA + 2;
        int bxl = bx; asm volatile("" : "+s"(bxl));
#ifndef NO_G2
        if (IN(pA)) {
            pg8::Gemm g{xb, WinT + (size_t)l * INC * DM, MTOK, INC, DM}; pg8::StaticOrder S; S.init(MTOK, INC, G, bxl);
            pg8::Unit u0_{0, 0}; (void)S.next(0, u0_); const int pm0_ = u0_.pm;
            fill_rowscale(ssq, pm0_, lds, opaque_tid(wave));
            pg8::EpiProj E{proj, INC, ssq, args.in[6] + l * 64, args.in[7] + l * 64, C_DQ / 256, C_DK / 256, C_DK / 256, C_DV / 256, QSCALE_D, (const PG8_LAS float*)((PG8_LAS unsigned char*)lds + 131072 + 2048), pm0_};
            pg8::gemm_phase<pg8::EpiProj, pg8::StaticOrder, true, true>((PG8_LAS unsigned char*)lds, g, S, E, wave);
        }
#endif
        SEAM(pA);
        if (IN(pB)) {
            att::DiffArgs DA{proj, yb, args.in[12] + l * 128, 0, 0, 0};
            { const int ln = opaque_tid(wave) & 63;
              const float mq = att::wave_max(fabsf(args.in[6][l * 64 + ln])), mk = att::wave_max(fabsf(args.in[7][l * 64 + ln]));
              const float s1 = att::wave_sum(args.in[8][l * 64 + ln] * args.in[9][l * 64 + ln]), s2 = att::wave_sum(args.in[10][l * 64 + ln] * args.in[11][l * 64 + ln]);
              const int cb = (l == 0) ? 0x3e4ccccd : (l == 1) ? 0x3eb60549 : (l == 2) ? 0x3ef1014c : 0x3f0e59d5;
              const float li = __int_as_float(cb);
              DA.nM2b = att::to_sgpr(__float_as_int(-(8.0f * mq * mk * LOG2E * 1.03f + 0.25f))); DA.lamb = att::to_sgpr(__float_as_int(expf(s1) - expf(s2) + li)); DA.laminitb = att::to_sgpr(cb); }
            att::MemArgs MA{proj, mkv, yb, args.in[15] + l * 128, args.in[16] + l * 128, l};
            unsigned* ctr = (unsigned*)(ws + WS_CTR) + l;
            att::ConvArgs CA{proj, yb, args.in[4] + l * 3 * 768, args.in[5] + l * 768};
            for (;;) { const int it = att::next_item(ctr, (char*)lds, opaque_tid(wave));
                if (it >= 768 + 256 + 256) break;
                if (it < 768) { const int r = it & 127; att::diff_unit(DA, r >> 6, 5 - (it >> 7), r & 63, (char*)lds, wave); }
                else if (it < 1024) { att::conv_items(CA, (long)(it - 768) * 512 + opaque_tid(wave), 256L * 512); __syncthreads(); }
                else att::mem_unit(MA, it - 1024, (char*)lds, wave); }
        }
        SEAM(pB);
#ifndef NO_G3
        if (IN(pC)) {
            pg8::Gemm g{yb, WoutT + (size_t)l * DM * DM, MTOK, DM, DM}; pg8::StaticOrder S; S.init(MTOK, DM, G, bxl);
            pg8::EpiOut E{args.out, xb, ssq, (l == DEPTH - 1) ? 1 : 0};
            pg8::gemm_phase<pg8::EpiOut, pg8::StaticOrder, true, true>((PG8_LAS unsigned char*)lds, g, S, E, wave);
        }
#endif
        if (l + 1 < DEPTH) SEAM(pC);
    }
#undef IN
#undef SEAM
}

extern "C" void kernel_launch(void* const* d_in, const int* in_sizes, int n_in, void* d_out, int out_size, void* d_ws, size_t ws_size, hipStream_t stream) {
    static int grid = 0;
    if (grid == 0) {
        if (n_in != 18 || in_sizes[0] != MTOK * DM || out_size != MTOK * DM || ws_size < WS_END) { fprintf(stderr, "kernel_launch: unexpected shapes (n_in %d, in0 %d, out %d, ws %zu)\n", n_in, n_in > 0 ? in_sizes[0] : -1, out_size, ws_size); grid = -1; return; }
        int dev = 0, cus = 0, per_cu = 0;
        if (hipGetDevice(&dev) != hipSuccess || hipDeviceGetAttribute(&cus, hipDeviceAttributeMultiprocessorCount, dev) != hipSuccess) { grid = -1; return; }
        if (hipFuncSetAttribute((const void*)fwd_megakernel, hipFuncAttributeMaxDynamicSharedMemorySize, LDS_BYTES) != hipSuccess) { fprintf(stderr, "kernel_launch: hipFuncSetAttribute failed\n"); grid = -1; return; }
        if (hipOccupancyMaxActiveBlocksPerMultiprocessor(&per_cu, (const void*)fwd_megakernel, 512, LDS_BYTES) != hipSuccess || per_cu < 1) { fprintf(stderr, "kernel_launch: occupancy query says %d blocks per CU\n", per_cu); per_cu = 1; }
        (void)hipGetLastError();
        grid = cus * 1;
    }
    if (grid < 0) return;
    Args a{};
    for (int i = 0; i < 18; ++i) a.in[i] = (const float*)d_in[i];
    a.out = (float*)d_out; a.ws = (unsigned char*)d_ws;
#if MK_ONE_LAUNCH
    a.ph_lo = 0; a.ph_hi = NPHASE;
    void* kargs[] = {&a};
    hipError_t e = hipLaunchCooperativeKernel((const void*)fwd_megakernel, dim3(grid), dim3(512), kargs, LDS_BYTES, stream);
    if (e != hipSuccess) fprintf(stderr, "kernel_launch: cooperative launch failed: %s (grid %d)\n", hipGetErrorString(e), grid);
#else
    for (int p = 0; p < NPHASE; ++p) { a.ph_lo = p; a.ph_hi = p + 1;
        hipLaunchKernelGGL(fwd_megakernel, dim3(grid), dim3(512), LDS_BYTES, stream, a);
        const hipError_t le = hipPeekAtLastError();
        if (le != hipSuccess) { fprintf(stderr, "kernel_launch: launch %d failed: %s\n", p, hipGetErrorName(le)); break; } }
#endif
}
```

```cpp
#include <hip/hip_runtime.h>
#include <hip/hip_cooperative_groups.h>
#include <cstdio>
#include <cstdint>
namespace cg = cooperative_groups;

#ifndef DIFF_ANTIPHASE
#define DIFF_ANTIPHASE 1
#endif
#ifndef MK_ONE_LAUNCH
#define MK_ONE_LAUNCH 1
#endif

constexpr int DM = 2048, BATCH = 2, SEQ = 8192, DEPTH = 4, NMEM = 256, MTOK = BATCH * SEQ, INC = 7168, MKVC = 4096, MMEM = BATCH * NMEM;
constexpr int C_AX = 0, C_AB = 768, C_AC = 1536, C_AG = 2304, C_DQ = 3072, C_DK = 3840, C_DV = 4608, C_DG = 5376, C_MQ = 6144, C_MG = 6656;
constexpr int Y_A = 0, Y_D = 768, Y_M = 1536;
constexpr float EPS = 1e-6f, LOG2E = 1.4426950408889634f;
constexpr float QSCALE_D = 0.125f * LOG2E;
constexpr float QSCALE_M = 0.08838834764831845f * LOG2E;
constexpr size_t MiB = 1u << 20;
constexpr size_t WS_WIN = 0, WS_WOUT = 112 * MiB, WS_WMEM = 144 * MiB, WS_XB = 160 * MiB, WS_MEMB = 224 * MiB, WS_MKV = 226 * MiB, WS_SSQ = 230 * MiB, WS_SSQM = 232 * MiB, WS_CTR = 233 * MiB, WS_BAR = 234 * MiB,
                 WS_PROJ = 240 * MiB, WS_Y = 464 * MiB, WS_END = 528 * MiB;
constexpr int LDS_BYTES = 131072 + 4096;
__device__ __forceinline__ int opaque_tid(int wv) { int lane_; asm volatile("v_mbcnt_lo_u32_b32 %0, -1, 0\n\tv_mbcnt_hi_u32_b32 %0, -1, %0" : "=v"(lane_)); return wv * 64 + lane_; }
template <int X> __device__ __forceinline__ float swz_xor(float v) { return __int_as_float(__builtin_amdgcn_ds_swizzle(__float_as_int(v), (X << 10) | 0x1f)); }
__device__ __forceinline__ float xsum32(float v) { auto rr = __builtin_amdgcn_permlane32_swap(__float_as_uint(v), __float_as_uint(v), false, false); return __uint_as_float(rr[0]) + __uint_as_float(rr[1]); }
__device__ __forceinline__ float xmax32(float v) { auto rr = __builtin_amdgcn_permlane32_swap(__float_as_uint(v), __float_as_uint(v), false, false); return fmaxf(__uint_as_float(rr[0]), __uint_as_float(rr[1])); }
namespace pg8 {
#define PG8_LAS __attribute__((address_space(3)))
typedef unsigned short bf16_t;
typedef short bf16x8 __attribute__((ext_vector_type(8)));
typedef float f32x4 __attribute__((ext_vector_type(4)));
typedef unsigned u32x4 __attribute__((ext_vector_type(4)));
constexpr int BM = 256, BK = 64, HALF = 128, HTB = HALF * BK * 2  , STAGE_BYTES = 8 * HTB, NXCD = 8, WGM = 8;

__host__ __device__ __forceinline__ int lds_byte(int r, int c) { const int st = (r >> 4) * 2 + (c >> 5), rr = r & 15, cc = c & 31, ob = rr * 64 + cc * 2; return st * 1024 + (ob ^ (((ob >> 9) & 1) << 5)); }
__host__ __device__ __forceinline__ void stage_rc(int b, int& R, int& C) { const int st = b / 1024, sb = b % 1024, swz = sb ^ (((sb >> 9) & 1) << 5); R = (st >> 1) * 16 + swz / 64; C = (st & 1) * 32 + (swz % 64) / 2; }
__host__ __device__ __forceinline__ int perm32(int rho) { const int n = rho >> 4, i = rho & 15; return 8 * (i >> 2) + 4 * n + (i & 3); }

struct Unit { int pm, pn; };
struct Gemm { const bf16_t* A; const bf16_t* Bt; int M, N, K; };

struct StaticOrder {
    int nM, nN, nwg, G, c;
    __host__ __device__ void init(int M, int N, int G_, int c_) { nM = M / BM; nN = N / BM; nwg = nM * nN; G = G_; c = c_; }
    __host__ __device__ bool next(int i, Unit& u) const {
        const long L = (long)i * G + c; if (L >= nwg) return false;
        int wgid = (int)L; { const int q = nwg / NXCD, r = nwg % NXCD, xcd = wgid % NXCD, off = wgid / NXCD; wgid = (xcd < r ? xcd * (q + 1) : r * (q + 1) + (xcd - r) * q) + off; }
        const int nig = WGM * nN, gid = wgid / nig, fm = gid * WGM, gsz = (nM - fm) < WGM ? (nM - fm) : WGM;
        u.pm = fm + ((wgid % nig) % gsz); u.pn = (wgid % nig) / gsz; return true;
    }
    __device__ __forceinline__ void a_ready(const Unit&) const {}
    __device__ __forceinline__ void done(const Unit&) const {}
};


__device__ __forceinline__ unsigned cvt_pk_bf16(float lo, float hi) { unsigned r; asm volatile("v_cvt_pk_bf16_f32 %0, %1, %2" : "=v"(r) : "v"(lo), "v"(hi)); return r; }

struct EpiProj {
    static constexpr bool PERM = true, AFTER_DRAIN = false;
    bf16_t* O; int ldc; const float* ssq; const float* gq; const float* gk; int qlo, qhi, klo, khi; float qscale;
    const PG8_LAS float* rs; int pm0;
    __device__ __forceinline__ void operator()(const f32x4 (&acc)[2][2][4][2], const Unit& u, int wr, int wc, int fr, int fq) const {
        const int row0 = u.pm * BM + wr * 64 + fr, colw = u.pn * BM + wc * 64 + 8 * fq;
        const int mode = (u.pn >= qlo && u.pn < qhi) ? 1 : ((u.pn >= klo && u.pn < khi) ? 2 : 0);
        float rv[2][4];
        if (u.pm == pm0) {
#pragma unroll
            for (int ai = 0; ai < 2; ++ai)
#pragma unroll
                for (int m = 0; m < 4; ++m) rv[ai][m] = rs[wr * 64 + fr + ai * HALF + m * 16];
        } else {
#pragma unroll
            for (int ai = 0; ai < 2; ++ai)
#pragma unroll
                for (int m = 0; m < 4; ++m) { const int row = row0 + ai * HALF + m * 16;
                    const f32x4* sp = (const f32x4*)(ssq + (size_t)row * 32 + 8 * fq); const f32x4 sa = sp[0], sb = sp[1];
                    float s = ((sa.x + sa.y) + (sa.z + sa.w)) + ((sb.x + sb.y) + (sb.z + sb.w)); s += swz_xor<16>(s); s = xsum32(s);
                    rv[ai][m] = __builtin_amdgcn_rsqf(s * (1.0f / 2048.0f) + 1e-6f); }
        }
        if (mode == 0) {
#pragma unroll
            for (int ai = 0; ai < 2; ++ai)
#pragma unroll
                for (int m = 0; m < 4; ++m) { const float r = rv[ai][m]; bf16_t* rowp = O + (size_t)(row0 + ai * HALF + m * 16) * ldc + colw;
#pragma unroll
                    for (int bj = 0; bj < 2; ++bj) { const f32x4 v0 = acc[ai][bj][m][0] * r, v1 = acc[ai][bj][m][1] * r;
                        u32x4 w; w.x = cvt_pk_bf16(v0[0], v0[1]); w.y = cvt_pk_bf16(v0[2], v0[3]); w.z = cvt_pk_bf16(v1[0], v1[1]); w.w = cvt_pk_bf16(v1[2], v1[3]);
                        *(u32x4*)(rowp + 32 * bj) = w; } }
            return; }
        f32x4 gv[2][2];
        { const float* g = (mode == 1) ? gq : gk; const float s = (mode == 1) ? qscale : 1.f;
#pragma unroll
            for (int bj = 0; bj < 2; ++bj)
#pragma unroll
                for (int n = 0; n < 2; ++n) gv[bj][n] = *(const f32x4*)(g + 32 * bj + 8 * fq + 4 * n) * s; }
#pragma unroll
        for (int ai = 0; ai < 2; ++ai)
#pragma unroll
            for (int m = 0; m < 4; ++m) {
                const int row = row0 + ai * HALF + m * 16;
                const float r = rv[ai][m];
                f32x4 v[2][2]; float ss = 0.f;
#pragma unroll
                for (int bj = 0; bj < 2; ++bj)
#pragma unroll
                    for (int n = 0; n < 2; ++n) { v[bj][n] = acc[ai][bj][m][n] * r; const f32x4 q = v[bj][n] * v[bj][n]; ss += (q.x + q.y) + (q.z + q.w); }
                ss += swz_xor<16>(ss); ss = xsum32(ss); const float rn = __builtin_amdgcn_rsqf(ss * (1.0f / 64.0f) + 1e-6f);
                bf16_t* rowp = O + (size_t)row * ldc + colw;
#pragma unroll
                for (int bj = 0; bj < 2; ++bj) { const f32x4 v0 = v[bj][0] * gv[bj][0] * rn, v1 = v[bj][1] * gv[bj][1] * rn;
                    u32x4 w; w.x = cvt_pk_bf16(v0[0], v0[1]); w.y = cvt_pk_bf16(v0[2], v0[3]); w.z = cvt_pk_bf16(v1[0], v1[1]); w.w = cvt_pk_bf16(v1[2], v1[3]);
                    *(u32x4*)(rowp + 32 * bj) = w; }
            }
    }
};

struct EpiOut {
    static constexpr bool PERM = true, AFTER_DRAIN = false;
    float* xout; bf16_t* xb; float* ssq; int last;
    __device__ __forceinline__ void operator()(const f32x4 (&acc)[2][2][4][2], const Unit& u, int wr, int wc, int fr, int fq) const {
        const int row0 = u.pm * BM + wr * 64 + fr, colw = u.pn * BM + wc * 64 + 8 * fq;
#pragma unroll
        for (int ai = 0; ai < 2; ++ai)
#pragma unroll
            for (int m = 0; m < 4; ++m) {
                const int row = row0 + ai * HALF + m * 16; float ss = 0.f;
#pragma unroll
                for (int bj = 0; bj < 2; ++bj) { const size_t off = (size_t)row * 2048 + colw + 32 * bj;
                    const u32x4 xw = *(const u32x4*)(xb + off);
                    f32x4 v0, v1;
                    v0.x = __uint_as_float(xw.x << 16); v0.y = __uint_as_float(xw.x & 0xffff0000u); v0.z = __uint_as_float(xw.y << 16); v0.w = __uint_as_float(xw.y & 0xffff0000u);
                    v1.x = __uint_as_float(xw.z << 16); v1.y = __uint_as_float(xw.z & 0xffff0000u); v1.z = __uint_as_float(xw.w << 16); v1.w = __uint_as_float(xw.w & 0xffff0000u);
                    v0 = v0 + acc[ai][bj][m][0]; v1 = v1 + acc[ai][bj][m][1];
                    if (last) { f32x4* op = (f32x4*)(xout + off); op[0] = v0; op[1] = v1; }
                    else { u32x4 w; w.x = cvt_pk_bf16(v0[0], v0[1]); w.y = cvt_pk_bf16(v0[2], v0[3]); w.z = cvt_pk_bf16(v1[0], v1[1]); w.w = cvt_pk_bf16(v1[2], v1[3]);
                        *(u32x4*)(xb + off) = w;
                        const f32x4 q0 = v0 * v0, q1 = v1 * v1; ss += ((q0.x + q0.y) + (q0.z + q0.w)) + ((q1.x + q1.y) + (q1.z + q1.w)); } }
                if (!last) { ss += swz_xor<16>(ss); ss = xsum32(ss);
                    if (fq == 0) ssq[(size_t)row * 32 + u.pn * 4 + wc] = ss; }
            }
    }
};

template <class Epi, class Sched, bool ALIGN_EPI = false, bool SP2 = false>
__device__ __forceinline__ void gemm_phase(PG8_LAS unsigned char* lds, const Gemm g, const Sched& S, const Epi& E, int wv) {
    const int tid = opaque_tid(wv), wid = __builtin_amdgcn_readfirstlane(tid >> 6), lane = tid & 63, wr = wid >> 2, wc = wid & 3, fr = lane & 15, fq = lane >> 4;
    const int K = g.K, nt = K / BK;
    unsigned voffA[2], voffB[2];
#pragma unroll
    for (int i = 0; i < 2; ++i) { int R, C; stage_rc(tid * 16 + i * 8192, R, C); const int Rb = Epi::PERM ? ((R & ~31) + perm32(R & 31)) : R;
        voffA[i] = (unsigned)(R * K + C) * 2u; voffB[i] = (unsigned)(Rb * K + C) * 2u; }
    const size_t kstep = (size_t)(BK * 2);
    const size_t hstep = (size_t)HALF * K * 2;
    const size_t tstep = 2 * hstep;
    const unsigned ldsw = (unsigned)wid * 1024u;
    const int aoff = lds_byte(wr * 64 + fr, fq * 8), boff = lds_byte(wc * 32 + fr, fq * 8);
#define PG8_SA(b, h) (((b) * 2 + (h)) * HTB)
#define PG8_SB(b, h) ((4 + (b) * 2 + (h)) * HTB)
#define PG8_STAGE(bufoff, gbase, voff) do { _Pragma("unroll") for (int _i = 0; _i < 2; ++_i) \
        __builtin_amdgcn_global_load_lds((const unsigned*)((const char*)(gbase) + (voff)[_i]), (PG8_LAS unsigned*)(lds + (bufoff) + ldsw + _i * 8192), 16, 0, 0); } while (0)
#define PG8_LDA(dst, b, h) do { _Pragma("unroll") for (int m = 0; m < 4; ++m) _Pragma("unroll") for (int k = 0; k < 2; ++k) dst[m][k] = *(const PG8_LAS bf16x8*)(lds + PG8_SA(b, h) + aoff + m * 2048 + k * 1024); } while (0)
#define PG8_LDB(dst, b, h) do { _Pragma("unroll") for (int n = 0; n < 2; ++n) _Pragma("unroll") for (int k = 0; k < 2; ++k) dst[n][k] = *(const PG8_LAS bf16x8*)(lds + PG8_SB(b, h) + boff + n * 2048 + k * 1024); } while (0)
#define PG8_MMA(ai, bj, At, Bt) do { __builtin_amdgcn_s_setprio(1); _Pragma("unroll") for (int m = 0; m < 4; ++m) _Pragma("unroll") for (int n = 0; n < 2; ++n) _Pragma("unroll") for (int k = 0; k < 2; ++k) \
        acc[ai][bj][m][n] = __builtin_amdgcn_mfma_f32_16x16x32_bf16(Bt[n][k], At[m][k], acc[ai][bj][m][n], 0, 0, 0); __builtin_amdgcn_s_setprio(0); } while (0)
#define PG8_WAIT_V(n) asm volatile("s_waitcnt vmcnt(" #n ")" ::: "memory")
#define PG8_WAIT_L(n) asm volatile("s_waitcnt lgkmcnt(" #n ")" ::: "memory")
#define PG8_BAR __builtin_amdgcn_s_barrier()
#define PG8_SCHED __builtin_amdgcn_sched_barrier(0)
    Unit cur, nxt; int ui = 0;
    if (!S.next(0, cur)) return;
    f32x4 acc[2][2][4][2];
#pragma unroll
    for (int a = 0; a < 2; ++a)
#pragma unroll
        for (int b = 0; b < 2; ++b)
#pragma unroll
            for (int m = 0; m < 4; ++m)
#pragma unroll
                for (int n = 0; n < 2; ++n) acc[a][b][m][n] = (f32x4){0.f, 0.f, 0.f, 0.f};
    bf16x8 At[4][2], B0[2][2], B1[2][2];
    const char* cA = (const char*)g.A + (size_t)cur.pm * tstep; const char* cB = (const char*)g.Bt + (size_t)cur.pn * tstep;
    S.a_ready(cur);
    if constexpr (SP2) {
        PG8_STAGE(PG8_SB(0, 0), cB, voffB); PG8_STAGE(PG8_SB(0, 1), cB + hstep, voffB); PG8_STAGE(PG8_SA(0, 0), cA, voffA); PG8_STAGE(PG8_SA(0, 1), cA + hstep, voffA);
        if (wr == 1) PG8_BAR;
        PG8_WAIT_V(2); PG8_BAR;
        PG8_STAGE(PG8_SB(1, 0), cB + kstep, voffB); PG8_STAGE(PG8_SA(1, 0), cA + kstep, voffA); PG8_STAGE(PG8_SB(1, 1), cB + hstep + kstep, voffB);
        PG8_WAIT_V(6); PG8_BAR;
    } else {
        PG8_STAGE(PG8_SB(0, 0), cB, voffB); PG8_STAGE(PG8_SA(0, 0), cA, voffA); PG8_STAGE(PG8_SB(0, 1), cB + hstep, voffB); PG8_STAGE(PG8_SA(0, 1), cA + hstep, voffA);
        if (wr == 1) PG8_BAR;
        PG8_WAIT_V(4); PG8_BAR;
        PG8_STAGE(PG8_SB(1, 0), cB + kstep, voffB); PG8_STAGE(PG8_SA(1, 0), cA + kstep, voffA); PG8_STAGE(PG8_SB(1, 1), cB + hstep + kstep, voffB);
        PG8_WAIT_V(6); PG8_BAR;
    }
    for (;;) {
        const bool has_next = S.next(ui + 1, nxt);
        const char* nA = has_next ? (const char*)g.A + (size_t)nxt.pm * tstep : cA; const char* nB = has_next ? (const char*)g.Bt + (size_t)nxt.pn * tstep : cB;
        for (int t = 0; t < nt; t += 2) {
            const bool last = (t == nt - 2);
            const char* a1 = cA + (size_t)(t + 1) * kstep;
            const char* a2 = last ? nA : cA + (size_t)(t + 2) * kstep; const char* b2 = last ? nB : cB + (size_t)(t + 2) * kstep;
            const char* a3 = a2 + kstep; const char* b3 = b2 + kstep;
            if (last && has_next) S.a_ready(nxt);
            if constexpr (SP2) {
            PG8_LDB(B0, 0, 0); PG8_LDB(B1, 0, 1); PG8_SCHED; PG8_LDA(At, 0, 0); PG8_STAGE(PG8_SA(1, 1), a1 + hstep, voffA);
            PG8_WAIT_V(8); PG8_WAIT_L(0); PG8_BAR; PG8_MMA(0, 0, At, B0); PG8_MMA(0, 1, At, B1); PG8_BAR; PG8_SCHED;
            PG8_LDA(At, 0, 1); PG8_STAGE(PG8_SB(0, 0), b2, voffB); PG8_STAGE(PG8_SB(0, 1), b2 + hstep, voffB); PG8_STAGE(PG8_SA(0, 0), a2, voffA);
            PG8_WAIT_V(8); PG8_WAIT_L(0); PG8_BAR; PG8_MMA(1, 0, At, B0); PG8_MMA(1, 1, At, B1); PG8_BAR; PG8_SCHED;
            PG8_LDB(B0, 1, 0); PG8_LDB(B1, 1, 1); PG8_SCHED; PG8_LDA(At, 1, 0); PG8_STAGE(PG8_SA(0, 1), a2 + hstep, voffA);
            PG8_WAIT_V(8); PG8_WAIT_L(0); PG8_BAR; PG8_MMA(0, 0, At, B0); PG8_MMA(0, 1, At, B1); PG8_BAR; PG8_SCHED;
            PG8_LDA(At, 1, 1); PG8_STAGE(PG8_SB(1, 0), b3, voffB); PG8_STAGE(PG8_SB(1, 1), b3 + hstep, voffB); PG8_STAGE(PG8_SA(1, 0), a3, voffA);
            PG8_WAIT_V(8); PG8_WAIT_L(0); PG8_BAR; PG8_MMA(1, 0, At, B0); PG8_MMA(1, 1, At, B1); PG8_BAR; PG8_SCHED;
            } else {
            PG8_LDB(B0, 0, 0); PG8_SCHED; PG8_LDA(At, 0, 0); PG8_STAGE(PG8_SA(1, 1), a1 + hstep, voffA);
            PG8_WAIT_L(8); PG8_BAR; PG8_WAIT_L(0); PG8_MMA(0, 0, At, B0); PG8_BAR; PG8_SCHED;
            PG8_LDB(B1, 0, 1); PG8_STAGE(PG8_SB(0, 0), b2, voffB);
            PG8_BAR; PG8_WAIT_L(0); PG8_MMA(0, 1, At, B1); PG8_BAR;
            PG8_LDA(At, 0, 1); PG8_STAGE(PG8_SA(0, 0), a2, voffA);
            PG8_BAR; PG8_WAIT_L(0); PG8_MMA(1, 0, At, B0); PG8_BAR; PG8_SCHED;
            PG8_STAGE(PG8_SB(0, 1), b2 + hstep, voffB);
            PG8_WAIT_V(6); PG8_BAR; PG8_MMA(1, 1, At, B1); PG8_BAR;
            PG8_LDB(B0, 1, 0); PG8_SCHED; PG8_LDA(At, 1, 0); PG8_STAGE(PG8_SA(0, 1), a2 + hstep, voffA);
            PG8_WAIT_L(8); PG8_BAR; PG8_WAIT_L(0); PG8_MMA(0, 0, At, B0); PG8_BAR; PG8_SCHED;
            PG8_LDB(B1, 1, 1); PG8_STAGE(PG8_SB(1, 0), b3, voffB);
            PG8_BAR; PG8_WAIT_L(0); PG8_MMA(0, 1, At, B1); PG8_BAR;
            PG8_LDA(At, 1, 1); PG8_STAGE(PG8_SA(1, 0), a3, voffA);
            PG8_BAR; PG8_WAIT_L(0); PG8_MMA(1, 0, At, B0); PG8_BAR; PG8_SCHED;
            PG8_STAGE(PG8_SB(1, 1), b3 + hstep, voffB);
            PG8_WAIT_V(6); PG8_BAR; PG8_MMA(1, 1, At, B1); PG8_BAR;
            }
        }
        if constexpr (ALIGN_EPI) { if (wr == 0) PG8_BAR; }
        if constexpr (!Epi::AFTER_DRAIN) { E(acc, cur, wr, wc, fr, fq); S.done(cur); }
        if (!has_next) break;
#pragma unroll
        for (int a = 0; a < 2; ++a)
#pragma unroll
            for (int b = 0; b < 2; ++b)
#pragma unroll
                for (int m = 0; m < 4; ++m)
#pragma unroll
                    for (int n = 0; n < 2; ++n) acc[a][b][m][n] = (f32x4){0.f, 0.f, 0.f, 0.f};
        cur = nxt; cA = nA; cB = nB; ++ui;
        if constexpr (ALIGN_EPI) { if (wr == 1) PG8_BAR; }
    }
    PG8_WAIT_V(0);
    if constexpr (!ALIGN_EPI) { if (wr == 0) PG8_BAR; }
    PG8_BAR;
    if constexpr (Epi::AFTER_DRAIN) { E.fused(acc, cur, wr, wc, fr, fq, lds, wid, lane); S.done(cur); }
#undef PG8_SA
#undef PG8_SB
#undef PG8_STAGE
#undef PG8_LDA
#undef PG8_LDB
#undef PG8_MMA
#undef PG8_WAIT_V
#undef PG8_WAIT_L
#undef PG8_BAR
#undef PG8_SCHED
}
}

namespace att {
using bf16 = unsigned short;
using bf16x8 = __attribute__((ext_vector_type(8))) short;
using s16x4  = __attribute__((ext_vector_type(4))) short;
using f32x16 = __attribute__((ext_vector_type(16))) float;
using f32x4  = __attribute__((ext_vector_type(4))) float;
using u32x4  = __attribute__((ext_vector_type(4))) unsigned;
constexpr int KVBLK = 64;
constexpr int SHM_V = 64 * 128 * 2, SHM_K = 64 * 128 * 2;
#define KSWZ(row, colB) ((row) * 256 + ((colB) ^ (((row) & 15) << 4)))
#define SBAR() __builtin_amdgcn_sched_barrier(0)
__device__ __forceinline__ int crow(int r, int hi) { return (r & 3) + 8 * (r >> 2) + 4 * hi; }
typedef float f32x2_t __attribute__((ext_vector_type(2))); typedef __bf16 bf16x2_t __attribute__((ext_vector_type(2)));
__device__ __forceinline__ unsigned cvtpk(float lo, float hi) { f32x2_t v = {lo, hi}; bf16x2_t b = __builtin_convertvector(v, bf16x2_t); return __builtin_bit_cast(unsigned, b); }
__device__ __forceinline__ float bf2f(unsigned short h) { return __uint_as_float(((unsigned)h) << 16); }
__device__ __forceinline__ float wave_sum(float v) { v += swz_xor<1>(v); v += swz_xor<2>(v); v += swz_xor<4>(v); v += swz_xor<8>(v); v += swz_xor<16>(v); return xsum32(v); }
__device__ __forceinline__ float wave_max(float v) { v = fmaxf(v, swz_xor<1>(v)); v = fmaxf(v, swz_xor<2>(v)); v = fmaxf(v, swz_xor<4>(v)); v = fmaxf(v, swz_xor<8>(v)); v = fmaxf(v, swz_xor<16>(v)); return xmax32(v); }
__device__ __forceinline__ float uni(float x) { return __uint_as_float(__builtin_amdgcn_readfirstlane(__float_as_uint(x))); }
__device__ __forceinline__ int to_sgpr(int v) { asm volatile("" : "+v"(v)); return __builtin_amdgcn_readfirstlane(v); }
__device__ __forceinline__ float silu(float x) { return x / (1.0f + __expf(-x)); }

__device__ __forceinline__ int v_st(int k, int c) { const int kk = (k & ~0xC) | ((k & 4) << 1) | ((k & 8) >> 1); return ((kk >> 3) * 4 + (c >> 5)) * 512 + ((kk & 7) * 32 + (c & 31)) * 2; }
__device__ __forceinline__ int v_rd_base(int lane) { return ((lane & 3) << 3) | (((lane >> 2) & 3) << 6) | (((lane >> 4) & 1) << 5) | (((lane >> 5) & 1) << 8); }
constexpr int v_rd_off(int d0, int ks, int half) { return d0 * 512 + ks * 4096 + half * 2048; }
template <int OFF> __device__ __forceinline__ s16x4 tr_read(int vb) {
    s16x4 r; asm volatile("ds_read_b64_tr_b16 %0, %1 offset:%2" : "=&v"(r) : "v"(vb), "i"(OFF) : "memory"); return r;
}
template <int D0> __device__ __forceinline__ void pv_one(f32x16& od, int vb, bf16x8 pa0, bf16x8 pa1, bf16x8 pa2, bf16x8 pa3) {
    const s16x4 l0 = tr_read<v_rd_off(D0, 0, 0)>(vb), h0 = tr_read<v_rd_off(D0, 0, 1)>(vb), l1 = tr_read<v_rd_off(D0, 1, 0)>(vb), h1 = tr_read<v_rd_off(D0, 1, 1)>(vb);
    const s16x4 l2 = tr_read<v_rd_off(D0, 2, 0)>(vb), h2 = tr_read<v_rd_off(D0, 2, 1)>(vb), l3 = tr_read<v_rd_off(D0, 3, 0)>(vb), h3 = tr_read<v_rd_off(D0, 3, 1)>(vb);
    asm volatile("s_waitcnt lgkmcnt(0)" ::: "memory"); SBAR();
#define PK(L, H) (bf16x8){L[0], L[1], L[2], L[3], H[0], H[1], H[2], H[3]}
    od = __builtin_amdgcn_mfma_f32_32x32x16_bf16(pa0, PK(l0, h0), od, 0, 0, 0);
    od = __builtin_amdgcn_mfma_f32_32x32x16_bf16(pa1, PK(l1, h1), od, 0, 0, 0);
    od = __builtin_amdgcn_mfma_f32_32x32x16_bf16(pa2, PK(l2, h2), od, 0, 0, 0);
    od = __builtin_amdgcn_mfma_f32_32x32x16_bf16(pa3, PK(l3, h3), od, 0, 0, 0);
#undef PK
}
template <int KS> __device__ __forceinline__ void pv_ks(f32x16* o, int vb, bf16x8 pa) {
    const s16x4 l0 = tr_read<v_rd_off(0, KS, 0)>(vb), h0 = tr_read<v_rd_off(0, KS, 1)>(vb), l1 = tr_read<v_rd_off(1, KS, 0)>(vb), h1 = tr_read<v_rd_off(1, KS, 1)>(vb);
    const s16x4 l2 = tr_read<v_rd_off(2, KS, 0)>(vb), h2 = tr_read<v_rd_off(2, KS, 1)>(vb), l3 = tr_read<v_rd_off(3, KS, 0)>(vb), h3 = tr_read<v_rd_off(3, KS, 1)>(vb);
#define PK(L, H) (bf16x8){L[0], L[1], L[2], L[3], H[0], H[1], H[2], H[3]}
    asm volatile("s_waitcnt lgkmcnt(6)" ::: "memory"); SBAR();
    o[0] = __builtin_amdgcn_mfma_f32_32x32x16_bf16(pa, PK(l0, h0), o[0], 0, 0, 0);
    asm volatile("s_waitcnt lgkmcnt(4)" ::: "memory"); SBAR();
    o[1] = __builtin_amdgcn_mfma_f32_32x32x16_bf16(pa, PK(l1, h1), o[1], 0, 0, 0);
    asm volatile("s_waitcnt lgkmcnt(2)" ::: "memory"); SBAR();
    o[2] = __builtin_amdgcn_mfma_f32_32x32x16_bf16(pa, PK(l2, h2), o[2], 0, 0, 0);
    asm volatile("s_waitcnt lgkmcnt(0)" ::: "memory"); SBAR();
    o[3] = __builtin_amdgcn_mfma_f32_32x32x16_bf16(pa, PK(l3, h3), o[3], 0, 0, 0);
#undef PK
}
__device__ __forceinline__ void pv_d0(f32x16* o, int vb, bf16x8 pa0, bf16x8 pa1, bf16x8 pa2, bf16x8 pa3) {
    __builtin_amdgcn_s_setprio(1);
    pv_ks<0>(o, vb, pa0); pv_ks<1>(o, vb, pa1); pv_ks<2>(o, vb, pa2); pv_ks<3>(o, vb, pa3);
    __builtin_amdgcn_s_setprio(0);
}
__device__ __forceinline__ void exp_half(f32x16& p) {
#pragma unroll
    for (int r = 0; r < 16; ++r) p[r] = __builtin_amdgcn_exp2f(p[r]);
}
__device__ __forceinline__ void pack_p(const f32x16& p0, const f32x16& p1, float& l_reg, bf16x8& pa0, bf16x8& pa1, bf16x8& pa2, bf16x8& pa3) {
    float ps = 0;
#pragma unroll
    for (int r = 0; r < 16; ++r) ps += p0[r];
#pragma unroll
    for (int r = 0; r < 16; ++r) ps += p1[r];
    l_reg += ps;
#define PK4(P, BASE, OUT) do { u32x4 w = {cvtpk(P[BASE + 0], P[BASE + 1]), cvtpk(P[BASE + 2], P[BASE + 3]), cvtpk(P[BASE + 4], P[BASE + 5]), cvtpk(P[BASE + 6], P[BASE + 7])}; \
    OUT = *reinterpret_cast<bf16x8*>(&w); } while (0)
    PK4(p0, 0, pa0); PK4(p0, 8, pa1); PK4(p1, 0, pa2); PK4(p1, 8, pa3);
#undef PK4
}
template <int ND0> __device__ __forceinline__ void qkt(f32x16& p0, f32x16& p1, const char* Ks, const bf16x8* qr, int r32, int hi, int colB0) {
#pragma unroll
    for (int d0 = 0; d0 < ND0; ++d0) { const int cb = colB0 + (d0 * 16 + hi * 8) * 2;
        const bf16x8 b0 = *reinterpret_cast<const bf16x8*>(Ks + KSWZ(r32, cb));
        const bf16x8 b1 = *reinterpret_cast<const bf16x8*>(Ks + KSWZ(32 + r32, cb));
        p0 = __builtin_amdgcn_mfma_f32_32x32x16_bf16(b0, qr[d0], p0, 0, 0, 0);
        p1 = __builtin_amdgcn_mfma_f32_32x32x16_bf16(b1, qr[d0], p1, 0, 0, 0); }
}
__device__ __forceinline__ void bias_init(f32x16& p0, f32x16& p1, float base, float nslope2, float nM2, int rel  ) {
    if (rel <= -63 || rel >= 31) {
        const float sg = (rel < 0) ? -nslope2 : nslope2, lbv = fmaf(-sg, base, nM2);
#pragma unroll
        for (int r = 0; r < 16; ++r) { p0[r] = fmaf((float)((r & 3) + 8 * (r >> 2)), sg, lbv); p1[r] = fmaf((float)((r & 3) + 8 * (r >> 2) + 32), sg, lbv); }
    } else {
#pragma unroll
        for (int r = 0; r < 16; ++r) { const float d = base - (float)((r & 3) + 8 * (r >> 2));
            p0[r] = fmaf(fabsf(d), nslope2, nM2); p1[r] = fmaf(fabsf(d - 32.f), nslope2, nM2); }
    }
}

struct DiffArgs { const bf16* proj; bf16* y; const float* ghead; int nM2b, lamb, laminitb; };

__device__ __forceinline__ void diff_unit(const DiffArgs& A, int b, int h, int qb, char* lds, int wv) {
    const int tid = opaque_tid(wv), wid = __builtin_amdgcn_readfirstlane(tid >> 6), lane = tid & 63, r32 = lane & 31, hi = lane >> 5, c = wid >> 2, wq = wid & 3;
    const char* Pb = (const char*)A.proj + ((size_t)b * SEQ * INC + h * 128) * 2;
    char* V_lds = lds; char* K_lds = lds + 4 * SHM_V;
    float* wsl = (float*)(lds + 131072) + wid * 64;
    int t_lo, nt; float nM2, lam, lam_init;
    { int a_ = A.nM2b, b_ = A.lamb, c_ = A.laminitb;
      asm volatile("" : "+s"(a_), "+s"(b_), "+s"(c_)); nM2 = __int_as_float(a_); lam = __int_as_float(b_); lam_init = __int_as_float(c_); }
    const float slope = exp2f(-8.0f * (float)(h + 1) / 6.0f);
    const float nslope2 = uni(-slope * LOG2E);
    { const float Df = (151.0f + 2.0f * (-nM2)) / (-nslope2); const int Dk = Df > 20000.f ? 20000 : (int)Df + 1; const int i0 = qb * 128;
      int lo_ = i0 - Dk + 1; lo_ = lo_ > 0 ? (lo_ >> 6) : 0; int hi_ = (i0 + 126 + Dk) >> 6; hi_ = hi_ > SEQ / KVBLK - 1 ? SEQ / KVBLK - 1 : hi_;
      if (((hi_ - lo_ + 1) & 1) != 0) { if (lo_ > 0) --lo_; else ++hi_; }
      t_lo = __builtin_amdgcn_readfirstlane(lo_); nt = __builtin_amdgcn_readfirstlane(hi_ - lo_ + 1); }
    const int ipos = qb * 128 + wq * 32 + r32;
    float l_reg = 0; f32x16 o[4] = {}; bf16x8 qr[4];
    { const char* Qw = Pb + (size_t)(qb * 128 + wq * 32) * (INC * 2) + (C_DQ + c * 64) * 2; const unsigned qoff = (unsigned)((r32 * INC + hi * 8) * 2);
#pragma unroll
      for (int d0 = 0; d0 < 4; ++d0) qr[d0] = *reinterpret_cast<const bf16x8*>(Qw + qoff + d0 * 32); }
    const int colB0 = c * 128;
    const int krow = wid * 4 + (lane >> 4), kcc = (lane & 15) ^ (krow & 15);
    const unsigned koff = (unsigned)((krow * INC + kcc * 8) * 2);
    const int vkey = (wid >> 2) * 16 + (((wid >> 1) & 1) << 3) + (((lane >> 4) & 1) << 2) + ((lane >> 2) & 3)  , vcol = ((wid & 1) * 2 + (lane >> 5)) * 32 + (lane & 3) * 8;
    const unsigned voff = (unsigned)((vkey * INC + vcol) * 2 + (C_DV - C_DK) * 2);
    const int vb0 = (int)(uintptr_t)V_lds + v_rd_base(lane);
    const char* Pk = Pb + (size_t)(t_lo * KVBLK) * (INC * 2) + C_DK * 2; int iposk = ipos - t_lo * KVBLK - 4 * hi; asm volatile("" : "+v"(iposk));     const int relw = t_lo * KVBLK - (qb * 128 + wq * 32);
    typedef __attribute__((address_space(3))) unsigned lds_u32;
    __attribute__((address_space(3))) unsigned char* ldsA = (__attribute__((address_space(3))) unsigned char*)lds + wid * 1024;
#define GLDS(gp, lp) __builtin_amdgcn_global_load_lds((const unsigned*)(gp), (lds_u32*)(lp), 16, 0, 0)
#define STAGE(t) do { const char* kt_ = Pk + (size_t)((t) * KVBLK) * (INC * 2); const int so_ = ((t) & 3) * SHM_K; \
    GLDS(kt_ + koff, ldsA + 4 * SHM_V + so_); GLDS(kt_ + 32 * INC * 2 + koff, ldsA + 4 * SHM_V + so_ + 8192); \
    GLDS(kt_ + voff, ldsA + so_); GLDS(kt_ + 32 * INC * 2 + voff, ldsA + so_ + 8192); } while (0)
#define SLOT(t) (((t) & 3) * SHM_K)
#define ENDI() do { asm volatile("s_waitcnt vmcnt(0)" ::: "memory"); __syncthreads(); } while (0)
#define BIAS(P0, P1, t) bias_init(P0, P1, (float)(iposk - (t) * KVBLK), nslope2, nM2, relw + (t) * KVBLK)
    f32x16 pA0, pA1, pB0, pB1; bf16x8 pa0, pa1, pa2, pa3; const int NT = nt;
    STAGE(0); ENDI();
    STAGE(1);
    BIAS(pA0, pA1, 0); qkt<4>(pA0, pA1, K_lds, qr, r32, hi, colB0);
#if DIFF_ANTIPHASE
    if (c == 0) {
#endif
        const int lp_ = opaque_tid(wv) & 63, r32p = lp_ & 31, hip = lp_ >> 5;
        exp_half(pA0);
        ENDI();
#pragma unroll 1
        for (int j = 1; j + 1 < NT; j += 2) {
            STAGE(j + 1);
            SBAR(); BIAS(pB0, pB1, j); qkt<4>(pB0, pB1, K_lds + SLOT(j), qr, r32p, hip, colB0);
            exp_half(pA1); pack_p(pA0, pA1, l_reg, pa0, pa1, pa2, pa3); SBAR();
            pv_d0(o, vb0 + SLOT(j - 1), pa0, pa1, pa2, pa3); exp_half(pB0);
            ENDI();
            STAGE(j + 2);
            SBAR(); BIAS(pA0, pA1, j + 1); qkt<4>(pA0, pA1, K_lds + SLOT(j + 1), qr, r32p, hip, colB0);
            exp_half(pB1); pack_p(pB0, pB1, l_reg, pa0, pa1, pa2, pa3); SBAR();
            pv_d0(o, vb0 + SLOT(j), pa0, pa1, pa2, pa3); exp_half(pA0);
            ENDI();
        }
        { const int lt_ = opaque_tid(wv) & 63;
          SBAR(); BIAS(pB0, pB1, NT - 1); qkt<4>(pB0, pB1, K_lds + SLOT(NT - 1), qr, lt_ & 31, lt_ >> 5, colB0); }
        exp_half(pA1); pack_p(pA0, pA1, l_reg, pa0, pa1, pa2, pa3); SBAR();
        pv_d0(o, vb0 + SLOT(NT - 2), pa0, pa1, pa2, pa3); exp_half(pB0);
        exp_half(pB1); pack_p(pB0, pB1, l_reg, pa0, pa1, pa2, pa3); SBAR();
        pv_d0(o, vb0 + SLOT(NT - 1), pa0, pa1, pa2, pa3);
#if DIFF_ANTIPHASE
    } else {
        const int lp_ = opaque_tid(wv) & 63, r32p = lp_ & 31, hip = lp_ >> 5;
        pa0 = bf16x8{}; pa1 = bf16x8{}; pa2 = bf16x8{}; pa3 = bf16x8{};
        ENDI();
#pragma unroll 1
        for (int j = 1; j + 1 < NT; j += 2) {
            STAGE(j + 1);
            SBAR(); pv_d0(o, vb0 + (j > 1 ? SLOT(j - 2) : 0), pa0, pa1, pa2, pa3);
            exp_half(pA0); SBAR();
            BIAS(pB0, pB1, j); qkt<4>(pB0, pB1, K_lds + SLOT(j), qr, r32p, hip, colB0);
            exp_half(pA1); pack_p(pA0, pA1, l_reg, pa0, pa1, pa2, pa3); SBAR();
            ENDI();
            STAGE(j + 2);
            SBAR(); pv_d0(o, vb0 + SLOT(j - 1), pa0, pa1, pa2, pa3);
            exp_half(pB0); SBAR();
            BIAS(pA0, pA1, j + 1); qkt<4>(pA0, pA1, K_lds + SLOT(j + 1), qr, r32p, hip, colB0);
            exp_half(pB1); pack_p(pB0, pB1, l_reg, pa0, pa1, pa2, pa3); SBAR();
            ENDI();
        }
        SBAR(); pv_d0(o, vb0 + SLOT(NT - 3), pa0, pa1, pa2, pa3);
        exp_half(pA0); SBAR();
        { const int lt_ = opaque_tid(wv) & 63;
          BIAS(pB0, pB1, NT - 1); qkt<4>(pB0, pB1, K_lds + SLOT(NT - 1), qr, lt_ & 31, lt_ >> 5, colB0); }
        exp_half(pA1); pack_p(pA0, pA1, l_reg, pa0, pa1, pa2, pa3); SBAR();
        pv_d0(o, vb0 + SLOT(NT - 2), pa0, pa1, pa2, pa3);
        exp_half(pB0); exp_half(pB1); pack_p(pB0, pB1, l_reg, pa0, pa1, pa2, pa3); SBAR();
        pv_d0(o, vb0 + SLOT(NT - 1), pa0, pa1, pa2, pa3);
    }
#endif
#undef GLDS
#undef STAGE
#undef SLOT
#undef ENDI
#undef BIAS
    { auto rr = __builtin_amdgcn_permlane32_swap(__float_as_uint(l_reg), __float_as_uint(l_reg), false, false);
      l_reg = __uint_as_float(rr[0]) + __uint_as_float(rr[1]); }
    const int tid_e = opaque_tid(wv), lane_e = tid_e & 63;
#define tid tid_e
#define r32 (lane_e & 31)
#define hi (lane_e >> 5)
    if (hi == 0) wsl[r32] = l_reg;
    asm volatile("s_waitcnt lgkmcnt(0)" ::: "memory");
    float rli[16];
#pragma unroll
    for (int r = 0; r < 16; ++r) rli[r] = (c ? lam : 1.0f) / wsl[crow(r, hi)];
    __syncthreads();
    float* OS = (float*)lds;
    if (c == 1) {
#pragma unroll
        for (int r = 0; r < 16; ++r) { float* orow = OS + (wq * 32 + crow(r, hi)) * 132 + r32;
#pragma unroll
            for (int d0 = 0; d0 < 4; ++d0) orow[d0 * 32] = o[d0][r] * rli[r]; }
    }
    __syncthreads();
    if (c == 0) {
#pragma unroll
        for (int r = 0; r < 16; ++r) { float* orow = OS + (wq * 32 + crow(r, hi)) * 132 + r32;
#pragma unroll
            for (int d0 = 0; d0 < 4; ++d0) orow[d0 * 32] = o[d0][r] * rli[r] - orow[d0 * 32]; }
    }
    __syncthreads();
    { const int row = tid >> 2, cq = tid & 3; const float* src = OS + row * 132 + cq * 32;
      f32x4 v[8]; float ss = 0.f;
#pragma unroll
      for (int i = 0; i < 8; ++i) { v[i] = *(const f32x4*)(src + 4 * i); const f32x4 q = v[i] * v[i]; ss += (q.x + q.y) + (q.z + q.w); }
      ss += swz_xor<1>(ss); ss += swz_xor<2>(ss);
      const float rn = (1.0f - lam_init) / sqrtf(ss * (1.0f / 128.0f) + EPS);
      const bf16* gp = (const bf16*)(Pb + (size_t)(qb * 128) * (INC * 2) + C_DG * 2 + (unsigned)((row * INC + cq * 32) * 2));
      bf16* yp = (bf16*)((char*)A.y + ((size_t)(b * SEQ + qb * 128) * DM + Y_D + h * 128) * 2 + (unsigned)((row * DM + cq * 32) * 2)); const float* gh = A.ghead + cq * 32;
#pragma unroll
      for (int i = 0; i < 4; ++i) { const bf16x8 g8 = *reinterpret_cast<const bf16x8*>(gp + 8 * i); const f32x4 h0 = *(const f32x4*)(gh + 8 * i), h1 = *(const f32x4*)(gh + 8 * i + 4);
          const f32x4 a = v[2 * i] * h0 * rn, bq = v[2 * i + 1] * h1 * rn;
          u32x4 w; w.x = cvtpk(a.x * silu(bf2f(g8[0])), a.y * silu(bf2f(g8[1]))); w.y = cvtpk(a.z * silu(bf2f(g8[2])), a.w * silu(bf2f(g8[3])));
          w.z = cvtpk(bq.x * silu(bf2f(g8[4])), bq.y * silu(bf2f(g8[5]))); w.w = cvtpk(bq.z * silu(bf2f(g8[6])), bq.w * silu(bf2f(g8[7])));
          *(u32x4*)(yp + 8 * i) = w; } }
    __syncthreads();
#undef tid
#undef r32
#undef hi
}

__device__ __forceinline__ int next_item(unsigned* ctr, char* lds, int tid) {
    int* slot = (int*)(lds + 131072 + 3072);
    if (tid == 0) *slot = (int)atomicAdd(ctr, 1u);
    __syncthreads();
    return __builtin_amdgcn_readfirstlane(*slot);
}

struct MemArgs { const bf16* proj; const bf16* mkv; bf16* y; const float* gmq; const float* gmk; int layer; };
__device__ __forceinline__ void mem_unit(const MemArgs& A, int unit, char* lds, int wv) {
    const int tid = opaque_tid(wv), wid = __builtin_amdgcn_readfirstlane(tid >> 6), lane = tid & 63, r32 = lane & 31, hi = lane >> 5;
    const int b = unit / (4 * 32), hm = (unit / 32) % 4, qb = unit % 32;
    const bf16* Kh = A.mkv + (size_t)b * NMEM * MKVC + A.layer * 1024 + hm * 128;
    const bf16* Vh = Kh + 512;
    char* V_lds = lds; char* K_lds = lds + 4 * SHM_V;
    float* wsl = (float*)(lds + 131072) + wid * 64;
    float nM2;
    { const float a = wave_max(fmaxf(fabsf(A.gmq[lane]), fabsf(A.gmq[lane + 64]))), bb = wave_max(fmaxf(fabsf(A.gmk[lane]), fabsf(A.gmk[lane + 64])));
      nM2 = -(11.3137085f * a * bb * LOG2E * 1.03f + 0.25f); }
    { const int sr = tid >> 4, sc = (tid & 15) * 8, kc = sc * 2;
      const f32x4 g0 = *(const f32x4*)(A.gmk + sc), g1 = *(const f32x4*)(A.gmk + sc + 4);
#pragma unroll
      for (int t = 0; t < 4; ++t)
#pragma unroll
        for (int hh = 0; hh < 2; ++hh) { const int key = t * 64 + hh * 32 + sr;
          const bf16x8 v8 = *reinterpret_cast<const bf16x8*>(&Vh[(size_t)key * MKVC + sc]); const bf16x8 k8 = *reinterpret_cast<const bf16x8*>(&Kh[(size_t)key * MKVC + sc]);
          float f[8]; float ss = 0.f;
#pragma unroll
          for (int i = 0; i < 8; ++i) { f[i] = bf2f((unsigned short)k8[i]); ss += f[i] * f[i]; }
          ss += swz_xor<1>(ss); ss += swz_xor<2>(ss); ss += swz_xor<4>(ss); ss += swz_xor<8>(ss);
          const float rn = 1.0f / sqrtf(ss * (1.0f / 128.0f) + EPS);
          u32x4 w; w.x = cvtpk(f[0] * rn * g0.x, f[1] * rn * g0.y); w.y = cvtpk(f[2] * rn * g0.z, f[3] * rn * g0.w); w.z = cvtpk(f[4] * rn * g1.x, f[5] * rn * g1.y); w.w = cvtpk(f[6] * rn * g1.z, f[7] * rn * g1.w);
          *(u32x4*)(K_lds + t * SHM_K + KSWZ(hh * 32 + sr, kc)) = w;
          { const int ks_ = hh * 32 + sr, kp_ = (ks_ & ~0xC) | ((ks_ & 4) << 1) | ((ks_ & 8) >> 1);
            *(bf16x8*)(V_lds + t * SHM_V + v_st(kp_, sc)) = v8; } } }
    bf16x8 qr[8];
    const size_t grow0 = (size_t)b * SEQ + qb * 256 + wid * 32;
    { const bf16* Qw = A.proj + (grow0 + r32) * INC + C_MQ + hm * 128 + hi * 8;
      bf16x8 raw[8]; float ss = 0.f;
#pragma unroll
      for (int d0 = 0; d0 < 8; ++d0) { raw[d0] = *reinterpret_cast<const bf16x8*>(Qw + d0 * 16);
#pragma unroll
          for (int i = 0; i < 8; ++i) { const float f = bf2f((unsigned short)raw[d0][i]); ss += f * f; } }
      { auto rr = __builtin_amdgcn_permlane32_swap(__float_as_uint(ss), __float_as_uint(ss), false, false); ss = __uint_as_float(rr[0]) + __uint_as_float(rr[1]); }
      const float rn = QSCALE_M / sqrtf(ss * (1.0f / 128.0f) + EPS);
#pragma unroll
      for (int d0 = 0; d0 < 8; ++d0) { const f32x4 g0 = *(const f32x4*)(A.gmq + d0 * 16 + hi * 8), g1 = *(const f32x4*)(A.gmq + d0 * 16 + hi * 8 + 4);
          u32x4 w; w.x = cvtpk(bf2f((unsigned short)raw[d0][0]) * rn * g0.x, bf2f((unsigned short)raw[d0][1]) * rn * g0.y); w.y = cvtpk(bf2f((unsigned short)raw[d0][2]) * rn * g0.z, bf2f((unsigned short)raw[d0][3]) * rn * g0.w);
          w.z = cvtpk(bf2f((unsigned short)raw[d0][4]) * rn * g1.x, bf2f((unsigned short)raw[d0][5]) * rn * g1.y); w.w = cvtpk(bf2f((unsigned short)raw[d0][6]) * rn * g1.z, bf2f((unsigned short)raw[d0][7]) * rn * g1.w);
          qr[d0] = *reinterpret_cast<bf16x8*>(&w); } }
    __syncthreads();
    float l_reg = 0; f32x16 o[4] = {};
    const int vb0 = (int)(uintptr_t)V_lds + v_rd_base(lane);
#pragma unroll 1
    for (int t = 0; t < 4; ++t) {
        f32x16 p0, p1; bf16x8 pa0, pa1, pa2, pa3;
#pragma unroll
        for (int r = 0; r < 16; ++r) { p0[r] = nM2; p1[r] = nM2; }
        qkt<8>(p0, p1, K_lds + t * SHM_K, qr, r32, hi, 0);
        exp_half(p0); exp_half(p1); pack_p(p0, p1, l_reg, pa0, pa1, pa2, pa3); SBAR();
        pv_d0(o, vb0 + t * SHM_V, pa0, pa1, pa2, pa3);
    }
    { auto rr = __builtin_amdgcn_permlane32_swap(__float_as_uint(l_reg), __float_as_uint(l_reg), false, false);
      l_reg = __uint_as_float(rr[0]) + __uint_as_float(rr[1]); }
    if (hi == 0) wsl[r32] = l_reg;
    asm volatile("s_waitcnt lgkmcnt(0)" ::: "memory");
#pragma unroll
    for (int r = 0; r < 16; ++r) { const int rr_ = crow(r, hi); const float rl = 1.0f / wsl[rr_];
        const bf16* gp = A.proj + (grow0 + rr_) * INC + C_MG + hm * 128 + r32; bf16* yp = A.y + (grow0 + rr_) * DM + Y_M + hm * 128 + r32;
#pragma unroll
        for (int d0 = 0; d0 < 4; ++d0) { const float g = bf2f(gp[d0 * 32]); const float val = o[d0][r] * rl * silu(g);
            yp[d0 * 32] = (bf16)(cvtpk(val, val) & 0xffffu); } }
    __syncthreads();
}

struct ConvArgs { const bf16* proj; bf16* y; const float* w; const float* bias; };
__device__ __forceinline__ void conv_items(const ConvArgs& A, long first, long stride) {
    constexpr long NIT = (long)(MTOK / 4) * 96;
    for (long it = first; it < NIT; it += stride) {
        const int row0 = (int)(it / 96) * 4, c8 = (int)(it % 96) * 8, t0 = row0 & (SEQ - 1);
        const bf16* p = A.proj + (size_t)row0 * INC + c8;
        bf16x8 xr[6], cr[6], br[4], gr[4];
#pragma unroll
        for (int i = 0; i < 6; ++i) { const int t = t0 - 1 + i; const bool ok = (t >= 0) && (t < SEQ);
            xr[i] = ok ? *reinterpret_cast<const bf16x8*>(p + (long)(i - 1) * INC + C_AX) : bf16x8{}; cr[i] = ok ? *reinterpret_cast<const bf16x8*>(p + (long)(i - 1) * INC + C_AC) : bf16x8{}; }
#pragma unroll
        for (int i = 0; i < 4; ++i) { br[i] = *reinterpret_cast<const bf16x8*>(p + (long)i * INC + C_AB); gr[i] = *reinterpret_cast<const bf16x8*>(p + (long)i * INC + C_AG); }
        float w0[8], w1[8], w2[8], bb[8];
#pragma unroll
        for (int i = 0; i < 2; ++i) { const f32x4 a = *(const f32x4*)(A.w + c8 + 4 * i), bq = *(const f32x4*)(A.w + 768 + c8 + 4 * i), cc = *(const f32x4*)(A.w + 1536 + c8 + 4 * i), dd = *(const f32x4*)(A.bias + c8 + 4 * i);
#pragma unroll
            for (int k = 0; k < 4; ++k) { w0[4 * i + k] = a[k]; w1[4 * i + k] = bq[k]; w2[4 * i + k] = cc[k]; bb[4 * i + k] = dd[k]; } }
        float u[6][8];
#pragma unroll
        for (int i = 0; i < 6; ++i)
#pragma unroll
            for (int k = 0; k < 8; ++k) u[i][k] = bf2f((unsigned short)cr[i][k]) * bf2f((unsigned short)xr[i][k]);
#pragma unroll
        for (int j = 0; j < 4; ++j) { float out[8];
#pragma unroll
            for (int k = 0; k < 8; ++k) { const float z = u[j][k] * w0[k] + u[j + 1][k] * w1[k] + u[j + 2][k] * w2[k] + bb[k];
                out[k] = bf2f((unsigned short)br[j][k]) * z * silu(bf2f((unsigned short)gr[j][k])); }
            u32x4 w; w.x = cvtpk(out[0], out[1]); w.y = cvtpk(out[2], out[3]); w.z = cvtpk(out[4], out[5]); w.w = cvtpk(out[6], out[7]);
            *(u32x4*)(A.y + (size_t)(row0 + j) * DM + Y_A + c8) = w; }
    }
}
}

using att::bf16;
typedef float f32x4_t __attribute__((ext_vector_type(4)));
typedef unsigned u32x4_t __attribute__((ext_vector_type(4)));
typedef unsigned u32x2_t __attribute__((ext_vector_type(2)));

__device__ __forceinline__ void transpose_item(const float* __restrict__ W, int K, int N, const float* __restrict__ gain, bf16* __restrict__ WT, float* scr, int item, int lane) {
    const int nblk = N / 32, kb = item / nblk, nb = item % nblk, k0 = 64 * kb, n0 = 32 * nb;
    float wv_[32], gv_[32];
    const float* wp_ = W + (size_t)(k0 + (lane >> 5)) * N + n0 + (lane & 31);
#pragma unroll
    for (int i = 0; i < 32; ++i) { wv_[i] = wp_[(size_t)(2 * i) * N]; gv_[i] = gain ? gain[k0 + 2 * i + (lane >> 5)] : 1.0f; }
#pragma unroll
    for (int i = 0; i < 32; ++i) scr[(2 * i + (lane >> 5)) * 33 + (lane & 31)] = wv_[i] * gv_[i];
    __builtin_amdgcn_s_waitcnt(0xc07f); asm volatile("s_waitcnt lgkmcnt(0)" ::: "memory");
    const int g8 = (n0 & 255) >> 5, n0p = (n0 & ~255) + 128 * (g8 & 1) + 32 * (g8 >> 1);
    const int c = lane & 7;
#pragma unroll
    for (int j = 0; j < 4; ++j) { const int n = (lane >> 3) + 8 * j; const float* s = scr + (8 * c) * 33 + n;
        u32x4_t o; o.x = pg8::cvt_pk_bf16(s[0 * 33], s[1 * 33]); o.y = pg8::cvt_pk_bf16(s[2 * 33], s[3 * 33]); o.z = pg8::cvt_pk_bf16(s[4 * 33], s[5 * 33]); o.w = pg8::cvt_pk_bf16(s[6 * 33], s[7 * 33]);
        *(u32x4_t*)(WT + (size_t)(n0p + n) * K + k0 + 8 * c) = o; }
    asm volatile("s_waitcnt lgkmcnt(0)" ::: "memory");
}
__device__ __forceinline__ void row_to_bf16(const float* __restrict__ xrow, bf16* __restrict__ orow, float* __restrict__ ssrow, int lane) {
    const f32x4_t* xr = (const f32x4_t*)xrow + lane; f32x4_t v[8]; float s = 0.f;
#pragma unroll
    for (int j = 0; j < 8; ++j) { v[j] = xr[64 * j]; s += (v[j].x * v[j].x + v[j].y * v[j].y) + (v[j].z * v[j].z + v[j].w * v[j].w); }
    s = att::wave_sum(s);
    u32x2_t* o8 = (u32x2_t*)orow + lane;
#pragma unroll
    for (int j = 0; j < 8; ++j) { u32x2_t w; w.x = pg8::cvt_pk_bf16(v[j].x, v[j].y); w.y = pg8::cvt_pk_bf16(v[j].z, v[j].w); o8[64 * j] = w; }
    if (lane < 32) ssrow[lane] = (lane == 0) ? s : 0.f;
}


#define XB_TMO      128
#define XB_XCNT(j)  (256  + 64 * (j))
#define XB_XSUB(j)  (1280 + 64 * (j))
#define XB_XGEN(j)  (2304 + 64 * (j))
#define XB_TOP      3328
#define XB_TOPGEN   3392
#define XCD_BAR_WORDS 3456
#define XB_SPIN_CAP (1u << 18)
#define LAS __attribute__((address_space(3)))

__device__ __forceinline__ unsigned xb_ld(unsigned* p)              { return __hip_atomic_load(p, __ATOMIC_RELAXED, __HIP_MEMORY_SCOPE_AGENT); }
__device__ __forceinline__ unsigned xb_add(unsigned* p, unsigned v) { return __hip_atomic_fetch_add(p, v, __ATOMIC_RELAXED, __HIP_MEMORY_SCOPE_AGENT); }
__device__ __forceinline__ unsigned xb_xcc_id() { return (unsigned)__builtin_amdgcn_s_getreg((3 << 11) | 20) & 0xFu; }
#define XB_SPIN(cond, bar) do { unsigned _sp = 0; while (cond) { __builtin_amdgcn_s_sleep(1); \
    if ((++_sp & 255u) == 0u) { if (xb_ld(&(bar)[XB_TMO])) break; if (_sp > XB_SPIN_CAP) { atomicAdd(&(bar)[XB_TMO], 1u); break; } } } } while (0)

struct XcdBarrier {
    unsigned* bar; unsigned x;
    volatile LAS unsigned* st;
};

__device__ __forceinline__ XcdBarrier xcd_barrier_post(unsigned* bar, volatile LAS unsigned* st) {
    XcdBarrier b; b.bar = bar; b.x = xb_xcc_id(); b.st = st;
    if (threadIdx.x == 0) (void)xb_add(&bar[XB_XCNT(b.x)], 1u);
    return b;
}
__device__ __forceinline__ void xcd_barrier_complete(unsigned* bar, unsigned x, unsigned& nloc, unsigned& nx) {
    const unsigned G = gridDim.x * gridDim.y * gridDim.z;
    unsigned sum, cnt, mine, sp = 0u;
    for (;;) {
        sum = 0u; cnt = 0u; mine = 0u;
#pragma unroll
        for (unsigned j = 0; j < 16; ++j) { const unsigned c = xb_ld(&bar[XB_XCNT(j)]); sum += c; cnt += (c > 0u) ? 1u : 0u; mine = (j == x) ? c : mine; }
        if (sum == G) break;
        __builtin_amdgcn_s_sleep(1);
        if ((++sp & 255u) == 0u) { if (xb_ld(&bar[XB_TMO])) break; if (sp > XB_SPIN_CAP) { atomicAdd(&bar[XB_TMO], 1u); break; } }
    }
    nloc = mine > 0u ? mine : 1u; nx = cnt > 0u ? cnt : 1u;
}

__device__ __forceinline__ void xcd_barrier(const XcdBarrier& b) {
    asm volatile("s_waitcnt vmcnt(0)" ::: "memory");
    __syncthreads();
    if (threadIdx.x == 0) {
        unsigned* bar = b.bar;
        __builtin_amdgcn_s_waitcnt(0);
        unsigned nloc = b.st[0], nx = b.st[1];
        if (nloc == 0u) { xcd_barrier_complete(bar, b.x, nloc, nx); b.st[0] = nloc; b.st[1] = nx; }
        const unsigned old = xb_add(&bar[XB_XSUB(b.x)], 1u);
        const unsigned gen = old / nloc;
        if (old + 1u == (gen + 1u) * nloc) {
            __builtin_amdgcn_fence(__ATOMIC_RELEASE, "agent");
            asm volatile("s_waitcnt vmcnt(0)" ::: "memory");
            const unsigned og = xb_add(&bar[XB_TOP], 1u);
            const unsigned tg = og / nx;
            if (og + 1u == (tg + 1u) * nx) xb_add(&bar[XB_TOPGEN], 1u);
            else XB_SPIN(xb_ld(&bar[XB_TOPGEN]) == tg, bar);
            __builtin_amdgcn_fence(__ATOMIC_ACQUIRE, "agent");
            xb_add(&bar[XB_XGEN(b.x)], 1u);
            asm volatile("s_waitcnt vmcnt(0)" ::: "memory");
        } else {
            XB_SPIN(xb_ld(&bar[XB_XGEN(b.x)]) == gen, bar);
            __builtin_amdgcn_fence(__ATOMIC_ACQUIRE, "agent");
            asm volatile("s_waitcnt vmcnt(0)" ::: "memory");
        }
    }
    __syncthreads();
}

__device__ __forceinline__ void fill_rowscale(const float* __restrict__ ssq, int pm0, unsigned char* lds, int tid) {
    const int row = tid >> 1, h = tid & 1;
    const f32x4_t* sp = (const f32x4_t*)(ssq + ((size_t)pm0 * 256 + row) * 32 + h * 16);
    const f32x4_t a = sp[0], b = sp[1], c = sp[2], d = sp[3];
    float s = (((a.x + a.y) + (a.z + a.w)) + ((b.x + b.y) + (b.z + b.w))) + (((c.x + c.y) + (c.z + c.w)) + ((d.x + d.y) + (d.z + d.w)));
    s += swz_xor<1>(s);
    if (h == 0) ((float*)(lds + 131072 + 2048))[row] = __builtin_amdgcn_rsqf(s * (1.0f / 2048.0f) + 1e-6f);
    __syncthreads();
}

struct Args { const float* in[18]; float* out; unsigned char* ws; int ph_lo, ph_hi; };
constexpr int NPHASE = 2 + 3 * DEPTH;

__global__ void __launch_bounds__(512) fwd_megakernel(Args args) {
    extern __shared__ __attribute__((aligned(16))) unsigned char lds[];
    cg::grid_group grid = cg::this_grid();
    const int tid = threadIdx.x, lane = tid & 63, wave = __builtin_amdgcn_readfirstlane(tid >> 6);
    const int G = gridDim.x, bx = blockIdx.x;
    unsigned char* ws = args.ws;
    bf16* WinT = (bf16*)(ws + WS_WIN); bf16* WoutT = (bf16*)(ws + WS_WOUT); bf16* WmemT = (bf16*)(ws + WS_WMEM);
    bf16* xb = (bf16*)(ws + WS_XB); bf16* memb = (bf16*)(ws + WS_MEMB); bf16* mkv = (bf16*)(ws + WS_MKV);
    float* ssq = (float*)(ws + WS_SSQ); float* ssqm = (float*)(ws + WS_SSQM);
    bf16* proj = (bf16*)(ws + WS_PROJ); bf16* yb = (bf16*)(ws + WS_Y);
    const int lo = args.ph_lo, hi = args.ph_hi;
#define IN(k) (lo <= (k) && (k) < hi)
    volatile LAS unsigned* xb_st = (volatile LAS unsigned*)((LAS unsigned char*)lds + 131072 + 3584);
    if (threadIdx.x < 4) xb_st[threadIdx.x] = 0u;
    __syncthreads();
    XcdBarrier xbar; xbar.bar = (unsigned*)(ws + WS_BAR); xbar.x = 0; xbar.st = xb_st;
#define SEAM(k) do { if (IN(k) && IN((k) + 1)) { if ((k) == 0) { grid.sync(); xbar = xcd_barrier_post((unsigned*)(ws + WS_BAR), xb_st); } else xcd_barrier(xbar); } } while (0)

#ifndef NO_PRO
    if (IN(0)) {
        float* scr = (float*)lds + wave * (64 * 33);
        const int gw = bx * 8 + wave, NGW = G * 8;
        constexpr int I_IN = (DM / 64) * (INC / 32), I_OUT = (DM / 64) * (DM / 32), I_MEM = (DM / 64) * (1024 / 32);
        constexpr int NITEMS = DEPTH * (I_IN + I_OUT + I_MEM);
        for (int it = gw; it < NITEMS; it += NGW) {
            int r = it;
            if (r < DEPTH * I_IN) { const int l = r / I_IN; r -= l * I_IN;
                transpose_item(args.in[3] + (size_t)l * DM * INC, DM, INC, args.in[2] + l * DM, WinT + (size_t)l * INC * DM, scr, r, lane); continue; }
            r -= DEPTH * I_IN;
            if (r < DEPTH * I_OUT) { const int l = r / I_OUT; r -= l * I_OUT;
                transpose_item(args.in[17] + (size_t)l * DM * DM, DM, DM, nullptr, WoutT + (size_t)l * DM * DM, scr, r, lane); continue; }
            r -= DEPTH * I_OUT;
            { const int l = r / I_MEM; r -= l * I_MEM;
                transpose_item(args.in[14] + (size_t)l * DM * 1024, DM, 1024, args.in[13] + l * DM, WmemT + (size_t)l * 1024 * DM, scr, r, lane); }
        }
        for (int m = gw; m < MTOK + MMEM; m += NGW) {
            if (m < MTOK) row_to_bf16(args.in[0] + (size_t)m * DM, xb + (size_t)m * DM, ssq + (size_t)m * 32, lane);
            else { const int mm = m - MTOK; row_to_bf16(args.in[1] + (size_t)mm * DM, memb + (size_t)mm * DM, ssqm + (size_t)mm * 32, lane); }
        }
        if (bx == 0 && opaque_tid(wave) < 16) ((unsigned*)(ws + WS_CTR))[opaque_tid(wave)] = (unsigned)G;
        if (bx == 0) for (int i_ = opaque_tid(wave); i_ < XCD_BAR_WORDS; i_ += 512) ((unsigned*)(ws + WS_BAR))[i_] = 0u;
        __syncthreads();
    }
#endif
    SEAM(0);
#ifndef NO_G1
    if (IN(1)) {
        pg8::Gemm g{memb, WmemT, MMEM, MKVC, DM}; pg8::StaticOrder S; S.init(MMEM, MKVC, G, bx);
        pg8::Unit u0_; int pm0_ = -1; if (S.next(0, u0_)) { pm0_ = u0_.pm; fill_rowscale(ssqm, pm0_, lds, opaque_tid(wave)); }
        pg8::EpiProj E{mkv, MKVC, ssqm, nullptr, nullptr, 0, 0, 0, 0, 1.f, (const PG8_LAS float*)((PG8_LAS unsigned char*)lds + 131072 + 2048), pm0_};
        pg8::gemm_phase<pg8::EpiProj, pg8::StaticOrder, true, true>((PG8_LAS unsigned char*)lds, g, S, E, wave);
    }
#endif
#pragma unroll 1
    for (int l = 0; l < DEPTH; ++l) {
        const int pA = 2 + 3 * l, pB = pA + 1, pC = pA + 2;
        int bxl = bx; asm volatile("" : "+s"(bxl));
#ifndef NO_G2
        if (IN(pA)) {
            pg8::Gemm g{xb, WinT + (size_t)l * INC * DM, MTOK, INC, DM}; pg8::StaticOrder S; S.init(MTOK, INC, G, bxl);
            pg8::Unit u0_{0, 0}; (void)S.next(0, u0_); const int pm0_ = u0_.pm;
            fill_rowscale(ssq, pm0_, lds, opaque_tid(wave));
            pg8::EpiProj E{proj, INC, ssq, args.in[6] + l * 64, args.in[7] + l * 64, C_DQ / 256, C_DK / 256, C_DK / 256, C_DV / 256, QSCALE_D, (const PG8_LAS float*)((PG8_LAS unsigned char*)lds + 131072 + 2048), pm0_};
            pg8::gemm_phase<pg8::EpiProj, pg8::StaticOrder, true, true>((PG8_LAS unsigned char*)lds, g, S, E, wave);
        }
#endif
        SEAM(pA);
        if (IN(pB)) {
            att::DiffArgs DA{proj, yb, args.in[12] + l * 128, 0, 0, 0};
            { const int ln = opaque_tid(wave) & 63;
              const float mq = att::wave_max(fabsf(args.in[6][l * 64 + ln])), mk = att::wave_max(fabsf(args.in[7][l * 64 + ln]));
              const float s1 = att::wave_sum(args.in[8][l * 64 + ln] * args.in[9][l * 64 + ln]), s2 = att::wave_sum(args.in[10][l * 64 + ln] * args.in[11][l * 64 + ln]);
              const int cb = (l == 0) ? 0x3e4ccccd : (l == 1) ? 0x3eb60549 : (l == 2) ? 0x3ef1014c : 0x3f0e59d5;
              const float li = __int_as_float(cb);
              DA.nM2b = att::to_sgpr(__float_as_int(-(8.0f * mq * mk * LOG2E * 1.03f + 0.25f))); DA.lamb = att::to_sgpr(__float_as_int(expf(s1) - expf(s2) + li)); DA.laminitb = att::to_sgpr(cb); }
            att::MemArgs MA{proj, mkv, yb, args.in[15] + l * 128, args.in[16] + l * 128, l};
            unsigned* ctr = (unsigned*)(ws + WS_CTR) + l;
            att::ConvArgs CA{proj, yb, args.in[4] + l * 3 * 768, args.in[5] + l * 768};
            for (int first_ = 1;; first_ = 0) { const int it = first_ ? bx : att::next_item(ctr, (char*)lds, opaque_tid(wave));
                if (it >= 768 + 256 + 256) break;
                if (it < 768) { const int r = it & 127; att::diff_unit(DA, r >> 6, 5 - (it >> 7), r & 63, (char*)lds, wave); }
                else if (it < 1024) { att::conv_items(CA, (long)(it - 768) * 512 + opaque_tid(wave), 256L * 512); __syncthreads(); }
                else att::mem_unit(MA, it - 1024, (char*)lds, wave); }
        }
        SEAM(pB);
#ifndef NO_G3
        if (IN(pC)) {
            pg8::Gemm g{yb, WoutT + (size_t)l * DM * DM, MTOK, DM, DM}; pg8::StaticOrder S; S.init(MTOK, DM, G, bxl);
            pg8::EpiOut E{args.out, xb, ssq, (l == DEPTH - 1) ? 1 : 0};
            pg8::gemm_phase<pg8::EpiOut, pg8::StaticOrder, true, true>((PG8_LAS unsigned char*)lds, g, S, E, wave);
        }
#endif
        if (l + 1 < DEPTH) SEAM(pC);
    }
#undef IN
#undef SEAM
}

extern "C" void kernel_launch(void* const* d_in, const int* in_sizes, int n_in, void* d_out, int out_size, void* d_ws, size_t ws_size, hipStream_t stream) {
    static int grid = 0;
    if (grid == 0) {
        if (n_in != 18 || in_sizes[0] != MTOK * DM || out_size != MTOK * DM || ws_size < WS_END) { fprintf(stderr, "kernel_launch: unexpected shapes (n_in %d, in0 %d, out %d, ws %zu)\n", n_in, n_in > 0 ? in_sizes[0] : -1, out_size, ws_size); grid = -1; return; }
        int dev = 0, cus = 0, per_cu = 0;
        if (hipGetDevice(&dev) != hipSuccess || hipDeviceGetAttribute(&cus, hipDeviceAttributeMultiprocessorCount, dev) != hipSuccess) { grid = -1; return; }
        if (hipFuncSetAttribute((const void*)fwd_megakernel, hipFuncAttributeMaxDynamicSharedMemorySize, LDS_BYTES) != hipSuccess) { fprintf(stderr, "kernel_launch: hipFuncSetAttribute failed\n"); grid = -1; return; }
        if (hipOccupancyMaxActiveBlocksPerMultiprocessor(&per_cu, (const void*)fwd_megakernel, 512, LDS_BYTES) != hipSuccess || per_cu < 1) { fprintf(stderr, "kernel_launch: occupancy query says %d blocks per CU\n", per_cu); per_cu = 1; }
        (void)hipGetLastError();
        grid = cus * 1;
    }
    if (grid < 0) return;
    Args a{};
    for (int i = 0; i < 18; ++i) a.in[i] = (const float*)d_in[i];
    a.out = (float*)d_out; a.ws = (unsigned char*)d_ws;
#if MK_ONE_LAUNCH
    a.ph_lo = 0; a.ph_hi = NPHASE;
    void* kargs[] = {&a};
    hipError_t e = hipLaunchCooperativeKernel((const void*)fwd_megakernel, dim3(grid), dim3(512), kargs, LDS_BYTES, stream);
    if (e != hipSuccess) fprintf(stderr, "kernel_launch: cooperative launch failed: %s (grid %d)\n", hipGetErrorString(e), grid);
#else
    for (int p = 0; p < NPHASE; ++p) { a.ph_lo = p; a.ph_hi = p + 1;
        hipLaunchKernelGGL(fwd_megakernel, dim3(grid), dim3(512), LDS_BYTES, stream, a);
        const hipError_t le = hipPeekAtLastError();
        if (le != hipSuccess) { fprintf(stderr, "kernel_launch: launch %d failed: %s\n", p, hipGetErrorName(le)); break; } }
#endif
}
```
